# Optimizing an MI355X kernel written in HIP

```python
import math
import jax, jax.numpy as jnp
from jax import lax
import numpy as np

D_MODEL = 4096
BATCH = 1
SEQ = 16384
DEPTH = 4

A_HEADS = 4
A_V_DIM = D_MODEL // 8
A_QK_DIM = A_V_DIM // 2
A_QK = A_HEADS * A_QK_DIM
A_WIDTH = A_HEADS * A_V_DIM
A_CHUNK = 64
CONV_WIDTH = 4
B_HEAD_DIM = 128
B_HEADS = 8
B_WIDTH = B_HEADS * B_HEAD_DIM
Q_BLOCK = 128
POOL_WINDOWS = (2, 4, 8, 16)
C_GROUPS = 4
C_WIDTH = D_MODEL
C_GROUP_DIM = C_WIDTH // C_GROUPS

EVEN_SPLITS = (2 * A_QK, A_WIDTH, A_WIDTH, A_WIDTH, A_HEADS, A_HEADS,
               B_WIDTH, B_WIDTH, B_WIDTH, B_WIDTH)
EVEN_IN = sum(EVEN_SPLITS)
EVEN_MIX = A_WIDTH + B_WIDTH
ODD_IN = 2 * C_WIDTH

DEEPNORM_ALPHA = (2 * DEPTH) ** 0.25
DEEPNORM_BETA = (8 * DEPTH) ** -0.25
LN_EPS = 1e-5

kernel_name = 'hybrid_mlstm_stickbreak_pool_deepnorm'


def layer_norm(x, g, b):
    xf = x.astype(jnp.float32)
    mu = xf.mean(-1, keepdims=True)
    var = jnp.square(xf - mu).mean(-1, keepdims=True)
    return ((xf - mu) * lax.rsqrt(var + LN_EPS) * g + b).astype(x.dtype)


def head_norm(h, w):
    mu = h.mean(-1, keepdims=True)
    var = jnp.square(h - mu).mean(-1, keepdims=True)
    return (h - mu) * lax.rsqrt(var + LN_EPS) * w


def causal_dwconv(x, w):
    K = w.shape[0]
    S = x.shape[1]
    xp = jnp.pad(x, ((0, 0), (K - 1, 0), (0, 0)))
    return sum(w[j] * xp[:, j:j + S] for j in range(K))


def mlstm_chunkwise(q, k, v, log_i, log_f):
    f32 = jnp.float32
    Bsz, S, H, dk = q.shape
    dv = v.shape[-1]
    L = A_CHUNK
    NC = S // L
    q = q.astype(f32) * dk ** -0.5

    def chunks(a):
        return a.astype(f32).reshape(Bsz, NC, L, H, -1).transpose(1, 0, 3, 2, 4)

    def gchunks(a):
        return a.astype(f32).reshape(Bsz, NC, L, H).transpose(1, 0, 3, 2)

    causal = jnp.tril(jnp.ones((L, L), dtype=bool))

    def step(carry, inp):
        C, n, m = carry
        qc, kc, vc, li, lf = inp
        b = jnp.cumsum(lf, axis=-1)
        dmat = jnp.where(causal, b[..., :, None] - b[..., None, :] + li[..., None, :], -jnp.inf)
        inter = b + m[..., None]
        m_t = jnp.maximum(inter, dmat.max(-1))
        w_intra = jnp.exp(dmat - m_t[..., None])
        s_intra = jnp.einsum('bhtd,bhsd->bhts', qc, kc) * w_intra
        w_inter = jnp.exp(inter - m_t)
        num = (jnp.einsum('bhts,bhsv->bhtv', s_intra, vc)
               + w_inter[..., None] * jnp.einsum('bhtd,bhdv->bhtv', qc, C))
        den = s_intra.sum(-1) + w_inter * jnp.einsum('bhtd,bhd->bht', qc, n)
        den = jnp.maximum(jnp.abs(den), jnp.exp(-m_t))
        h = num / den[..., None]
        b_last = b[..., -1]
        wdec = b_last[..., None] - b + li
        m_new = jnp.maximum(b_last + m, wdec.max(-1))
        ws = jnp.exp(wdec - m_new[..., None])
        carry_decay = jnp.exp(b_last + m - m_new)
        C_new = carry_decay[..., None, None] * C + jnp.einsum('bhs,bhsd,bhsv->bhdv', ws, kc, vc)
        n_new = carry_decay[..., None] * n + jnp.einsum('bhs,bhsd->bhd', ws, kc)
        return (C_new, n_new, m_new), h

    init = (jnp.zeros((Bsz, H, dk, dv), f32), jnp.zeros((Bsz, H, dk), f32),
            jnp.zeros((Bsz, H), f32))
    _, h = lax.scan(step, init, (chunks(q), chunks(k), chunks(v), gchunks(log_i), gchunks(log_f)))
    return h.transpose(1, 0, 3, 2, 4).reshape(Bsz, S, H, dv)


def stick_breaking(q, k, v):
    f32 = jnp.float32
    Bsz, S, H, dh = q.shape
    NQB = S // Q_BLOCK
    qt = (q.astype(f32) * dh ** -0.5).transpose(0, 2, 1, 3)
    kt = k.astype(f32).transpose(0, 2, 1, 3)
    vt = v.astype(f32).transpose(0, 2, 1, 3)
    ar = jnp.arange(Q_BLOCK)
    diag_mask = ar[None, :] < ar[:, None]
    outs = []
    for i in range(NQB):
        start, end = i * Q_BLOCK, (i + 1) * Q_BLOCK
        mask = jnp.concatenate([jnp.ones((Q_BLOCK, start), dtype=bool), diag_mask], axis=1)
        z = jnp.einsum('bhqd,bhsd->bhqs', qt[:, :, start:end], kt[:, :, :end])
        ls = jax.nn.log_sigmoid(z)
        log_keep = jnp.where(mask, ls - z, 0.0)
        between = lax.cumsum(log_keep, axis=3, reverse=True) - log_keep
        weights = jnp.where(mask, jnp.exp(ls + between), 0.0)
        outs.append(jnp.einsum('bhqs,bhsd->bhqd', weights, vt[:, :, :end]))
    out = jnp.concatenate(outs, axis=2)
    return out.transpose(0, 2, 1, 3).reshape(Bsz, S, H * dh)


def even_mixer(u, w_in, conv_w, igate_b, fgate_b, head_norm_w, w_out):
    f32 = jnp.float32
    Bsz, S, _ = u.shape
    p = u @ w_in
    idx = np.cumsum(EVEN_SPLITS)[:-1].tolist()
    qkA, vA, oA, zA, iA, fA, qB, kB, vB, zB = jnp.split(p, idx, axis=-1)
    qkA = jax.nn.silu(causal_dwconv(qkA, conv_w))
    qA, kA = jnp.split(qkA, 2, axis=-1)
    log_i = iA.astype(f32) + igate_b
    log_f = jax.nn.log_sigmoid(fA.astype(f32) + fgate_b)
    hA = mlstm_chunkwise(qA.reshape(Bsz, S, A_HEADS, A_QK_DIM),
                         kA.reshape(Bsz, S, A_HEADS, A_QK_DIM),
                         vA.reshape(Bsz, S, A_HEADS, A_V_DIM), log_i, log_f)
    hA = jax.nn.sigmoid(oA.astype(f32)).reshape(Bsz, S, A_HEADS, A_V_DIM) * hA
    hA = head_norm(hA, head_norm_w.reshape(A_HEADS, A_V_DIM)).reshape(Bsz, S, A_WIDTH)
    hA = hA * jax.nn.silu(zA.astype(f32))
    hB = stick_breaking(qB.reshape(Bsz, S, B_HEADS, B_HEAD_DIM),
                        kB.reshape(Bsz, S, B_HEADS, B_HEAD_DIM),
                        vB.reshape(Bsz, S, B_HEADS, B_HEAD_DIM))
    hB = hB * jax.nn.silu(zB.astype(f32))
    mix = jnp.concatenate([hA, hB], axis=-1).astype(u.dtype)
    return mix @ w_out


def pool_mixer(u, w_in, pool_w, pool_b, pool_scale, w_out):
    f32 = jnp.float32
    Bsz, S, _ = u.shape
    p = u @ w_in
    v, z = jnp.split(p, 2, axis=-1)
    vg = v.astype(f32).reshape(Bsz, S, C_GROUPS, C_GROUP_DIM)
    csum = jnp.concatenate([jnp.zeros_like(vg[:, :1]), jnp.cumsum(vg, axis=1)], axis=1)
    pos = jnp.arange(1, S + 1, dtype=f32)
    groups = []
    for g, w in enumerate(POOL_WINDOWS):
        cg = csum[:, :, g]
        lag = jnp.concatenate([jnp.zeros_like(cg[:, :w - 1]), cg[:, :S + 1 - w]], axis=1)
        mean = (cg[:, 1:] - lag) / jnp.minimum(pos, w)[None, :, None]
        groups.append(mean - vg[:, :, g])
    pooled = jnp.stack(groups, axis=2)
    mixed = jnp.einsum('bsgc,gcd->bsgd', pooled, pool_w.astype(f32)) + pool_b
    h = mixed.reshape(Bsz, S, C_WIDTH) * pool_scale * jax.nn.silu(z.astype(f32))
    return h.astype(u.dtype) @ w_out


def _even_params(ks, l):
    D = D_MODEL
    return {
        'ada_w_%d' % l: jax.random.normal(next(ks), (D, 3 * D)) * (0.2 * D ** -0.5),
        'ada_b_%d' % l: jax.random.normal(next(ks), (3 * D,)) * 0.01,
        'w_in_%d' % l: jax.random.normal(next(ks), (D, EVEN_IN)) * D ** -0.5,
        'conv_w_%d' % l: jax.random.normal(next(ks), (CONV_WIDTH, 2 * A_QK)) * CONV_WIDTH ** -0.5,
        'igate_b_%d' % l: jax.random.normal(next(ks), (A_HEADS,)) * 0.1,
        'fgate_b_%d' % l: 3.0 + jnp.linspace(0.0, 3.0, A_HEADS) + jax.random.normal(next(ks), (A_HEADS,)) * 0.1,
        'head_norm_w_%d' % l: 1.0 + jax.random.normal(next(ks), (A_WIDTH,)) * 0.02,
        'w_out_%d' % l: jax.random.normal(next(ks), (EVEN_MIX, D)) * (EVEN_MIX ** -0.5 * DEEPNORM_BETA),
        'ln_g_%d' % l: 1.0 + jax.random.normal(next(ks), (D,)) * 0.02,
        'ln_b_%d' % l: jax.random.normal(next(ks), (D,)) * 0.02,
    }


def _odd_params(ks, l):
    D = D_MODEL
    return {
        'ada_w_%d' % l: jax.random.normal(next(ks), (D, 3 * D)) * (0.2 * D ** -0.5),
        'ada_b_%d' % l: jax.random.normal(next(ks), (3 * D,)) * 0.01,
        'w_in_%d' % l: jax.random.normal(next(ks), (D, ODD_IN)) * D ** -0.5,
        'pool_w_%d' % l: jax.random.normal(next(ks), (C_GROUPS, C_GROUP_DIM, C_GROUP_DIM)) * C_GROUP_DIM ** -0.5,
        'pool_b_%d' % l: jax.random.normal(next(ks), (C_GROUPS, C_GROUP_DIM)) * 0.02,
        'pool_scale_%d' % l: 1.0 + jax.random.normal(next(ks), (C_WIDTH,)) * 0.1,
        'w_out_%d' % l: jax.random.normal(next(ks), (C_WIDTH, D)) * (C_WIDTH ** -0.5 * DEEPNORM_BETA),
        'ln_g_%d' % l: 1.0 + jax.random.normal(next(ks), (D,)) * 0.02,
        'ln_b_%d' % l: jax.random.normal(next(ks), (D,)) * 0.02,
    }


def setup_inputs(seed: int = 0) -> dict:
    key = jax.random.key(seed)
    ks = iter(jax.random.split(key, 64))
    params = {
        'x': jax.random.normal(next(ks), (BATCH, SEQ, D_MODEL), dtype=jnp.float32),
        'c': jax.random.normal(next(ks), (BATCH, D_MODEL), dtype=jnp.float32),
    }
    for l in range(DEPTH):
        params.update(_even_params(ks, l) if l % 2 == 0 else _odd_params(ks, l))
    return params


def reference(x, c,
              ada_w_0, ada_b_0, w_in_0, conv_w_0, igate_b_0, fgate_b_0, head_norm_w_0, w_out_0, ln_g_0, ln_b_0,
              ada_w_1, ada_b_1, w_in_1, pool_w_1, pool_b_1, pool_scale_1, w_out_1, ln_g_1, ln_b_1,
              ada_w_2, ada_b_2, w_in_2, conv_w_2, igate_b_2, fgate_b_2, head_norm_w_2, w_out_2, ln_g_2, ln_b_2,
              ada_w_3, ada_b_3, w_in_3, pool_w_3, pool_b_3, pool_scale_3, w_out_3, ln_g_3, ln_b_3):
    ada = [(ada_w_0, ada_b_0), (ada_w_1, ada_b_1), (ada_w_2, ada_b_2), (ada_w_3, ada_b_3)]
    post = [(ln_g_0, ln_b_0), (ln_g_1, ln_b_1), (ln_g_2, ln_b_2), (ln_g_3, ln_b_3)]
    mixers = [
        (w_in_0, conv_w_0, igate_b_0, fgate_b_0, head_norm_w_0, w_out_0),
        (w_in_1, pool_w_1, pool_b_1, pool_scale_1, w_out_1),
        (w_in_2, conv_w_2, igate_b_2, fgate_b_2, head_norm_w_2, w_out_2),
        (w_in_3, pool_w_3, pool_b_3, pool_scale_3, w_out_3),
    ]
    c_act = jax.nn.silu(c)
    for l in range(DEPTH):
        mod = c_act @ ada[l][0] + ada[l][1]
        shift, scale, gate = jnp.split(mod, 3, axis=-1)
        u = x * (1.0 + scale[:, None, :]) + shift[:, None, :]
        if l % 2 == 0:
            y = even_mixer(u, *mixers[l])
        else:
            y = pool_mixer(u, *mixers[l])
        x = layer_norm(DEEPNORM_ALPHA * x + (1.0 + gate[:, None, :]) * y, *post[l])
    return x
```

```cpp
#include <hip/hip_runtime.h>
#include <cstdio>
#include <cstdint>

#ifndef REP_P0
#define REP_P0 1
#endif
#ifndef REP_E2
#define REP_E2 1
#endif
#ifndef REP_E3
#define REP_E3 1
#endif
#ifndef REP_ROWS
#define REP_ROWS 1
#endif
#ifndef REP_GEMM
#define REP_GEMM 1
#endif
#ifndef MK_MULTI
#define MK_MULTI 0
#endif

namespace pg8 {
#define PG8_LAS __attribute__((address_space(3)))
typedef unsigned short bf16_t;
typedef short bf16x8 __attribute__((ext_vector_type(8)));
typedef float f32x4 __attribute__((ext_vector_type(4)));
typedef unsigned u32x4 __attribute__((ext_vector_type(4)));
constexpr int BM = 256, BK = 64, HALF = 128, HTB = HALF * BK * 2, STAGE_BYTES = 8 * HTB, NXCD = 8, WGM = 8;

__host__ __device__ __forceinline__ int lds_byte(int r, int c) { const int st = (r >> 4) * 2 + (c >> 5), rr = r & 15, cc = c & 31, ob = rr * 64 + cc * 2; return st * 1024 + (ob ^ (((ob >> 9) & 1) << 5)); }
__host__ __device__ __forceinline__ void stage_rc(int b, int& R, int& C) { const int st = b / 1024, sb = b % 1024, swz = sb ^ (((sb >> 9) & 1) << 5); R = (st >> 1) * 16 + swz / 64; C = (st & 1) * 32 + (swz % 64) / 2; }
__host__ __device__ __forceinline__ int perm32(int rho) { const int n = rho >> 4, i = rho & 15; return 8 * (i >> 2) + 4 * n + (i & 3); }

struct Unit { int pm, pn; };
struct Gemm { const bf16_t* A; const bf16_t* Bt; int M, N, K, lda, ldb, grp_tiles, grpb_tiles; };

struct StaticOrder {
    int nM, nN, nwg, G, c;
    __host__ __device__ void init(int M, int N, int G_, int c_) { nM = M / BM; nN = N / BM; nwg = nM * nN; G = G_; c = c_; }
    __host__ __device__ bool next(int i, Unit& u) const {
        const long L = (long)i * G + c; if (L >= nwg) return false;
        int wgid = (int)L; { const int q = nwg / NXCD, r = nwg % NXCD, xcd = wgid % NXCD, off = wgid / NXCD; wgid = (xcd < r ? xcd * (q + 1) : r * (q + 1) + (xcd - r) * q) + off; }
        const int nig = WGM * nN, gid = wgid / nig, fm = gid * WGM, gsz = (nM - fm) < WGM ? (nM - fm) : WGM;
        u.pm = fm + ((wgid % nig) % gsz); u.pn = (wgid % nig) / gsz; return true;
    }
    __device__ __forceinline__ void a_ready(const Unit&) const {}
    __device__ __forceinline__ void done(const Unit&) const {}
};

__device__ __forceinline__ unsigned cvt_pk_bf16(float lo, float hi) { unsigned r; asm volatile("v_cvt_pk_bf16_f32 %0, %1, %2" : "=v"(r) : "v"(lo), "v"(hi)); return r; }
__device__ __forceinline__ float sigmoidf_fast(float x) { return __builtin_amdgcn_rcpf(1.0f + __expf(-x)); }

struct EpiAct {
    static constexpr bool PERM = true, AFTER_DRAIN = false;
    bf16_t* O; int ldc; int mode; const float* bias;
    __device__ __forceinline__ void operator()(const f32x4 (&acc)[2][2][4][2], const Unit& u, int wr, int wc, int fr, int fq) const {
        const int row0 = u.pm * BM + wr * 64 + fr, colt = u.pn * BM;
        int act = 0; float sc = 1.f;
        if (mode == 0) { if (colt >= 4096 && colt < 6144) act = 1; else if ((colt >= 6144 && colt < 8192) || colt >= 11264) act = 2; else if (colt >= 8192 && colt < 9216) sc = 0.08838834764831845f; }
        else if (mode == 1) { if (colt >= 4096) act = 2; }
        const int col0 = colt + wc * 32 + 8 * fq;
        f32x4 bv[2][2];
#pragma unroll
        for (int bj = 0; bj < 2; ++bj)
#pragma unroll
            for (int n = 0; n < 2; ++n) bv[bj][n] = bias ? *(const f32x4*)(bias + col0 + bj * HALF + 4 * n) : (f32x4){0.f, 0.f, 0.f, 0.f};
#pragma unroll
        for (int ai = 0; ai < 2; ++ai)
#pragma unroll
            for (int m = 0; m < 4; ++m) { bf16_t* rowp = O + (size_t)(row0 + ai * HALF + m * 16) * ldc + col0;
#pragma unroll
                for (int bj = 0; bj < 2; ++bj) { f32x4 v0 = acc[ai][bj][m][0] + bv[bj][0], v1 = acc[ai][bj][m][1] + bv[bj][1];
                    if (act == 1) {
#pragma unroll
                        for (int j = 0; j < 4; ++j) { v0[j] = sigmoidf_fast(v0[j]); v1[j] = sigmoidf_fast(v1[j]); } }
                    else if (act == 2) {
#pragma unroll
                        for (int j = 0; j < 4; ++j) { v0[j] = v0[j] * sigmoidf_fast(v0[j]); v1[j] = v1[j] * sigmoidf_fast(v1[j]); } }
                    v0 = v0 * sc; v1 = v1 * sc;
                    u32x4 w; w.x = cvt_pk_bf16(v0[0], v0[1]); w.y = cvt_pk_bf16(v0[2], v0[3]); w.z = cvt_pk_bf16(v1[0], v1[1]); w.w = cvt_pk_bf16(v1[2], v1[3]);
                    *(u32x4*)(rowp + bj * HALF) = w; } }
    }
};
struct EpiRes {
    static constexpr bool PERM = false, AFTER_DRAIN = false;
    const float* X; float* T; const float* gate; float alpha;
    __device__ __forceinline__ void operator()(const f32x4 (&acc)[2][2][4][2], const Unit& u, int wr, int wc, int fr, int fq) const {
        const int row0 = u.pm * BM + wr * 64 + fr, col0 = u.pn * BM + wc * 32 + 4 * fq;
        f32x4 gv[2][2];
#pragma unroll
        for (int bj = 0; bj < 2; ++bj)
#pragma unroll
            for (int n = 0; n < 2; ++n) gv[bj][n] = *(const f32x4*)(gate + col0 + bj * HALF + n * 16) + 1.0f;
#pragma unroll
        for (int ai = 0; ai < 2; ++ai)
#pragma unroll
            for (int m = 0; m < 4; ++m) { const size_t off = (size_t)(row0 + ai * HALF + m * 16) * 4096 + col0;
#pragma unroll
                for (int bj = 0; bj < 2; ++bj)
#pragma unroll
                    for (int n = 0; n < 2; ++n) { const f32x4 xs = *(const f32x4*)(X + off + bj * HALF + n * 16);
                        *(f32x4*)(T + off + bj * HALF + n * 16) = xs * alpha + gv[bj][n] * acc[ai][bj][m][n]; }
                asm volatile("" ::: "memory"); }
    }
};
struct EpiColScale {
    static constexpr bool PERM = true, AFTER_DRAIN = false;
    bf16_t* O; int ldc; const float* scale;
    __device__ __forceinline__ void operator()(const f32x4 (&acc)[2][2][4][2], const Unit& u, int wr, int wc, int fr, int fq) const {
        const int row0 = u.pm * BM + wr * 64 + fr, col0 = u.pn * BM + wc * 32 + 8 * fq;
        f32x4 sv[2][2];
#pragma unroll
        for (int bj = 0; bj < 2; ++bj)
#pragma unroll
            for (int n = 0; n < 2; ++n) sv[bj][n] = *(const f32x4*)(scale + col0 + bj * HALF + 4 * n) + 1.0f;
#pragma unroll
        for (int ai = 0; ai < 2; ++ai)
#pragma unroll
            for (int m = 0; m < 4; ++m) { const size_t r = (size_t)(row0 + ai * HALF + m * 16);
#pragma unroll
                for (int bj = 0; bj < 2; ++bj) { const f32x4 v0 = acc[ai][bj][m][0] * sv[bj][0], v1 = acc[ai][bj][m][1] * sv[bj][1];
                    u32x4 w; w.x = cvt_pk_bf16(v0[0], v0[1]); w.y = cvt_pk_bf16(v0[2], v0[3]); w.z = cvt_pk_bf16(v1[0], v1[1]); w.w = cvt_pk_bf16(v1[2], v1[3]);
                    *(u32x4*)(O + r * ldc + col0 + bj * HALF) = w; } }
    }
};

template <class Epi, class Sched, bool ALIGN_EPI>
__device__ __forceinline__ void gemm_phase(PG8_LAS unsigned char* lds, const Gemm g, const Sched& S, const Epi& E) {
    int tid = threadIdx.x; asm volatile("" : "+v"(tid));
    const int wid = __builtin_amdgcn_readfirstlane(tid >> 6), lane = tid & 63, wr = wid >> 2, wc = wid & 3, fr = lane & 15, fq = lane >> 4;
    const int K = g.K, nt = K / BK;
    unsigned voffA[2], voffB[2];
#pragma unroll
    for (int i = 0; i < 2; ++i) { int R, C; stage_rc(tid * 16 + i * 8192, R, C); const int Rb = Epi::PERM ? ((R & ~31) + perm32(R & 31)) : R;
        voffA[i] = (unsigned)(R * g.lda + C) * 2u; voffB[i] = (unsigned)(Rb * g.ldb + C) * 2u; }
    const size_t kstep = (size_t)(BK * 2);
    const size_t hstepA = (size_t)HALF * g.lda * 2, hstepB = (size_t)HALF * g.ldb * 2;
    const size_t tstepA = 2 * hstepA, tstepB = 2 * hstepB;
    const unsigned ldsw = (unsigned)wid * 1024u;
    const int aoff = lds_byte(wr * 64 + fr, fq * 8), boff = lds_byte(wc * 32 + fr, fq * 8);
#define PG8_UA(u) ((const char*)g.A + (size_t)(u).pm * tstepA + (g.grp_tiles ? (size_t)((u).pn / g.grp_tiles) * (size_t)K * 2 : (size_t)0))
#define PG8_UB(u) ((const char*)g.Bt + (size_t)(u).pn * tstepB + (g.grpb_tiles ? (size_t)((u).pm / g.grpb_tiles) * (size_t)K * 2 : (size_t)0))
#define PG8_SA(b, h) (((b) * 2 + (h)) * HTB)
#define PG8_SB(b, h) ((4 + (b) * 2 + (h)) * HTB)
#define PG8_STAGE(bufoff, gbase, voff) do { _Pragma("unroll") for (int _i = 0; _i < 2; ++_i) \
        __builtin_amdgcn_global_load_lds((const unsigned*)((const char*)(gbase) + (voff)[_i]), (PG8_LAS unsigned*)(lds + (bufoff) + ldsw + _i * 8192), 16, 0, 0); } while (0)
#define PG8_LDA(dst, b, h) do { _Pragma("unroll") for (int m = 0; m < 4; ++m) _Pragma("unroll") for (int k = 0; k < 2; ++k) dst[m][k] = *(const PG8_LAS bf16x8*)(lds + PG8_SA(b, h) + aoff + m * 2048 + k * 1024); } while (0)
#define PG8_LDB(dst, b, h) do { _Pragma("unroll") for (int n = 0; n < 2; ++n) _Pragma("unroll") for (int k = 0; k < 2; ++k) dst[n][k] = *(const PG8_LAS bf16x8*)(lds + PG8_SB(b, h) + boff + n * 2048 + k * 1024); } while (0)
#define PG8_MMA(ai, bj, At, Bt) do { __builtin_amdgcn_s_setprio(1); _Pragma("unroll") for (int m = 0; m < 4; ++m) _Pragma("unroll") for (int n = 0; n < 2; ++n) _Pragma("unroll") for (int k = 0; k < 2; ++k) \
        acc[ai][bj][m][n] = __builtin_amdgcn_mfma_f32_16x16x32_bf16(Bt[n][k], At[m][k], acc[ai][bj][m][n], 0, 0, 0); __builtin_amdgcn_s_setprio(0); } while (0)
#define PG8_WAIT_V(n) asm volatile("s_waitcnt vmcnt(" #n ")" ::: "memory")
#define PG8_WAIT_L(n) asm volatile("s_waitcnt lgkmcnt(" #n ")" ::: "memory")
#define PG8_BAR __builtin_amdgcn_s_barrier()
#define PG8_SCHED __builtin_amdgcn_sched_barrier(0)
    Unit cur, nxt; int ui = 0;
    if (!S.next(0, cur)) return;
    f32x4 acc[2][2][4][2];
#pragma unroll
    for (int a = 0; a < 2; ++a)
#pragma unroll
        for (int b = 0; b < 2; ++b)
#pragma unroll
            for (int m = 0; m < 4; ++m)
#pragma unroll
                for (int n = 0; n < 2; ++n) acc[a][b][m][n] = (f32x4){0.f, 0.f, 0.f, 0.f};
    bf16x8 At[4][2], B0[2][2], B1[2][2];
    const char* cA = PG8_UA(cur); const char* cB = PG8_UB(cur);
    S.a_ready(cur);
    PG8_STAGE(PG8_SB(0, 0), cB, voffB); PG8_STAGE(PG8_SB(0, 1), cB + hstepB, voffB); PG8_STAGE(PG8_SA(0, 0), cA, voffA); PG8_STAGE(PG8_SA(0, 1), cA + hstepA, voffA);
    if (wr == 1) PG8_BAR;
    PG8_WAIT_V(2); PG8_BAR;
    PG8_STAGE(PG8_SB(1, 0), cB + kstep, voffB); PG8_STAGE(PG8_SA(1, 0), cA + kstep, voffA); PG8_STAGE(PG8_SB(1, 1), cB + hstepB + kstep, voffB);
    PG8_WAIT_V(6); PG8_BAR;
    for (;;) {
        const bool has_next = S.next(ui + 1, nxt);
        const char* nA = has_next ? PG8_UA(nxt) : cA; const char* nB = has_next ? PG8_UB(nxt) : cB;
        for (int t = 0; t < nt; t += 2) {
            const bool last = (t == nt - 2);
            const char* a1 = cA + (size_t)(t + 1) * kstep;
            const char* a2 = last ? nA : cA + (size_t)(t + 2) * kstep; const char* b2 = last ? nB : cB + (size_t)(t + 2) * kstep;
            const char* a3 = a2 + kstep; const char* b3 = b2 + kstep;
            if (last && has_next) S.a_ready(nxt);
            PG8_LDB(B0, 0, 0); PG8_LDB(B1, 0, 1); PG8_SCHED; PG8_LDA(At, 0, 0); PG8_STAGE(PG8_SA(1, 1), a1 + hstepA, voffA);
            PG8_WAIT_V(8); PG8_WAIT_L(0); PG8_BAR; PG8_MMA(0, 0, At, B0); PG8_MMA(0, 1, At, B1); PG8_BAR; PG8_SCHED;
            PG8_LDA(At, 0, 1); PG8_STAGE(PG8_SB(0, 0), b2, voffB); PG8_STAGE(PG8_SB(0, 1), b2 + hstepB, voffB); PG8_STAGE(PG8_SA(0, 0), a2, voffA);
            PG8_WAIT_V(8); PG8_WAIT_L(0); PG8_BAR; PG8_MMA(1, 0, At, B0); PG8_MMA(1, 1, At, B1); PG8_BAR; PG8_SCHED;
            PG8_LDB(B0, 1, 0); PG8_LDB(B1, 1, 1); PG8_SCHED; PG8_LDA(At, 1, 0); PG8_STAGE(PG8_SA(0, 1), a2 + hstepA, voffA);
            PG8_WAIT_V(8); PG8_WAIT_L(0); PG8_BAR; PG8_MMA(0, 0, At, B0); PG8_MMA(0, 1, At, B1); PG8_BAR; PG8_SCHED;
            PG8_LDA(At, 1, 1); PG8_STAGE(PG8_SB(1, 0), b3, voffB); PG8_STAGE(PG8_SB(1, 1), b3 + hstepB, voffB); PG8_STAGE(PG8_SA(1, 0), a3, voffA);
            PG8_WAIT_V(8); PG8_WAIT_L(0); PG8_BAR; PG8_MMA(1, 0, At, B0); PG8_MMA(1, 1, At, B1); PG8_BAR; PG8_SCHED;
        }
        if constexpr (ALIGN_EPI) { if (wr == 0) PG8_BAR; }
        E(acc, cur, wr, wc, fr, fq); S.done(cur);
        if (!has_next) break;
#pragma unroll
        for (int a = 0; a < 2; ++a)
#pragma unroll
            for (int b = 0; b < 2; ++b)
#pragma unroll
                for (int m = 0; m < 4; ++m)
#pragma unroll
                    for (int n = 0; n < 2; ++n) acc[a][b][m][n] = (f32x4){0.f, 0.f, 0.f, 0.f};
        cur = nxt; cA = nA; cB = nB; ++ui;
        if constexpr (ALIGN_EPI) { if (wr == 1) PG8_BAR; }
    }
    PG8_WAIT_V(0);
    if constexpr (!ALIGN_EPI) { if (wr == 0) PG8_BAR; }
    PG8_BAR;
#undef PG8_UA
#undef PG8_UB
#undef PG8_SA
#undef PG8_SB
#undef PG8_STAGE
#undef PG8_LDA
#undef PG8_LDB
#undef PG8_MMA
#undef PG8_WAIT_V
#undef PG8_WAIT_L
#undef PG8_BAR
#undef PG8_SCHED
}
}

constexpr int NWAVES = 8, NTHR = 512;
constexpr int M = 16384, D = 4096;
constexpr int EVEN_IN = 12296, EVEN_N = 12288, EVEN_MIX = 3072, ODD_IN = 8192;
constexpr float LN_EPS = 1e-5f;
constexpr float DN_ALPHA = 1.6817928305074290861f;
constexpr float SB_EXIT = 104.0f;

constexpr size_t MiB = 1u << 20;
constexpr size_t WS_CTL = 0, CTL_ZERO_BYTES = 1 * MiB;
constexpr size_t WS_MOD = 1 * MiB;
constexpr size_t WS_WG = 2 * MiB;
constexpr size_t WS_GATES = 3 * MiB;
constexpr size_t WS_WINTER = 4 * MiB;
constexpr size_t WS_EMT = 5 * MiB;
constexpr size_t WS_CDEC = 6 * MiB;
constexpr size_t WS_DENR = 7 * MiB;
constexpr size_t WS_S = 8 * MiB;
constexpr size_t WS_QC = 16 * MiB;
constexpr size_t WS_KC = 48 * MiB;
constexpr size_t WS_U = 80 * MiB;
constexpr size_t WS_T = 208 * MiB;
constexpr size_t WS_P = 464 * MiB;
constexpr size_t WS_MIX = 848 * MiB;
constexpr size_t WS_NUM = 976 * MiB;
constexpr size_t WS_W = 1104 * MiB;
constexpr size_t W_IN_E = 96 * MiB, W_OUT_E = 24 * MiB, W_IN_O = 64 * MiB, W_POOL = 8 * MiB, W_OUT_O = 32 * MiB, W_PAIR = W_IN_E + W_OUT_E + W_IN_O + W_POOL + W_OUT_O;
constexpr size_t WS_VT = WS_W + 2 * W_PAIR;
constexpr size_t WS_VBT = WS_VT + 64 * MiB;
constexpr size_t WS_NUM2 = WS_VBT + 32 * MiB;
constexpr size_t WS_END = WS_NUM2 + 256 * MiB;
constexpr int CW_BAR = 4096;
constexpr size_t WS_BIAS = WS_CTL + 65536;

constexpr int RING_BYTES = 149504, LDSCTL_OFF = RING_BYTES, MISC_OFF = LDSCTL_OFF + 320, LDS_BYTES = 155648;

#define LAS __attribute__((address_space(3)))
typedef unsigned short bf16;
typedef float f32x4 __attribute__((ext_vector_type(4)));
typedef float f32x2 __attribute__((ext_vector_type(2)));
typedef unsigned u32x4 __attribute__((ext_vector_type(4)));
typedef unsigned u32x2 __attribute__((ext_vector_type(2)));
typedef short bf16x8 __attribute__((ext_vector_type(8)));
typedef __bf16 bf16x2n __attribute__((ext_vector_type(2)));

__device__ __forceinline__ unsigned f2bf(float f) { unsigned u = __builtin_bit_cast(unsigned, f); return (u + 0x7fffu + ((u >> 16) & 1u)) >> 16; }
__device__ __forceinline__ unsigned pk2(float lo, float hi) { return pg8::cvt_pk_bf16(lo, hi); }
__device__ __forceinline__ unsigned pk2n(float lo, float hi) { return __builtin_bit_cast(unsigned, __builtin_convertvector((f32x2){lo, hi}, bf16x2n)); }
__device__ __forceinline__ unsigned pkh(float lo, float hi) { return (unsigned)__builtin_bit_cast(unsigned short, (_Float16)lo) | ((unsigned)__builtin_bit_cast(unsigned short, (_Float16)hi) << 16); }
__device__ __forceinline__ float hlo(unsigned w) { return (float)__builtin_bit_cast(_Float16, (unsigned short)(w & 0xffffu)); }
__device__ __forceinline__ float hhi(unsigned w) { return (float)__builtin_bit_cast(_Float16, (unsigned short)(w >> 16)); }
__device__ __forceinline__ float bflo(unsigned w) { return __uint_as_float(w << 16); }
__device__ __forceinline__ float bfhi(unsigned w) { return __uint_as_float(w & 0xffff0000u); }
__device__ __forceinline__ float wave_sum(float v) {
#pragma unroll
    for (int o = 1; o < 64; o <<= 1) v += __shfl_xor(v, o);
    return v;
}
__device__ __forceinline__ float wave_max(float v) {
#pragma unroll
    for (int o = 1; o < 64; o <<= 1) v = fmaxf(v, __shfl_xor(v, o));
    return v;
}
__device__ __forceinline__ float wave_min(float v) {
#pragma unroll
    for (int o = 1; o < 64; o <<= 1) v = fminf(v, __shfl_xor(v, o));
    return v;
}
__device__ __forceinline__ float wave_incl_sum(float v, int lane) {
#pragma unroll
    for (int o = 1; o < 64; o <<= 1) { const float t = __shfl_up(v, o); if (lane >= o) v += t; }
    return v;
}
__device__ __forceinline__ float wave_incl_max(float v, int lane) {
#pragma unroll
    for (int o = 1; o < 64; o <<= 1) { const float t = __shfl_up(v, o); if (lane >= o) v = fmaxf(v, t); }
    return v;
}
__device__ __forceinline__ float logsigmoidf_acc(float x) { return x >= 0.f ? -log1pf(expf(-x)) : x - log1pf(expf(x)); }
__device__ __forceinline__ float softplusf_acc(float z) { return fmaxf(z, 0.f) + log1pf(expf(-fabsf(z))); }
__device__ __forceinline__ float softplusf_fast(float z) { return fmaxf(z, 0.f) + __logf(1.0f + __expf(-fabsf(z))); }
__device__ __forceinline__ void unpack8(const u32x4 w, float (&f)[8]) { f[0] = bflo(w.x); f[1] = bfhi(w.x); f[2] = bflo(w.y); f[3] = bfhi(w.y); f[4] = bflo(w.z); f[5] = bfhi(w.z); f[6] = bflo(w.w); f[7] = bfhi(w.w); }

#define XB_TMO      128
#define XB_XCNT(j)  (256  + 64 * (j))
#define XB_XSUB(j)  (1280 + 64 * (j))
#define XB_XGEN(j)  (2304 + 64 * (j))
#define XB_TOP      3328
#define XB_TOPGEN   3392
#define XCD_BAR_WORDS 3456
#define XB_SPIN_CAP (1u << 18)
__device__ __forceinline__ unsigned xb_ld(unsigned* p)              { return __hip_atomic_load(p, __ATOMIC_RELAXED, __HIP_MEMORY_SCOPE_AGENT); }
__device__ __forceinline__ unsigned xb_add(unsigned* p, unsigned v) { return __hip_atomic_fetch_add(p, v, __ATOMIC_RELAXED, __HIP_MEMORY_SCOPE_AGENT); }
__device__ __forceinline__ unsigned xb_xcc_id() { return (unsigned)__builtin_amdgcn_s_getreg((3 << 11) | 20) & 0xFu; }
#define XB_SPIN(cond, bar) do { unsigned _sp = 0; while (cond) { __builtin_amdgcn_s_sleep(1); \
    if ((++_sp & 255u) == 0u) { if (xb_ld(&(bar)[XB_TMO])) break; if (_sp > XB_SPIN_CAP) { atomicAdd(&(bar)[XB_TMO], 1u); break; } } } } while (0)
struct XcdBarrier { unsigned* bar; unsigned x; volatile LAS unsigned* st; };
__device__ __forceinline__ XcdBarrier xcd_barrier_post(unsigned* bar, volatile LAS unsigned* st) {
    XcdBarrier b; b.bar = bar; b.x = xb_xcc_id(); b.st = st;
    if (threadIdx.x == 0) (void)xb_add(&bar[XB_XCNT(b.x)], 1u);
    return b;
}
__device__ __forceinline__ void xcd_barrier_complete(unsigned* bar, unsigned x, unsigned& nloc, unsigned& nx) {
    const unsigned G = gridDim.x * gridDim.y * gridDim.z;
    unsigned sum, cnt, mine, sp = 0u;
    for (;;) {
        sum = 0u; cnt = 0u; mine = 0u;
#pragma unroll
        for (unsigned j = 0; j < 16; ++j) { const unsigned c = xb_ld(&bar[XB_XCNT(j)]); sum += c; cnt += (c > 0u) ? 1u : 0u; mine = (j == x) ? c : mine; }
        if (sum == G) break;
        __builtin_amdgcn_s_sleep(1);
        if ((++sp & 255u) == 0u) { if (xb_ld(&bar[XB_TMO])) break; if (sp > XB_SPIN_CAP) { atomicAdd(&bar[XB_TMO], 1u); break; } }
    }
    nloc = mine > 0u ? mine : 1u; nx = cnt > 0u ? cnt : 1u;
}
__device__ __forceinline__ void xcd_barrier(const XcdBarrier& b) {
    asm volatile("s_waitcnt vmcnt(0)" ::: "memory");
    __syncthreads();
    if (threadIdx.x == 0) {
        unsigned* bar = b.bar;
        __builtin_amdgcn_s_waitcnt(0);
        unsigned nloc = b.st[0], nx = b.st[1];
        if (nloc == 0u) { xcd_barrier_complete(bar, b.x, nloc, nx); b.st[0] = nloc; b.st[1] = nx; }
        const unsigned old = xb_add(&bar[XB_XSUB(b.x)], 1u);
        const unsigned gen = old / nloc;
        if (old + 1u == (gen + 1u) * nloc) {
            __builtin_amdgcn_fence(__ATOMIC_RELEASE, "agent");
            asm volatile("s_waitcnt vmcnt(0)" ::: "memory");
            const unsigned og = xb_add(&bar[XB_TOP], 1u);
            const unsigned tg = og / nx;
            if (og + 1u == (tg + 1u) * nx) xb_add(&bar[XB_TOPGEN], 1u);
            else XB_SPIN(xb_ld(&bar[XB_TOPGEN]) == tg, bar);
            __builtin_amdgcn_fence(__ATOMIC_ACQUIRE, "agent");
            xb_add(&bar[XB_XGEN(b.x)], 1u);
            asm volatile("s_waitcnt vmcnt(0)" ::: "memory");
        } else {
            XB_SPIN(xb_ld(&bar[XB_XGEN(b.x)]) == gen, bar);
            __builtin_amdgcn_fence(__ATOMIC_ACQUIRE, "agent");
            asm volatile("s_waitcnt vmcnt(0)" ::: "memory");
        }
    }
    __syncthreads();
}

__device__ __forceinline__ void xcd_barrier_next(const XcdBarrier& b) {
    asm volatile("s_waitcnt vmcnt(0)" ::: "memory");
    __syncthreads();
    if (threadIdx.x == 0) {
        unsigned* bar = b.bar;
        __builtin_amdgcn_s_waitcnt(0);
        const unsigned nloc = b.st[0], nx = b.st[1];
        const unsigned old = xb_add(&bar[XB_XSUB(b.x)], 1u);
        const unsigned gen = old / nloc;
        if (old + 1u == (gen + 1u) * nloc) {
            __builtin_amdgcn_fence(__ATOMIC_RELEASE, "agent");
            asm volatile("s_waitcnt vmcnt(0)" ::: "memory");
            const unsigned og = xb_add(&bar[XB_TOP], 1u);
            const unsigned tg = og / nx;
            if (og + 1u == (tg + 1u) * nx) xb_add(&bar[XB_TOPGEN], 1u);
            else XB_SPIN(xb_ld(&bar[XB_TOPGEN]) == tg, bar);
            __builtin_amdgcn_fence(__ATOMIC_ACQUIRE, "agent");
            xb_add(&bar[XB_XGEN(b.x)], 1u);
            asm volatile("s_waitcnt vmcnt(0)" ::: "memory");
        } else {
            XB_SPIN(xb_ld(&bar[XB_XGEN(b.x)]) == gen, bar);
            __builtin_amdgcn_fence(__ATOMIC_ACQUIRE, "agent");
            asm volatile("s_waitcnt vmcnt(0)" ::: "memory");
        }
    }
    __syncthreads();
}

struct Args { const float* in[40]; float* out; unsigned char* ws; int ph_lo, ph_hi; };
constexpr int I_X = 0, I_C = 1;

__device__ __forceinline__ void p0_transpose_item(const float* W, int ldw, int src_col0, bf16* WT, int ldt, int dst_row0, int nblk, LAS float* scr, int item, int lane,
                                                  const float* scl, const float* shf, float* bias) {
    const int kb = item / nblk, nb = item % nblk, k0 = 64 * kb, n0 = 32 * nb;
    float bacc = 0.f;
    LAS float* sms = scr + 64 * 33;
    if (scl) { sms[lane] = 1.0f + scl[k0 + lane]; sms[64 + lane] = shf[k0 + lane]; asm volatile("s_waitcnt lgkmcnt(0)" ::: "memory"); }
#pragma unroll 8
    for (int i = 0; i < 32; ++i) { const int kk = 2 * i + (lane >> 5); const float wv = W[(size_t)(k0 + kk) * ldw + src_col0 + n0 + (lane & 31)];
        if (scl) { scr[kk * 33 + (lane & 31)] = wv * sms[kk]; bacc += sms[64 + kk] * wv; } else scr[kk * 33 + (lane & 31)] = wv; }
    if (scl) { bacc += __shfl_xor(bacc, 32); if (lane < 32) atomicAdd(bias + dst_row0 + n0 + lane, bacc); }
    asm volatile("s_waitcnt lgkmcnt(0)" ::: "memory");
    const int c = lane & 7;
#pragma unroll
    for (int j = 0; j < 4; ++j) { const int n = (lane >> 3) + 8 * j; const LAS float* s = scr + (8 * c) * 33 + n;
        u32x4 o; o.x = pk2(s[0 * 33], s[1 * 33]); o.y = pk2(s[2 * 33], s[3 * 33]); o.z = pk2(s[4 * 33], s[5 * 33]); o.w = pk2(s[6 * 33], s[7 * 33]);
        *(u32x4*)(WT + (size_t)(dst_row0 + n0 + n) * ldt + k0 + 8 * c) = o; }
    asm volatile("s_waitcnt lgkmcnt(0)" ::: "memory");
}
__device__ __forceinline__ void p0_convert(const float* W, int K, int ldw, int src_col0, int ncols, bf16* WT, int dst_row0, LAS float* scr, int gw, int NGW, int lane,
                                           const float* scl, const float* shf, float* bias) {
    const int nblk = ncols / 32, nitems = (K / 64) * nblk;
    for (int it = gw; it < nitems; it += NGW) p0_transpose_item(W, ldw, src_col0, WT, K, dst_row0, nblk, scr, it, lane, scl, shf, bias);
}
__device__ __forceinline__ void phase_mods(const Args& a, LAS unsigned char* lds, int G) {
    __syncthreads();
    int tid = threadIdx.x; asm volatile("" : "+v"(tid));
    const int lane = tid & 63, wave = tid >> 6;
    LAS float* cact = (LAS float*)lds; LAS float* red = (LAS float*)(lds + 16384);
    for (int i = tid; i < D; i += NTHR) { const float c = a.in[I_C][i]; cact[i] = c / (1.0f + expf(-c)); }
    __syncthreads();
    float* MOD = (float*)(a.ws + WS_MOD);
    if (blockIdx.x == 0) ((u32x4*)(a.ws + WS_CDEC + 131072))[tid] = (u32x4){0x3F803F80u, 0x3F803F80u, 0x3F803F80u, 0x3F803F80u};
    for (int item = blockIdx.x; item < 4 * 192; item += G) {
        const int l = item / 192, col = (item % 192) * 64 + lane;
        const float* Wl = l == 0 ? a.in[2] : l == 1 ? a.in[12] : l == 2 ? a.in[21] : a.in[31];
        const float* bl = l == 0 ? a.in[3] : l == 1 ? a.in[13] : l == 2 ? a.in[22] : a.in[32];
        const float* Wp = Wl + (size_t)(wave * 512) * 12288 + col; const LAS float* cp = cact + wave * 512;
        float acc = 0.f;
#pragma unroll 16
        for (int k = 0; k < 512; ++k) acc += cp[k] * Wp[(size_t)k * 12288];
        red[wave * 64 + lane] = acc;
        __syncthreads();
        if (wave == 0) { float s = 0.f;
#pragma unroll
            for (int w = 0; w < 8; ++w) s += red[w * 64 + lane];
            MOD[l * 12288 + col] = s + bl[col]; }
        __syncthreads();
    }
}
__device__ __forceinline__ void phase_weights(const Args& a, LAS unsigned char* lds, int G) {
    __syncthreads();
    int tid = threadIdx.x; asm volatile("" : "+v"(tid));
    const int lane = tid & 63, wave = tid >> 6;
    unsigned char* ws = a.ws;
    const float* MOD = (const float*)(ws + WS_MOD); float* BIAS = (float*)(ws + WS_BIAS);
    LAS float* scr = (LAS float*)(lds + wave * 16384);
    const int gw = blockIdx.x * NWAVES + wave, NGW = G * NWAVES;
#pragma unroll 1
    for (int lp = 0; lp < 2; ++lp) {
        bf16* wb = (bf16*)(ws + WS_W + (size_t)lp * W_PAIR);
        const float* w_in_e = lp ? a.in[23] : a.in[4]; const float* w_out_e = lp ? a.in[28] : a.in[9];
        const float* w_in_o = lp ? a.in[33] : a.in[14]; const float* pool_w = lp ? a.in[34] : a.in[15]; const float* w_out_o = lp ? a.in[37] : a.in[18];
        bf16* Wt_in_e = wb; bf16* Wt_out_e = (bf16*)((unsigned char*)wb + W_IN_E); bf16* Wt_in_o = (bf16*)((unsigned char*)wb + W_IN_E + W_OUT_E);
        bf16* Wt_pool = (bf16*)((unsigned char*)wb + W_IN_E + W_OUT_E + W_IN_O); bf16* Wt_out_o = (bf16*)((unsigned char*)wb + W_IN_E + W_OUT_E + W_IN_O + W_POOL);
        const float* mod_e = MOD + (2 * lp) * 12288; const float* mod_o = MOD + (2 * lp + 1) * 12288;
        p0_convert(w_in_e, D, EVEN_IN, 0, 8192, Wt_in_e, 0, scr, gw, NGW, lane, mod_e + D, mod_e, BIAS + (2 * lp) * 12288);
        p0_convert(w_in_e, D, EVEN_IN, 8200, 4096, Wt_in_e, 8192, scr, gw, NGW, lane, mod_e + D, mod_e, BIAS + (2 * lp) * 12288);
        p0_convert(w_out_e, EVEN_MIX, D, 0, D, Wt_out_e, 0, scr, gw, NGW, lane, nullptr, nullptr, nullptr);
        p0_convert(w_in_o, D, ODD_IN, 4096, 4096, Wt_in_o, 4096, scr, gw, NGW, lane, mod_o + D, mod_o, BIAS + (2 * lp + 1) * 12288);
        {
            bf16* WV = (bf16*)(ws + WS_P) + (size_t)lp * D * D;
            for (size_t i = (size_t)blockIdx.x * NTHR + tid; i < (size_t)D * D / 8; i += (size_t)G * NTHR) { const size_t k = i / 512, c8 = i % 512;
                const f32x4 a0 = *(const f32x4*)(w_in_o + k * ODD_IN + c8 * 8), a1 = *(const f32x4*)(w_in_o + k * ODD_IN + c8 * 8 + 4);
                *(u32x4*)(WV + k * D + c8 * 8) = (u32x4){pk2(a0.x, a0.y), pk2(a0.z, a0.w), pk2(a1.x, a1.y), pk2(a1.z, a1.w)}; }
        }
#pragma unroll 1
        for (int g = 0; g < 4; ++g) p0_convert(pool_w + (size_t)g * 1024 * 1024, 1024, 1024, 0, 1024, Wt_pool, g * 1024, scr, gw, NGW, lane, nullptr, nullptr, nullptr);
        p0_convert(w_out_o, D, D, 0, D, Wt_out_o, 0, scr, gw, NGW, lane, nullptr, nullptr, nullptr);
        bf16* WGB = (bf16*)(ws + WS_WG) + lp * 8 * D; float* GB = (float*)(ws + WS_WG + 262144) + lp * 8;
        for (int i = blockIdx.x * NTHR + tid; i < 8 * D; i += G * NTHR) { const int j = i / D, k = i % D; WGB[i] = (bf16)f2bf(w_in_e[(size_t)k * EVEN_IN + 8192 + j] * (1.0f + mod_e[D + k])); }
        if (gw < 8) { float acc = 0.f; for (int k = lane; k < D; k += 64) acc += mod_e[k] * w_in_e[(size_t)k * EVEN_IN + 8192 + gw]; acc = wave_sum(acc); if (lane == 0) GB[gw] = acc; }
    }
}

constexpr int RW_G1 = 0, RW_LG = 16384, RW_LB = 32768, RW_WG = 49152;
template <bool FIRST, bool SRCB, bool DSTF>
__device__ __forceinline__ void phase_rows(const void* src, const bf16* Y, const float* gate, const float* lng, const float* lnb, void* xout, bf16* xh, const bf16* wgb, const float* gb, float* GATES,
                                           LAS unsigned char* lds, int G) {
    int tid = threadIdx.x; asm volatile("" : "+v"(tid));
    const int lane = tid & 63, wave = tid >> 6;
    __syncthreads();
    if (!FIRST) { for (int i = tid; i < 1024; i += NTHR) { ((LAS f32x4*)(lds + RW_G1))[i] = ((const f32x4*)gate)[i] + 1.0f; ((LAS f32x4*)(lds + RW_LG))[i] = ((const f32x4*)lng)[i]; ((LAS f32x4*)(lds + RW_LB))[i] = ((const f32x4*)lnb)[i]; } }
    if (wgb) { for (int i = tid; i < 4096; i += NTHR) ((LAS u32x4*)(lds + RW_WG))[i] = ((const u32x4*)wgb)[i]; }
    __syncthreads();
    const int gw = blockIdx.x * NWAVES + wave, NGW = G * NWAVES;
#pragma unroll 1
    for (int m = gw; m < M; m += NGW) {
        int ln = lane; asm volatile("" : "+v"(ln));
        f32x4 v[16]; u32x2 yy[16];
        if (SRCB) { const u32x2* xr = (const u32x2*)((const bf16*)src + (size_t)m * D) + ln; u32x2 xx[16];
#pragma unroll
            for (int j = 0; j < 16; ++j) xx[j] = xr[64 * j];
            if (!FIRST) { const u32x2* yr = (const u32x2*)(Y + (size_t)m * D) + ln;
#pragma unroll
                for (int j = 0; j < 16; ++j) yy[j] = yr[64 * j]; }
#pragma unroll
            for (int j = 0; j < 16; ++j) v[j] = (f32x4){hlo(xx[j].x), hhi(xx[j].x), hlo(xx[j].y), hhi(xx[j].y)}; }
        else { const f32x4* xr = (const f32x4*)((const float*)src + (size_t)m * D) + ln;
#pragma unroll
            for (int j = 0; j < 16; ++j) v[j] = xr[64 * j];
            if (!FIRST) { const u32x2* yr = (const u32x2*)(Y + (size_t)m * D) + ln;
#pragma unroll
                for (int j = 0; j < 16; ++j) yy[j] = yr[64 * j]; } }
        if (!FIRST) {
            const LAS f32x4* g1 = (const LAS f32x4*)(lds + RW_G1) + ln; const LAS f32x4* lg = (const LAS f32x4*)(lds + RW_LG) + ln; const LAS f32x4* lb = (const LAS f32x4*)(lds + RW_LB) + ln;
            float s = 0.f;
#pragma unroll
            for (int j = 0; j < 16; ++j) { const f32x4 yv = (f32x4){bflo(yy[j].x), bfhi(yy[j].x), bflo(yy[j].y), bfhi(yy[j].y)}; v[j] = v[j] * DN_ALPHA + g1[64 * j] * yv; s += (v[j].x + v[j].y) + (v[j].z + v[j].w); }
            const float mean = wave_sum(s) * (1.f / D); float s2 = 0.f;
#pragma unroll
            for (int j = 0; j < 16; ++j) { v[j] = v[j] - mean; s2 += (v[j].x * v[j].x + v[j].y * v[j].y) + (v[j].z * v[j].z + v[j].w * v[j].w); }
            const float rstd = 1.f / sqrtf(wave_sum(s2) * (1.f / D) + LN_EPS);
#pragma unroll
            for (int j = 0; j < 16; ++j) { v[j] = v[j] * rstd * lg[64 * j] + lb[64 * j];
                if (DSTF) ((f32x4*)((float*)xout + (size_t)m * D) + ln)[64 * j] = v[j]; }
        }
        if (!DSTF) { u32x2* xo = (u32x2*)((bf16*)xout + (size_t)m * D) + ln;
#pragma unroll
            for (int j = 0; j < 16; ++j) { u32x2 o; o.x = pk2(v[j].x, v[j].y); o.y = pk2(v[j].z, v[j].w); xo[64 * j] = o; }
            if (xh) { u32x2* ho = (u32x2*)(xh + (size_t)m * D) + ln;
#pragma unroll
                for (int j = 0; j < 16; ++j) { u32x2 o; o.x = pkh(v[j].x, v[j].y); o.y = pkh(v[j].z, v[j].w); ho[64 * j] = o; } } }
        if (wgb) {
            float keep = 0.f;
#pragma unroll 1
            for (int jg = 0; jg < 8; ++jg) { float p = 0.f; const LAS u32x2* wr = (const LAS u32x2*)(lds + RW_WG) + jg * 1024 + ln;
#pragma unroll
                for (int j = 0; j < 16; ++j) { const u32x2 w = wr[64 * j]; p += (v[j].x * bflo(w.x) + v[j].y * bfhi(w.x)) + (v[j].z * bflo(w.y) + v[j].w * bfhi(w.y)); }
                p = wave_sum(p); if (lane == jg) keep = p + gb[jg]; }
            if (lane < 8) GATES[(size_t)m * 8 + lane] = keep;
        }
    }
}

constexpr int E2_BL = 0, E2_WM = 4096, E2_MP = 8192;
constexpr int E2_SQ = 16384, E2_SK = E2_SQ + 64 * 528;
constexpr int E2_VC = 16384, E2_VC_PITCH = 1544;
constexpr int E2_SS = 115712, E2_SC = 123904;
static_assert(E2_SK + 64 * 528 <= E2_SS && E2_VC + 64 * E2_VC_PITCH <= E2_SS && E2_SC + 1280 <= RING_BYTES, "E2 LDS map");

__device__ __forceinline__ void chunk_gate_sums(const float* GATES, const float* igb, const float* fgb, float* BLWM, int G) {
    int tid = threadIdx.x; asm volatile("" : "+v"(tid));
    const int lane = tid & 63, wave = tid >> 6;
    for (int pair = blockIdx.x * NWAVES + wave; pair < 1024; pair += G * NWAVES) {
        const int c = pair >> 2, h = pair & 3, m = 64 * c + lane;
        const float lf = logsigmoidf_acc(GATES[(size_t)m * 8 + 4 + h] + fgb[h]), li = GATES[(size_t)m * 8 + h] + igb[h];
        const float b = wave_incl_sum(lf, lane), gmax = wave_max(li - b), blast = __shfl(b, 63);
        if (lane == 0) { BLWM[(h * 256 + c) * 2] = blast; BLWM[(h * 256 + c) * 2 + 1] = blast + gmax; }
    }
}
__device__ __forceinline__ void e2_preamble(const float* BLWM, LAS unsigned char* lds) {
    int tid = threadIdx.x; asm volatile("" : "+v"(tid));
    LAS float* sBL = (LAS float*)(lds + E2_BL); LAS float* sWM = (LAS float*)(lds + E2_WM); LAS float* sMP = (LAS float*)(lds + E2_MP);
    __syncthreads();
    for (int i = tid; i < 1024; i += NTHR) { const f32x2 v = *(const f32x2*)(BLWM + 2 * i); sBL[i] = v.x; sWM[i] = v.y; }
    __syncthreads();
    if (tid < 256) { const int hh = tid >> 6, ln = tid & 63;
        float av[4], bv[4];
#pragma unroll
        for (int i = 0; i < 4; ++i) { av[i] = sBL[hh * 256 + 4 * ln + i]; bv[i] = sWM[hh * 256 + 4 * ln + i]; }
        float A = av[0], B = bv[0];
#pragma unroll
        for (int i = 1; i < 4; ++i) { B = fmaxf(B + av[i], bv[i]); A += av[i]; }
#pragma unroll
        for (int o = 1; o < 64; o <<= 1) { const float Ap = __shfl_up(A, o), Bp = __shfl_up(B, o); if (ln >= o) { B = fmaxf(Bp + A, B); A = Ap + A; } }
        const float Ae = __shfl_up(A, 1), Be = __shfl_up(B, 1);
        float mm = ln ? fmaxf(0.f + Ae, Be) : 0.f;
#pragma unroll
        for (int i = 0; i < 4; ++i) { sMP[hh * 256 + 4 * ln + i] = mm; mm = fmaxf(av[i] + mm, bv[i]); } }
    __syncthreads();
}
__device__ __forceinline__ void e2_prep_item(int c, int h, const bf16* P, const float* conv_w, const float* GATES, const float* igb, const float* fgb,
                                             bf16* QC, bf16* KCT, bf16* SB, bf16* VT, bf16* VBT, bf16* QB2, bf16* KB2, float* WINTER, float* EMT, float* CDEC, LAS unsigned char* lds) {
    int tid = threadIdx.x; asm volatile("" : "+v"(tid));
    const int lane = tid & 63, wave = tid >> 6;
    LAS float* sMP = (LAS float*)(lds + E2_MP);
    LAS float* sb = (LAS float*)(lds + E2_SC); LAS float* sli = sb + 64; LAS float* smt = sb + 128; LAS float* sws = sb + 192;
    LAS unsigned char* sq = lds + E2_SQ; LAS unsigned char* sk = lds + E2_SK; LAS unsigned char* sS = lds + E2_SS; LAS unsigned char* sVc = lds + E2_VC;
    const int item = c * 4 + h;
    u32x4 vreg[12];
#pragma unroll
    for (int i = 0; i < 12; ++i) { const int idx = tid + NTHR * i, s = idx / 96, p = idx % 96;
        vreg[i] = *(const u32x4*)(P + (size_t)(64 * c + s) * EVEN_N + (p < 64 ? 2048 + h * 512 + p * 8 : 10240 + h * 256 + (p - 64) * 8)); }
    __syncthreads();
    if (wave == 0) {
        const int m = 64 * c + lane;
        const float lf = logsigmoidf_acc(GATES[(size_t)m * 8 + 4 + h] + fgb[h]), li = GATES[(size_t)m * 8 + h] + igb[h];
        const float b = wave_incl_sum(lf, lane), g = li - b, pm = wave_incl_max(g, lane), gmax = __shfl(pm, 63), blast = __shfl(b, 63);
        const float mprev = sMP[h * 256 + c];
        const float mt = fmaxf(b + mprev, b + pm);
        const float mnew = fmaxf(blast + mprev, blast + gmax);
        sb[lane] = b; sli[lane] = li; smt[lane] = mt; sws[lane] = expf(blast + g - mnew);
        sb[256 + lane] = expf(b + mprev - mt);
        EMT[(size_t)m * 4 + h] = expf(-mt);
        if (lane == 0) CDEC[c * 4 + h] = expf(blast + mprev - mnew);
    }
    __syncthreads();
    {
        const int d2 = tid & 127, tq = tid >> 7;
        const int dk = 2 * d2, r5 = dk & 31, pos = (dk & ~31) + 8 * ((r5 >> 2) & 3) + 4 * (r5 >> 4) + (r5 & 3);
        unsigned xw[2][19]; float cw0[2][4], cw1[2][4];
#pragma unroll
        for (int part = 0; part < 2; ++part) { const int col = part * 1024 + h * 256 + 2 * d2;
#pragma unroll
            for (int j = 0; j < 19; ++j) { const int mr = 64 * c + 16 * tq - 3 + j; xw[part][j] = (mr >= 0) ? *(const unsigned*)(P + (size_t)(mr >= 0 ? mr : 0) * EVEN_N + col) : 0u; }
#pragma unroll
            for (int j = 0; j < 4; ++j) { cw0[part][j] = conv_w[j * 2048 + col]; cw1[part][j] = conv_w[j * 2048 + col + 1]; } }
#pragma unroll
        for (int part = 0; part < 2; ++part) {
            unsigned kw0[8], kw1[8]; float p0 = 0.f, p1 = 0.f;
#pragma unroll
            for (int tt = 0; tt < 16; ++tt) {
                const int t = 16 * tq + tt, mr = 64 * c + t;
                float y0 = 0.f, y1 = 0.f;
#pragma unroll
                for (int j = 0; j < 4; ++j) { const unsigned w = xw[part][tt + j]; y0 += cw0[part][j] * bflo(w); y1 += cw1[part][j] * bfhi(w); }
                y0 = y0 * pg8::sigmoidf_fast(y0); y1 = y1 * pg8::sigmoidf_fast(y1);
                if (part == 0) { const float wq = sb[256 + t] * 0.0625f; *(LAS unsigned*)(sq + t * 528 + d2 * 4) = pk2(y0 * 0.0625f, y1 * 0.0625f); *(unsigned*)(QC + (size_t)mr * 1024 + h * 256 + pos) = pk2(y0 * wq, y1 * wq); }
                else { const float wsv = sws[t]; *(LAS unsigned*)(sk + t * 528 + d2 * 4) = pk2(y0, y1);
                    const float s0 = y0 * wsv, s1 = y1 * wsv;
                    if (tt & 1) { kw0[tt >> 1] = pk2(p0, s0); kw1[tt >> 1] = pk2(p1, s1); } else { p0 = s0; p1 = s1; } }
            }
            if (part == 1) { bf16* kr = KCT + (size_t)item * 16384 + (size_t)dk * 64 + 16 * tq;
                *(u32x4*)(kr) = (u32x4){kw0[0], kw0[1], kw0[2], kw0[3]}; *(u32x4*)(kr + 8) = (u32x4){kw0[4], kw0[5], kw0[6], kw0[7]};
                *(u32x4*)(kr + 64) = (u32x4){kw1[0], kw1[1], kw1[2], kw1[3]}; *(u32x4*)(kr + 72) = (u32x4){kw1[4], kw1[5], kw1[6], kw1[7]}; }
        }
    }
    __syncthreads();
    {
        const int wv = __builtin_amdgcn_readfirstlane(tid >> 6), ta = wv & 3, wh = wv >> 2, fr = lane & 15, fq = lane >> 4;
        f32x4 z0 = (f32x4){0.f, 0.f, 0.f, 0.f}, z1 = z0;
#pragma unroll
        for (int kk = 0; kk < 8; ++kk) { const bf16x8 af = *(const LAS bf16x8*)(sq + (16 * ta + fr) * 528 + (32 * kk + 8 * fq) * 2);
            const bf16x8 b0 = *(const LAS bf16x8*)(sk + (32 * wh + fr) * 528 + (32 * kk + 8 * fq) * 2), b1 = *(const LAS bf16x8*)(sk + (32 * wh + 16 + fr) * 528 + (32 * kk + 8 * fq) * 2);
            z0 = __builtin_amdgcn_mfma_f32_16x16x32_bf16(af, b0, z0, 0, 0, 0); z1 = __builtin_amdgcn_mfma_f32_16x16x32_bf16(af, b1, z1, 0, 0, 0); }
        const int s0 = 32 * wh + fr, s1 = s0 + 16; const float e0 = sli[s0] - sb[s0], e1 = sli[s1] - sb[s1];
#pragma unroll
        for (int r = 0; r < 4; ++r) { const int t = 16 * ta + 4 * fq + r; const float bm = sb[t] - smt[t];
            const float w0 = (s0 <= t) ? expf(bm + e0) : 0.f, w1 = (s1 <= t) ? expf(bm + e1) : 0.f;
            *(LAS unsigned short*)(sS + (t * 64 + s0) * 2) = (unsigned short)f2bf(z0[r] * w0); *(LAS unsigned short*)(sS + (t * 64 + s1) * 2) = (unsigned short)f2bf(z1[r] * w1); }
    }
    __syncthreads();
    *(u32x4*)(SB + (size_t)item * 4096 + tid * 8) = *(const LAS u32x4*)(sS + tid * 16);
#pragma unroll
    for (int i = 0; i < 12; ++i) { const int idx = tid + NTHR * i, s = idx / 96, p = idx % 96; LAS unsigned char* d = sVc + s * E2_VC_PITCH + p * 16;
        *(LAS u32x2*)d = (u32x2){vreg[i].x, vreg[i].y}; *(LAS u32x2*)(d + 8) = (u32x2){vreg[i].z, vreg[i].w}; }
    __syncthreads();
    {
        const int cp = lane >> 3, pc = lane & 7;
#pragma unroll
        for (int rd = 0; rd < 6; ++rd) {
            const int R = wave * 6 + rd, v0 = 16 * R + 2 * cp;
            unsigned x[8];
#pragma unroll
            for (int j = 0; j < 8; ++j) x[j] = *(const LAS unsigned*)(sVc + (8 * pc + j) * E2_VC_PITCH + v0 * 2);
            const u32x4 lo = (u32x4){__builtin_amdgcn_perm(x[1], x[0], 0x05040100u), __builtin_amdgcn_perm(x[3], x[2], 0x05040100u), __builtin_amdgcn_perm(x[5], x[4], 0x05040100u), __builtin_amdgcn_perm(x[7], x[6], 0x05040100u)};
            const u32x4 hi = (u32x4){__builtin_amdgcn_perm(x[1], x[0], 0x07060302u), __builtin_amdgcn_perm(x[3], x[2], 0x07060302u), __builtin_amdgcn_perm(x[5], x[4], 0x07060302u), __builtin_amdgcn_perm(x[7], x[6], 0x07060302u)};
            bf16* dst;
            if (R < 32) dst = VT + (size_t)item * 32768 + (size_t)v0 * 64 + 8 * pc;
            else { const int vb = v0 - 512; dst = VBT + ((size_t)(c * 8 + 2 * h + (vb >> 7)) * 128 + (vb & 127)) * 64 + 8 * pc; }
            *(u32x4*)dst = lo; *(u32x4*)(dst + 64) = hi;
        }
    }
}

constexpr int AT_Q = 0, AT_K = AT_Q + 64 * 272, AT_VT = AT_K + 64 * 272, AT_Z = AT_VT + 128 * 144, AT_W = AT_Z + 64 * 272, AT_MIN = AT_W + 64 * 144, AT_O = 0;
static_assert(AT_MIN + 64 <= RING_BYTES && 64 * 528 <= AT_VT, "attention LDS map");
#define AT_BAR() do { asm volatile("s_waitcnt lgkmcnt(0)" ::: "memory"); __builtin_amdgcn_s_barrier(); asm volatile("" ::: "memory"); } while (0)
__device__ __forceinline__ void e3_attn_item(int hb, int qt, const bf16* P, const bf16* QB2, const bf16* KB2, const bf16* VBT, bf16* MIX, LAS unsigned char* lds) {
    int tid = threadIdx.x; asm volatile("" : "+v"(tid));
    const int lane = tid & 63, wave = __builtin_amdgcn_readfirstlane(tid >> 6), fr = lane & 15, fq = lane >> 4;
    LAS unsigned char* sQ = lds + AT_Q; LAS unsigned char* sK = lds + AT_K; LAS unsigned char* sVT = lds + AT_VT; LAS unsigned char* sW = lds + AT_W;
    LAS float* sZ = (LAS float*)(lds + AT_Z); LAS float* sMin = (LAS float*)(lds + AT_MIN); LAS float* sO = (LAS float*)(lds + AT_O);
    const int q0 = qt * 64, t = tid >> 3, sg = tid & 7;
    const int ta = wave & 3, wh = wave >> 2;
    u32x4 rk[2], rv[2];
#pragma unroll
    for (int i = 0; i < 2; ++i) { const int idx = tid + NTHR * i; rk[i] = *(const u32x4*)(P + (size_t)(64 * qt + (idx >> 4)) * EVEN_N + 9216 + hb * 128 + (idx & 15) * 8); rv[i] = *(const u32x4*)(VBT + (size_t)(qt * 8 + hb) * 8192 + idx * 8); }
    __syncthreads();
#pragma unroll
    for (int i = 0; i < 2; ++i) { const int idx = tid + NTHR * i, row = idx >> 4, p = idx & 15;
        *(LAS u32x4*)(sQ + row * 272 + p * 16) = *(const u32x4*)(P + (size_t)(64 * qt + row) * EVEN_N + 8192 + hb * 128 + p * 8); }
    float R = 0.f; f32x4 acc[4];
#pragma unroll
    for (int e = 0; e < 4; ++e) acc[e] = (f32x4){0.f, 0.f, 0.f, 0.f};
    for (int kb = qt; kb >= 0; --kb) {
        const int k0 = kb * 64;
        AT_BAR();
#pragma unroll
        for (int i = 0; i < 2; ++i) { const int idx = tid + NTHR * i;
            *(LAS u32x4*)(sK + (idx >> 4) * 272 + (idx & 15) * 16) = rk[i];
            *(LAS u32x4*)(sVT + (idx >> 3) * 144 + (idx & 7) * 16) = rv[i]; }
        { const int kn = kb > 0 ? kb - 1 : 0;
#pragma unroll
            for (int i = 0; i < 2; ++i) { const int idx = tid + NTHR * i; rk[i] = *(const u32x4*)(P + (size_t)(64 * kn + (idx >> 4)) * EVEN_N + 9216 + hb * 128 + (idx & 15) * 8); rv[i] = *(const u32x4*)(VBT + (size_t)(kn * 8 + hb) * 8192 + idx * 8); } }
        AT_BAR();
        {
            f32x4 z0 = (f32x4){0.f, 0.f, 0.f, 0.f}, z1 = z0;
#pragma unroll
            for (int kk = 0; kk < 4; ++kk) { const bf16x8 af = *(const LAS bf16x8*)(sQ + (16 * ta + fr) * 272 + (32 * kk + 8 * fq) * 2);
                const bf16x8 b0 = *(const LAS bf16x8*)(sK + (32 * wh + fr) * 272 + (32 * kk + 8 * fq) * 2), b1 = *(const LAS bf16x8*)(sK + (32 * wh + 16 + fr) * 272 + (32 * kk + 8 * fq) * 2);
                z0 = __builtin_amdgcn_mfma_f32_16x16x32_bf16(af, b0, z0, 0, 0, 0); z1 = __builtin_amdgcn_mfma_f32_16x16x32_bf16(af, b1, z1, 0, 0, 0); }
#pragma unroll
            for (int r = 0; r < 4; ++r) { sZ[(16 * ta + 4 * fq + r) * 68 + 32 * wh + fr] = z0[r]; sZ[(16 * ta + 4 * fq + r) * 68 + 32 * wh + 16 + fr] = z1[r]; }
        }
        AT_BAR();
        {
            const f32x4 za = *(const LAS f32x4*)(sZ + t * 68 + 8 * sg), zb = *(const LAS f32x4*)(sZ + t * 68 + 8 * sg + 4);
            const float z[8] = {za.x, za.y, za.z, za.w, zb.x, zb.y, zb.z, zb.w};
            float sp[8], tot = 0.f;
#pragma unroll
            for (int i = 0; i < 8; ++i) { const bool ok = (k0 + 8 * sg + i) < (q0 + t); sp[i] = ok ? softplusf_fast(z[i]) : 0.f; tot += sp[i]; }
            float v = tot;
#pragma unroll
            for (int o = 1; o < 8; o <<= 1) { const float u = __shfl_down(v, o, 8); if (sg + o < 8) v += u; }
            const float rowtot = __shfl(v, 0, 8);
            float suf = R + (v - tot);
            float w[8];
#pragma unroll
            for (int i = 7; i >= 0; --i) { const bool ok = (k0 + 8 * sg + i) < (q0 + t); w[i] = ok ? __expf(z[i] - sp[i] - suf) : 0.f; suf += sp[i]; }
            *(LAS u32x4*)(sW + t * 144 + sg * 16) = (u32x4){pk2(w[0], w[1]), pk2(w[2], w[3]), pk2(w[4], w[5]), pk2(w[6], w[7])};
            R += rowtot;
            const float mn = wave_min(R);
            if (lane == 0) sMin[wave] = mn;
        }
        AT_BAR();
        {
#pragma unroll
            for (int kk = 0; kk < 2; ++kk) { const bf16x8 af = *(const LAS bf16x8*)(sW + (16 * ta + fr) * 144 + (32 * kk + 8 * fq) * 2);
#pragma unroll
                for (int e = 0; e < 4; ++e) { const bf16x8 bfr = *(const LAS bf16x8*)(sVT + (16 * (4 * wh + e) + fr) * 144 + (32 * kk + 8 * fq) * 2);
                    acc[e] = __builtin_amdgcn_mfma_f32_16x16x32_bf16(af, bfr, acc[e], 0, 0, 0); } }
        }
        float mn = sMin[0];
#pragma unroll
        for (int w = 1; w < 8; ++w) mn = fminf(mn, sMin[w]);
        if (mn > SB_EXIT) break;
    }
    __syncthreads();
#pragma unroll
    for (int e = 0; e < 4; ++e)
#pragma unroll
        for (int r = 0; r < 4; ++r) sO[(16 * ta + 4 * fq + r) * 132 + 16 * (4 * wh + e) + fr] = acc[e][r];
    __syncthreads();
    {
        const size_t m = (size_t)(q0 + t);
#pragma unroll
        for (int half = 0; half < 2; ++half) { const int d0 = 64 * half + 8 * sg;
            const f32x4 oa = *(const LAS f32x4*)(sO + t * 132 + d0), ob = *(const LAS f32x4*)(sO + t * 132 + d0 + 4);
            float zf[8]; unpack8(*(const u32x4*)(P + m * EVEN_N + 11264 + hb * 128 + d0), zf);
            u32x4 o; o.x = pk2(oa.x * zf[0], oa.y * zf[1]); o.y = pk2(oa.z * zf[2], oa.w * zf[3]); o.z = pk2(ob.x * zf[4], ob.y * zf[5]); o.w = pk2(ob.z * zf[6], ob.w * zf[7]);
            *(u32x4*)(MIX + m * EVEN_MIX + 2048 + hb * 128 + d0) = o; }
    }
}

#define SC_BAR() do { asm volatile("s_waitcnt lgkmcnt(0)" ::: "memory"); __builtin_amdgcn_s_barrier(); asm volatile("" ::: "memory"); } while (0)
constexpr int SC_SLICES = 8, SC_ITEMS = 4 * (SC_SLICES + 1) * 2;
constexpr int SC_SQ = 0, SC_SS = 16384, SC_SWI = 24576, SC_SVT = 25088, SC_SKT = 33280, SC_SET = 49664;
constexpr int SC_NSET = 3, SC_PUB = 32;
static_assert(SC_NSET * SC_SET <= RING_BYTES, "scan LDS map");
__device__ __forceinline__ void e3_scan_item(int h, int sl, int half, const bf16* QC, const bf16* KCT, const bf16* SB, const bf16* VT, const float* WINTER, const float* CDEC,
                                             float* NUM, float* DENR, const bf16* ONES, unsigned* prog, LAS unsigned char* lds) {
    int tid = threadIdx.x; asm volatile("" : "+v"(tid));
    const int lane = tid & 63, wave = __builtin_amdgcn_readfirstlane(tid >> 6), fr = lane & 15, fq = lane >> 4;
    const bool ones = (sl == SC_SLICES);
    __syncthreads();
    if (wave >= 4) {
        const int wl = wave - 4, rr = lane >> 2, q = (lane & 3) ^ ((rr & 8) ? 2 : 0);
        const unsigned offQ = (unsigned)(rr * 1024 + q * 8) * 2u, off64 = (unsigned)(rr * 64 + q * 8) * 2u;
        const char* gQ = (const char*)(QC + (size_t)(16 * wl) * 1024 + h * 256 + 128 * half) + offQ;
        const char* gK = (const char*)(KCT + (size_t)h * 16384 + (size_t)(128 * half + 32 * wl) * 64) + off64;
        const char* gS = (const char*)(SB + (size_t)h * 4096 + (size_t)(16 * (2 * half + (wl >> 1))) * 64) + off64 + (wl & 1) * 64;
        const int vrow = 32 * (wl >> 1) + 8 * (rr >> 2) + 4 * (wl & 1) + (rr & 3);
        const char* gV = (ones ? (const char*)ONES + (size_t)(16 * wl) * 128 + off64 : (const char*)(VT + (size_t)h * 32768 + (size_t)(64 * sl) * 64) + (size_t)vrow * 128 + (size_t)(q * 16));
        const float* gC = CDEC + h;
#define SC_DMA16(src, dstoff) __builtin_amdgcn_global_load_lds((const unsigned*)(src), (LAS unsigned*)(lds + (dstoff)), 16, 0, 0)
#define SC_DMA4(src, dstoff) __builtin_amdgcn_global_load_lds((const unsigned*)(src), (LAS unsigned*)(lds + (dstoff)), 4, 0, 0)
#define SC_DMA(cc, setoff) do { const int _c = (cc) < 255 ? (cc) : 255; const int _so = (setoff); \
            _Pragma("unroll") for (int kt = 0; kt < 4; ++kt) SC_DMA16(gQ + (size_t)_c * 131072 + kt * 64, _so + SC_SQ + (wl * 4 + kt) * 1024); \
            _Pragma("unroll") for (int j = 0; j < 4; ++j) SC_DMA16(gK + (size_t)_c * 131072 + (j >> 1) * 2048 + (j & 1) * 64, _so + SC_SKT + ((2 * wl + (j >> 1)) * 2 + (j & 1)) * 1024); \
            SC_DMA16(gS + (size_t)_c * 32768, _so + SC_SS + wl * 1024); \
            _Pragma("unroll") for (int k2 = 0; k2 < 2; ++k2) SC_DMA16(gV + (ones ? (size_t)0 : (size_t)_c * 262144) + k2 * 64, _so + SC_SVT + (wl * 2 + k2) * 1024); \
            SC_DMA4(gC + _c * 4, _so + SC_SWI + 256); } while (0)
        SC_DMA(0, 0); SC_DMA(1, SC_SET);
        asm volatile("s_waitcnt vmcnt(12)" ::: "memory");
        int so2 = 2 * SC_SET;
        for (int c = 0; c < 256; ++c) {
            SC_BAR();
            SC_DMA(c + 2, so2);
            asm volatile("s_waitcnt vmcnt(12)" ::: "memory");
            so2 = (so2 == 2 * SC_SET) ? 0 : so2 + SC_SET;
        }
        asm volatile("s_waitcnt vmcnt(0)" ::: "memory");
        SC_BAR();
#undef SC_DMA16
#undef SC_DMA4
#undef SC_DMA
    } else if (wave < 2) {
        f32x4 C[2][8];
#pragma unroll
        for (int u = 0; u < 2; ++u)
#pragma unroll
            for (int i = 0; i < 8; ++i) C[u][i] = (f32x4){0.f, 0.f, 0.f, 0.f};
        const int lo = fr * 64 + ((fq ^ ((fr >> 3) << 1)) * 16);
        int sco = 0;
        bf16* NUMh = (bf16*)NUM + (size_t)half * ((size_t)M * 2048); float* DENRh = DENR + (size_t)half * ((size_t)M * 4);
        __builtin_amdgcn_s_setprio(2);
        for (int c = 0; c < 256; ++c) {
            if (c > 0 && (c & (SC_PUB - 1)) == 0) asm volatile("s_waitcnt vmcnt(0)" ::: "memory");
            SC_BAR();
            const LAS unsigned char* sb_ = lds + sco; sco = (sco == 2 * SC_SET) ? 0 : sco + SC_SET;
            const LAS unsigned char* qbase = sb_ + SC_SQ + lo; const LAS unsigned char* sbase = sb_ + SC_SS + lo; const LAS unsigned char* kbase = sb_ + SC_SKT + lo;
            const LAS float* sWI = (const LAS float*)(sb_ + SC_SWI);
#define SC_LD4(F, base, s1) do { _Pragma("unroll") for (int _j = 0; _j < 4; ++_j) F[_j] = *(const LAS bf16x8*)((base) + _j * (s1)); } while (0)
#define SC_SB __builtin_amdgcn_sched_barrier(0)
#define SC_USE4(F) asm volatile("" :: "v"(F[0]), "v"(F[1]), "v"(F[2]), "v"(F[3]))
#define SC_CVT(dst, t) do { _Pragma("unroll") for (int _u = 0; _u < 2; ++_u) { \
                const u32x4 _w = (u32x4){pk2n(C[_u][t][0], C[_u][t][1]), pk2n(C[_u][t][2], C[_u][t][3]), pk2n(C[_u][(t) + 1][0], C[_u][(t) + 1][1]), pk2n(C[_u][(t) + 1][2], C[_u][(t) + 1][3])}; dst[_u] = __builtin_bit_cast(bf16x8, _w); } } while (0)
#define SC_INTER(cbv, F) do { _Pragma("unroll") for (int _u = 0; _u < 2; ++_u) _Pragma("unroll") for (int _a = 0; _a < 4; ++_a) o[_u][_a] = __builtin_amdgcn_mfma_f32_16x16x32_bf16(cbv[_u], F[_a], o[_u][_a], 0, 0, 0); } while (0)
#define SC_SCALE(t) do { _Pragma("unroll") for (int _u = 0; _u < 2; ++_u) { C[_u][t] = C[_u][t] * cdec; C[_u][(t) + 1] = C[_u][(t) + 1] * cdec; asm volatile("" : "+v"(C[_u][t]), "+v"(C[_u][(t) + 1])); } } while (0)
#define SC_MIX(nv) do { _Pragma("unroll") for (int _g = 0; _g < 8; ++_g) { __builtin_amdgcn_sched_group_barrier(0x008, 1, 0); __builtin_amdgcn_sched_group_barrier(0x002, nv, 0); } } while (0)
#define SC_UPD(F, b, k) do { _Pragma("unroll") for (int _i = 0; _i < 4; ++_i) _Pragma("unroll") for (int _u = 0; _u < 2; ++_u) \
                C[_u][4 * (b) + _i] = __builtin_amdgcn_mfma_f32_16x16x32_bf16(F[_i], v[_u][k], C[_u][4 * (b) + _i], 0, 0, 0); } while (0)
            {
                bf16x8 v[2][2], F0[4], F1[4], cba[2], cbb[2]; f32x4 o[2][4];
                const float cdec = sWI[64];
#pragma unroll
                for (int u = 0; u < 2; ++u)
#pragma unroll
                    for (int a = 0; a < 4; ++a) o[u][a] = (f32x4){0.f, 0.f, 0.f, 0.f};
                SC_LD4(F0, qbase, 4096);
                SC_CVT(cba, 0);
                SC_SB;
                SC_USE4(F0); SC_SB; SC_LD4(F1, qbase + 1024, 4096);
#pragma unroll
                for (int u = 0; u < 2; ++u)
#pragma unroll
                    for (int k2 = 0; k2 < 2; ++k2) v[u][k2] = *(const LAS bf16x8*)(sb_ + SC_SVT + (2 * (2 * wave + u) + k2) * 1024 + lo);
                SC_SB; SC_INTER(cba, F0); SC_CVT(cbb, 2); SC_SCALE(0); SC_MIX(2); SC_SB;
                SC_USE4(F1); SC_SB; SC_LD4(F0, qbase + 2048, 4096); SC_SB; SC_INTER(cbb, F1); SC_CVT(cba, 4); SC_SCALE(2); SC_MIX(2); SC_SB;
                SC_USE4(F0); SC_SB; SC_LD4(F1, qbase + 3072, 4096); SC_SB; SC_INTER(cba, F0); SC_CVT(cbb, 6); SC_SCALE(4); SC_MIX(2); SC_SB;
                SC_USE4(F1); SC_SB; SC_LD4(F0, sbase, 1024); SC_SB; SC_INTER(cbb, F1); SC_SCALE(6); SC_MIX(1); SC_SB;
                SC_USE4(F0); SC_SB; SC_LD4(F1, kbase, 2048); SC_SB;
                if (half == 0) {
#pragma unroll
                    for (int k2 = 0; k2 < 2; ++k2)
#pragma unroll
                        for (int a = 0; a < 2; ++a)
#pragma unroll
                            for (int u = 0; u < 2; ++u) o[u][a] = __builtin_amdgcn_mfma_f32_16x16x32_bf16(v[u][k2], F0[a * 2 + k2], o[u][a], 0, 0, 0);
                } else {
#pragma unroll
                    for (int k2 = 0; k2 < 2; ++k2)
#pragma unroll
                        for (int a = 0; a < 2; ++a)
#pragma unroll
                            for (int u = 0; u < 2; ++u) o[u][2 + a] = __builtin_amdgcn_mfma_f32_16x16x32_bf16(v[u][k2], F0[a * 2 + k2], o[u][2 + a], 0, 0, 0);
                }
                SC_SB;
                SC_USE4(F1); SC_SB; SC_LD4(F0, kbase + 1024, 2048); SC_SB;
                if (!ones) {
                    SC_UPD(F1, 0, 0);
#pragma unroll
                    for (int a = 0; a < 4; ++a) { const size_t mrow = (size_t)(64 * c + 16 * a + fr);
                        *(u32x4*)(NUMh + mrow * 2048 + h * 512 + 64 * sl + 32 * wave + 8 * fq) = (u32x4){pk2n(o[0][a][0], o[0][a][1]), pk2n(o[0][a][2], o[0][a][3]), pk2n(o[1][a][0], o[1][a][1]), pk2n(o[1][a][2], o[1][a][3])}; }
                    SC_MIX(2);
                } else {
                    SC_UPD(F1, 0, 0);
#pragma unroll
                    for (int a = 0; a < 4; ++a) { const size_t mrow = (size_t)(64 * c + 16 * a + fr); if (wave == 0 && fq == 0) DENRh[mrow * 4 + h] = o[0][a][0]; }
                }
                SC_SB;
                SC_USE4(F0); SC_SB; SC_LD4(F1, kbase + 8192, 2048); SC_SB; SC_UPD(F0, 0, 1); SC_SB;
                SC_USE4(F1); SC_SB; SC_LD4(F0, kbase + 8192 + 1024, 2048); SC_SB; SC_UPD(F1, 1, 0); SC_SB;
                SC_UPD(F0, 1, 1); SC_SB;
            }
#undef SC_LD4
#undef SC_SB
#undef SC_USE4
#undef SC_INTER
#undef SC_CVT
#undef SC_SCALE
#undef SC_MIX
#undef SC_UPD
        }
        __builtin_amdgcn_s_setprio(0);
        asm volatile("s_waitcnt vmcnt(0)" ::: "memory");
        SC_BAR();
    } else {
        for (int c = 0; c <= 256; ++c) {
            SC_BAR();
            if (wave == 2 && c > 0 && (c & (SC_PUB - 1)) == 0) {
                __builtin_amdgcn_fence(__ATOMIC_RELEASE, "agent");
                asm volatile("s_waitcnt vmcnt(0)" ::: "memory");
                if (lane == 0) __hip_atomic_store(prog, (unsigned)c, __ATOMIC_RELAXED, __HIP_MEMORY_SCOPE_AGENT);
            }
        }
    }
}

__device__ __forceinline__ void e4_step(int it0, int stride, const float* NUM, const float* DENR, const float* EMT, const bf16* P, const float* hnw, bf16* MIX, int lane) {
    u32x4 ra[2], rb[2], ro[2], rz[2]; float dn[2], em[2]; f32x4 w0[2], w1[2];
#pragma unroll
    for (int q = 0; q < 2; ++q) { const int it = it0 + q * stride < M * 4 ? it0 + q * stride : it0; const int m = it >> 2, h = it & 3;
        const bf16* NB0 = (const bf16*)NUM + (size_t)m * 2048 + h * 512 + lane * 8;
        ra[q] = *(const u32x4*)NB0; rb[q] = *(const u32x4*)(NB0 + (size_t)M * 2048);
        ro[q] = *(const u32x4*)(P + (size_t)m * EVEN_N + 4096 + h * 512 + lane * 8); rz[q] = *(const u32x4*)(P + (size_t)m * EVEN_N + 6144 + h * 512 + lane * 8);
        dn[q] = DENR[(size_t)m * 4 + h] + DENR[(size_t)M * 4 + (size_t)m * 4 + h]; em[q] = EMT[(size_t)m * 4 + h];
        w0[q] = *(const f32x4*)(hnw + h * 512 + lane * 8); w1[q] = *(const f32x4*)(hnw + h * 512 + lane * 8 + 4); }
#pragma unroll
    for (int q = 0; q < 2; ++q) { const int it = it0 + q * stride; if (it >= M * 4) break; const int m = it >> 2, h = it & 3;
        float na[8], nb[8], og[8], zg[8]; unpack8(ra[q], na); unpack8(rb[q], nb); unpack8(ro[q], og); unpack8(rz[q], zg);
        const float rd = 1.0f / fmaxf(fabsf(dn[q]), em[q]);
        float v[8]; float s = 0.f;
#pragma unroll
        for (int e = 0; e < 8; ++e) { v[e] = (na[e] + nb[e]) * rd * og[e]; s += v[e]; }
        const float mean = wave_sum(s) * (1.f / 512.f); float s2 = 0.f;
#pragma unroll
        for (int e = 0; e < 8; ++e) { v[e] -= mean; s2 += v[e] * v[e]; }
        const float rstd = 1.f / sqrtf(wave_sum(s2) * (1.f / 512.f) + LN_EPS);
        const float wv[8] = {w0[q].x, w0[q].y, w0[q].z, w0[q].w, w1[q].x, w1[q].y, w1[q].z, w1[q].w};
#pragma unroll
        for (int e = 0; e < 8; ++e) v[e] = v[e] * rstd * wv[e] * zg[e];
        u32x4 o; o.x = pk2(v[0], v[1]); o.y = pk2(v[2], v[3]); o.z = pk2(v[4], v[5]); o.w = pk2(v[6], v[7]);
        *(u32x4*)(MIX + (size_t)m * EVEN_MIX + h * 512 + lane * 8) = o; }
}
__device__ __forceinline__ void phase_e4(const float* NUM, const float* DENR, const float* EMT, const bf16* P, const float* hnw, bf16* MIX, int G) {
    int tid = threadIdx.x; asm volatile("" : "+v"(tid));
    const int lane = tid & 63, wave = tid >> 6;
    const int gw = blockIdx.x * NWAVES + wave, NGW = G * NWAVES;
    for (int it0 = gw; it0 < M * 4; it0 += 2 * NGW) e4_step(it0, NGW, NUM, DENR, EMT, P, hnw, MIX, lane);
}
__device__ __forceinline__ void e4_fused(int bq, int nb, const unsigned* prog, const float* NUM, const float* DENR, const float* EMT, const bf16* P, const float* hnw, bf16* MIX, LAS unsigned char* lds) {
    int tid = threadIdx.x; asm volatile("" : "+v"(tid));
    const int lane = tid & 63, wave = __builtin_amdgcn_readfirstlane(tid >> 6);
    const int NGW = nb * NWAVES;
    volatile LAS unsigned* sHave = (volatile LAS unsigned*)(lds + MISC_OFF) + 16;
    unsigned have = 0u;
    for (int base = bq * NWAVES; base < M * 4; base += 2 * NGW) {
        int last = base + NWAVES - 1 + NGW; last = last < M * 4 ? last : M * 4 - 1;
        const unsigned need = (unsigned)((last >> 2) >> 6) + 1u;
        if (have < need) {
            __syncthreads();
            if (wave == 0) {
                unsigned mn, sp = 0u;
                for (;;) {
                    unsigned a0 = __hip_atomic_load(prog + lane, __ATOMIC_RELAXED, __HIP_MEMORY_SCOPE_AGENT);
                    unsigned a1 = (lane < SC_ITEMS - 64) ? __hip_atomic_load(prog + 64 + lane, __ATOMIC_RELAXED, __HIP_MEMORY_SCOPE_AGENT) : 256u;
                    a0 = a0 < a1 ? a0 : a1;
#pragma unroll
                    for (int o = 32; o >= 1; o >>= 1) { const unsigned u = (unsigned)__shfl_xor((int)a0, o); a0 = a0 < u ? a0 : u; }
                    mn = a0;
                    if (mn >= need || ++sp > (1u << 16)) break;
                    __builtin_amdgcn_s_sleep(64);
                }
                __builtin_amdgcn_fence(__ATOMIC_ACQUIRE, "agent");
                asm volatile("s_waitcnt vmcnt(0)" ::: "memory");
                if (lane == 0) sHave[0] = mn;
            }
            __syncthreads();
            have = sHave[0];
        }
        e4_step(base + wave, NGW, NUM, DENR, EMT, P, hnw, MIX, lane);
    }
}

__device__ __forceinline__ void phase_o2(const bf16* P2, const float* pool_b, const float* pool_s, bf16* H, int G) {
    int tid = threadIdx.x; asm volatile("" : "+v"(tid));
    const int gt = blockIdx.x * NTHR + tid, NT = G * NTHR;
    for (int idx = gt; idx < 256 * 512; idx += NT) {
        const int cg = idx & 511, run = idx >> 9, g = cg >> 7, w = 2 << g, t0 = run * 64;
        const bf16* src = P2 + cg * 8;
        const f32x4 b0 = *(const f32x4*)(pool_b + cg * 8), b1 = *(const f32x4*)(pool_b + cg * 8 + 4), s0 = *(const f32x4*)(pool_s + cg * 8), s1 = *(const f32x4*)(pool_s + cg * 8 + 4);
        const float pb[8] = {b0.x, b0.y, b0.z, b0.w, b1.x, b1.y, b1.z, b1.w}, ps[8] = {s0.x, s0.y, s0.z, s0.w, s1.x, s1.y, s1.z, s1.w};
        float sum[8];
#pragma unroll
        for (int e = 0; e < 8; ++e) sum[e] = 0.f;
        for (int t = t0 - w + 1; t < t0; ++t) if (t >= 0) { float f[8]; unpack8(*(const u32x4*)(src + (size_t)t * ODD_IN), f);
#pragma unroll
            for (int e = 0; e < 8; ++e) sum[e] += f[e]; }
        for (int t = t0; t < t0 + 64; t += 4) {
            u32x4 rc[4], rz[4], ro[4];
#pragma unroll
            for (int j = 0; j < 4; ++j) { rc[j] = *(const u32x4*)(src + (size_t)(t + j) * ODD_IN); rz[j] = *(const u32x4*)(src + (size_t)(t + j) * ODD_IN + 4096);
                const int to = t + j - w + 1; ro[j] = *(const u32x4*)(src + (size_t)(to >= 0 ? to : 0) * ODD_IN); }
#pragma unroll
            for (int j = 0; j < 4; ++j) {
                float cur[8], zf[8]; unpack8(rc[j], cur); unpack8(rz[j], zf);
#pragma unroll
                for (int e = 0; e < 8; ++e) sum[e] += cur[e];
                const int tt = t + j; const float inv = 1.0f / (float)((tt + 1) < w ? (tt + 1) : w);
                float o[8];
#pragma unroll
                for (int e = 0; e < 8; ++e) o[e] = ((sum[e] * inv - cur[e]) + pb[e]) * ps[e] * zf[e];
                *(u32x4*)(H + (size_t)tt * D + cg * 8) = (u32x4){pk2(o[0], o[1]), pk2(o[2], o[3]), pk2(o[4], o[5]), pk2(o[6], o[7])};
                if (tt - w + 1 >= 0) { float old[8]; unpack8(ro[j], old);
#pragma unroll
                    for (int e = 0; e < 8; ++e) sum[e] -= old[e]; }
            }
        }
    }
}

constexpr int N_PHASES = 24;
__global__ void __launch_bounds__(NTHR, 2) fwd_kernel(Args a) {
    extern __shared__ __attribute__((aligned(16))) unsigned char lds_raw[];
    LAS unsigned char* lds = (LAS unsigned char*)lds_raw;
    const int tid = threadIdx.x, G = gridDim.x;
    unsigned char* ws = a.ws;
    for (int u = tid; u < (LDS_BYTES - LDSCTL_OFF) / 4; u += NTHR) ((LAS unsigned*)(lds + LDSCTL_OFF))[u] = 0u;
    __syncthreads();
    unsigned* barw = (unsigned*)(ws + WS_CTL) + CW_BAR;
    XcdBarrier bar; bar.bar = barw; bar.x = 0; bar.st = nullptr;
    if (!MK_MULTI) bar = xcd_barrier_post(barw, (volatile LAS unsigned*)(lds + MISC_OFF) + 8);
    const int lo = a.ph_lo, hi = a.ph_hi;
#define IN(k) (lo <= (k) && (k) < hi)
#define SEAM(k) do { if (!MK_MULTI && IN(k) && IN((k) + 1)) xcd_barrier_next(bar); } while (0)
#define SEAM0(k) do { if (!MK_MULTI && IN(k) && IN((k) + 1)) xcd_barrier(bar); } while (0)

    float* MOD = (float*)(ws + WS_MOD); float* GATES = (float*)(ws + WS_GATES);
    bf16* U = (bf16*)(ws + WS_U); float* T = (float*)(ws + WS_T); bf16* YB = (bf16*)(ws + WS_T); bf16* XH = (bf16*)(ws + WS_T + 128 * MiB);     bf16* P = (bf16*)(ws + WS_P); bf16* MIX = (bf16*)(ws + WS_MIX);
    float* NUM = (float*)(ws + WS_NUM2); bf16* POOLED = (bf16*)(ws + WS_NUM);
    float* WINTER = (float*)(ws + WS_WINTER); float* EMT = (float*)(ws + WS_EMT); float* CDEC = (float*)(ws + WS_CDEC); float* DENR = (float*)(ws + WS_DENR); float* BLWM = (float*)(ws + WS_CDEC + 65536);
    bf16* SB = (bf16*)(ws + WS_S); bf16* QC = (bf16*)(ws + WS_QC); bf16* KC = (bf16*)(ws + WS_KC); bf16* VT = (bf16*)(ws + WS_VT); bf16* VBT = (bf16*)(ws + WS_VBT); bf16* QB2 = (bf16*)(ws + WS_T); bf16* KB2 = (bf16*)(ws + WS_T + 32 * MiB);

    float* BIAS = (float*)(ws + WS_BIAS);
    if (IN(0)) { phase_mods(a, lds, G); } SEAM0(0);
    if (IN(1)) { for (int rep = 0; rep < REP_P0; ++rep) phase_weights(a, lds, G); } SEAM(1);
    if (IN(2)) {
#pragma unroll 1
        for (int lp = 0; lp < 2; ++lp) {
            const bf16* wbp = (const bf16*)(ws + WS_W + (size_t)lp * W_PAIR);
            const bf16* Wt_pool_ = (const bf16*)((const unsigned char*)wbp + W_IN_E + W_OUT_E + W_IN_O); bf16* Wt_in_o_ = (bf16*)((unsigned char*)wbp + W_IN_E + W_OUT_E);
            pg8::Gemm g{Wt_pool_, (const bf16*)(ws + WS_P) + (size_t)lp * D * D, D, D, 1024, 1024, D, 0, 4}; pg8::StaticOrder S; S.init(D, D, G, (int)blockIdx.x);
            pg8::EpiColScale E{Wt_in_o_, D, MOD + (2 * lp + 1) * 12288 + D}; pg8::gemm_phase<pg8::EpiColScale, pg8::StaticOrder, true>(lds, g, S, E);
        }
    }
    if (IN(3)) { phase_rows<true, false, false>(a.in[I_X], nullptr, nullptr, nullptr, nullptr, U, nullptr, (const bf16*)(ws + WS_WG), (const float*)(ws + WS_WG + 262144), GATES, lds, G); } SEAM(3);

#pragma unroll 1
    for (int lp = 0; lp < 2; ++lp) {
        const int pb = 4 + 10 * lp;
        const bf16* wb = (const bf16*)(ws + WS_W + (size_t)lp * W_PAIR);
        const bf16* Wt_in_e = wb; const bf16* Wt_out_e = (const bf16*)((const unsigned char*)wb + W_IN_E); const bf16* Wt_in_o = (const bf16*)((const unsigned char*)wb + W_IN_E + W_OUT_E);
        const bf16* Wt_pool = (const bf16*)((const unsigned char*)wb + W_IN_E + W_OUT_E + W_IN_O); const bf16* Wt_out_o = (const bf16*)((const unsigned char*)wb + W_IN_E + W_OUT_E + W_IN_O + W_POOL);
        const float* conv_w = lp ? a.in[24] : a.in[5]; const float* igb = lp ? a.in[25] : a.in[6]; const float* fgb = lp ? a.in[26] : a.in[7]; const float* hnw = lp ? a.in[27] : a.in[8];
        const float* lng_e = lp ? a.in[29] : a.in[10]; const float* lnb_e = lp ? a.in[30] : a.in[11];
        const float* pool_b = lp ? a.in[35] : a.in[16]; const float* pool_s = lp ? a.in[36] : a.in[17];
        const float* lng_o = lp ? a.in[38] : a.in[19]; const float* lnb_o = lp ? a.in[39] : a.in[20];
        const float* xcur_e = lp ? (const float*)a.out : a.in[I_X];
        const float* mod_e = MOD + (2 * lp) * 12288; const float* mod_o = MOD + (2 * lp + 1) * 12288;

        if (IN(pb + 0)) { chunk_gate_sums(GATES, igb, fgb, BLWM, G);
            pg8::Gemm g{U, Wt_in_e, M, EVEN_N, D, D, D, 0, 0}; pg8::StaticOrder S; S.init(M, EVEN_N, G, (int)blockIdx.x);
            pg8::EpiAct E{P, EVEN_N, 0, BIAS + (2 * lp) * 12288}; pg8::gemm_phase<pg8::EpiAct, pg8::StaticOrder, true>(lds, g, S, E); }
        SEAM(pb + 0);
        if (IN(pb + 1)) for (int rep = 0; rep < REP_E2; ++rep) {
            e2_preamble(BLWM, lds);
            for (int it = blockIdx.x; it < 1024; it += G) e2_prep_item(it >> 2, it & 3, P, conv_w, GATES, igb, fgb, QC, KC, SB, VT, VBT, QB2, KB2, WINTER, EMT, CDEC, lds);
        }
        SEAM(pb + 1);
        const bool fusedE4 = G > 2 * SC_ITEMS;
        unsigned* PROG = (unsigned*)(ws + WS_CTL + 32768) + lp * 128;
        if (IN(pb + 2)) for (int rep = 0; rep < REP_E3; ++rep) {
            const int nscan = G > 2 * SC_ITEMS ? SC_ITEMS : 0;
#define SC_CALL(it) e3_scan_item(((it) >> 1) / (SC_SLICES + 1), ((it) >> 1) % (SC_SLICES + 1), (it) & 1, QC, KC, SB, VT, WINTER, CDEC, NUM, DENR, (const bf16*)(ws + WS_CDEC + 131072), PROG + (it), lds)
            if ((int)blockIdx.x < nscan) { const int g_ = (int)blockIdx.x & 7, s_ = (int)blockIdx.x >> 3; SC_CALL(((g_ >> 1) * (SC_SLICES + 1) + s_) * 2 + (g_ & 1)); }
            else {
                if (nscan == 0) for (int it = blockIdx.x; it < SC_ITEMS; it += G) SC_CALL(it);
                for (int it = blockIdx.x - nscan; it < 2048; it += G - nscan) { const int r = 2047 - it; e3_attn_item(r & 7, r >> 3, P, QB2, KB2, VBT, MIX, lds); }
                if (nscan) e4_fused((int)blockIdx.x - nscan, G - nscan, PROG, NUM, DENR, EMT, P, hnw, MIX, lds);
            }
#undef SC_CALL
        }
        if (!fusedE4 || MK_MULTI) SEAM(pb + 2);
        if (IN(pb + 3) && !fusedE4) { phase_e4(NUM, DENR, EMT, P, hnw, MIX, G); }
        SEAM(pb + 3);
        if (IN(pb + 4)) { pg8::Gemm g{MIX, Wt_out_e, M, D, EVEN_MIX, EVEN_MIX, EVEN_MIX, 0, 0}; pg8::StaticOrder S; S.init(M, D, G, (int)blockIdx.x);
            pg8::EpiAct E{YB, D, 2, nullptr}; pg8::gemm_phase<pg8::EpiAct, pg8::StaticOrder, true>(lds, g, S, E); }
        SEAM(pb + 4);
        if (IN(pb + 5)) for (int rep = 0; rep < REP_ROWS; ++rep) {
            if (lp == 0) phase_rows<false, false, false>(a.in[I_X], YB, mod_e + 2 * D, lng_e, lnb_e, U, XH, nullptr, nullptr, nullptr, lds, G);
            else phase_rows<false, true, false>(XH, YB, mod_e + 2 * D, lng_e, lnb_e, U, XH, nullptr, nullptr, nullptr, lds, G);
        }
        SEAM(pb + 5);
        if (IN(pb + 6)) { pg8::Gemm g{U, Wt_in_o, M, ODD_IN, D, D, D, 0, 0}; pg8::StaticOrder S; S.init(M, ODD_IN, G, (int)blockIdx.x);
            pg8::EpiAct E{P, ODD_IN, 1, BIAS + (2 * lp + 1) * 12288}; pg8::gemm_phase<pg8::EpiAct, pg8::StaticOrder, true>(lds, g, S, E); }
        SEAM(pb + 6);
        if (IN(pb + 7)) { phase_o2(P, pool_b, pool_s, MIX, G); }
        SEAM(pb + 7);
        if (IN(pb + 8)) for (int rep = 0; rep < REP_GEMM; ++rep) { pg8::Gemm g{MIX, Wt_out_o, M, D, D, D, D, 0, 0}; pg8::StaticOrder S; S.init(M, D, G, (int)blockIdx.x);
            pg8::EpiAct E{YB, D, 2, nullptr}; pg8::gemm_phase<pg8::EpiAct, pg8::StaticOrder, true>(lds, g, S, E); }
        SEAM(pb + 8);
        if (IN(pb + 9)) {
            if (lp == 0) phase_rows<false, true, false>(XH, YB, mod_o + 2 * D, lng_o, lnb_o, U, XH, (const bf16*)(ws + WS_WG) + 8 * D, (const float*)(ws + WS_WG + 262144) + 8, GATES, lds, G);
            else phase_rows<false, true, true>(XH, YB, mod_o + 2 * D, lng_o, lnb_o, a.out, nullptr, nullptr, nullptr, nullptr, lds, G);
        }
        SEAM(pb + 9);
    }
#undef IN
#undef SEAM
}

extern "C" void kernel_launch(void* const* d_in, const int* in_sizes, int n_in, void* d_out, int out_size, void* d_ws, size_t ws_size, hipStream_t stream) {
    static int grid = 0;
    if (grid == 0) {
        if (n_in != 40 || in_sizes[0] != M * D || out_size != M * D || ws_size < WS_END) { fprintf(stderr, "kernel_launch: unexpected shapes (n_in %d, in0 %d, out %d, ws %zu < %zu)\n", n_in, n_in > 0 ? in_sizes[0] : -1, out_size, ws_size, (size_t)WS_END); grid = -1; return; }
        int dev = 0, cus = 0, per_cu = 0;
        if (hipGetDevice(&dev) != hipSuccess || hipDeviceGetAttribute(&cus, hipDeviceAttributeMultiprocessorCount, dev) != hipSuccess) { grid = -1; return; }
        if (hipFuncSetAttribute((const void*)fwd_kernel, hipFuncAttributeMaxDynamicSharedMemorySize, LDS_BYTES) != hipSuccess) { fprintf(stderr, "kernel_launch: hipFuncSetAttribute failed\n"); grid = -1; return; }
        if (hipOccupancyMaxActiveBlocksPerMultiprocessor(&per_cu, (const void*)fwd_kernel, NTHR, LDS_BYTES) != hipSuccess || per_cu < 1)
            fprintf(stderr, "kernel_launch: note: occupancy query reports %d workgroups per CU\n", per_cu);
        (void)hipGetLastError();
        grid = cus;
    }
    if (grid < 0) return;
    if (hipMemsetAsync((char*)d_ws + WS_CTL, 0, CTL_ZERO_BYTES, stream) != hipSuccess) return;
    Args a{};
    for (int i = 0; i < 40; ++i) a.in[i] = (const float*)d_in[i];
    a.out = (float*)d_out; a.ws = (unsigned char*)d_ws;
#if MK_MULTI
    for (int p = 0; p < N_PHASES; ++p) { a.ph_lo = p; a.ph_hi = p + 1; hipLaunchKernelGGL(fwd_kernel, dim3(grid), dim3(NTHR), LDS_BYTES, stream, a); }
#else
    a.ph_lo = 0; a.ph_hi = N_PHASES; hipLaunchKernelGGL(fwd_kernel, dim3(grid), dim3(NTHR), LDS_BYTES, stream, a);
#endif
}
```

```cpp
#include <hip/hip_runtime.h>
#include <cstdio>
#include <cstdint>

#ifndef REP_P0
#define REP_P0 1
#endif
#ifndef REP_E2
#define REP_E2 1
#endif
#ifndef REP_E3
#define REP_E3 1
#endif
#ifndef REP_ROWS
#define REP_ROWS 1
#endif
#ifndef REP_GEMM
#define REP_GEMM 1
#endif
#ifndef MK_MULTI
#define MK_MULTI 0
#endif

namespace pg8 {
#define PG8_LAS __attribute__((address_space(3)))
typedef unsigned short bf16_t;
typedef short bf16x8 __attribute__((ext_vector_type(8)));
typedef float f32x4 __attribute__((ext_vector_type(4)));
typedef unsigned u32x4 __attribute__((ext_vector_type(4)));
constexpr int BM = 256, BK = 64, HALF = 128, HTB = HALF * BK * 2, STAGE_BYTES = 8 * HTB, NXCD = 8, WGM = 8;

__host__ __device__ __forceinline__ int lds_byte(int r, int c) { const int st = (r >> 4) * 2 + (c >> 5), rr = r & 15, cc = c & 31, ob = rr * 64 + cc * 2; return st * 1024 + (ob ^ (((ob >> 9) & 1) << 5)); }
__host__ __device__ __forceinline__ void stage_rc(int b, int& R, int& C) { const int st = b / 1024, sb = b % 1024, swz = sb ^ (((sb >> 9) & 1) << 5); R = (st >> 1) * 16 + swz / 64; C = (st & 1) * 32 + (swz % 64) / 2; }
__host__ __device__ __forceinline__ int perm32(int rho) { const int n = rho >> 4, i = rho & 15; return 8 * (i >> 2) + 4 * n + (i & 3); }

struct Unit { int pm, pn; };
struct Gemm { const bf16_t* A; const bf16_t* Bt; int M, N, K, lda, ldb, grp_tiles, grpb_tiles; };

struct StaticOrder {
    int nM, nN, nwg, G, c;
    __host__ __device__ void init(int M, int N, int G_, int c_) { nM = M / BM; nN = N / BM; nwg = nM * nN; G = G_; c = c_; }
    __host__ __device__ bool next(int i, Unit& u) const {
        const long L = (long)i * G + c; if (L >= nwg) return false;
        int wgid = (int)L; { const int q = nwg / NXCD, r = nwg % NXCD, xcd = wgid % NXCD, off = wgid / NXCD; wgid = (xcd < r ? xcd * (q + 1) : r * (q + 1) + (xcd - r) * q) + off; }
        const int nig = WGM * nN, gid = wgid / nig, fm = gid * WGM, gsz = (nM - fm) < WGM ? (nM - fm) : WGM;
        u.pm = fm + ((wgid % nig) % gsz); u.pn = (wgid % nig) / gsz; return true;
    }
    __device__ __forceinline__ void a_ready(const Unit&) const {}
    __device__ __forceinline__ void done(const Unit&) const {}
};

__device__ __forceinline__ unsigned cvt_pk_bf16(float lo, float hi) { unsigned r; asm volatile("v_cvt_pk_bf16_f32 %0, %1, %2" : "=v"(r) : "v"(lo), "v"(hi)); return r; }
__device__ __forceinline__ float sigmoidf_fast(float x) { return __builtin_amdgcn_rcpf(1.0f + __expf(-x)); }

struct EpiAct {
    static constexpr bool PERM = true, AFTER_DRAIN = false;
    bf16_t* O; int ldc; int mode; const float* bias;
    __device__ __forceinline__ void operator()(const f32x4 (&acc)[2][2][4][2], const Unit& u, int wr, int wc, int fr, int fq) const {
        const int row0 = u.pm * BM + wr * 64 + fr, colt = u.pn * BM;
        int act = 0; float sc = 1.f;
        if (mode == 0) { if (colt >= 4096 && colt < 6144) act = 1; else if ((colt >= 6144 && colt < 8192) || colt >= 11264) act = 2; else if (colt >= 8192 && colt < 9216) sc = 0.08838834764831845f; }
        else if (mode == 1) { if (colt >= 4096) act = 2; }
        const int col0 = colt + wc * 32 + 8 * fq;
        f32x4 bv[2][2];
#pragma unroll
        for (int bj = 0; bj < 2; ++bj)
#pragma unroll
            for (int n = 0; n < 2; ++n) bv[bj][n] = bias ? *(const f32x4*)(bias + col0 + bj * HALF + 4 * n) : (f32x4){0.f, 0.f, 0.f, 0.f};
#pragma unroll
        for (int ai = 0; ai < 2; ++ai)
#pragma unroll
            for (int m = 0; m < 4; ++m) { bf16_t* rowp = O + (size_t)(row0 + ai * HALF + m * 16) * ldc + col0;
#pragma unroll
                for (int bj = 0; bj < 2; ++bj) { f32x4 v0 = acc[ai][bj][m][0] + bv[bj][0], v1 = acc[ai][bj][m][1] + bv[bj][1];
                    if (act == 1) {
#pragma unroll
                        for (int j = 0; j < 4; ++j) { v0[j] = sigmoidf_fast(v0[j]); v1[j] = sigmoidf_fast(v1[j]); } }
                    else if (act == 2) {
#pragma unroll
                        for (int j = 0; j < 4; ++j) { v0[j] = v0[j] * sigmoidf_fast(v0[j]); v1[j] = v1[j] * sigmoidf_fast(v1[j]); } }
                    v0 = v0 * sc; v1 = v1 * sc;
                    u32x4 w; w.x = cvt_pk_bf16(v0[0], v0[1]); w.y = cvt_pk_bf16(v0[2], v0[3]); w.z = cvt_pk_bf16(v1[0], v1[1]); w.w = cvt_pk_bf16(v1[2], v1[3]);
                    *(u32x4*)(rowp + bj * HALF) = w; } }
    }
};
struct EpiRes {
    static constexpr bool PERM = false, AFTER_DRAIN = false;
    const float* X; float* T; const float* gate; float alpha;
    __device__ __forceinline__ void operator()(const f32x4 (&acc)[2][2][4][2], const Unit& u, int wr, int wc, int fr, int fq) const {
        const int row0 = u.pm * BM + wr * 64 + fr, col0 = u.pn * BM + wc * 32 + 4 * fq;
        f32x4 gv[2][2];
#pragma unroll
        for (int bj = 0; bj < 2; ++bj)
#pragma unroll
            for (int n = 0; n < 2; ++n) gv[bj][n] = *(const f32x4*)(gate + col0 + bj * HALF + n * 16) + 1.0f;
#pragma unroll
        for (int ai = 0; ai < 2; ++ai)
#pragma unroll
            for (int m = 0; m < 4; ++m) { const size_t off = (size_t)(row0 + ai * HALF + m * 16) * 4096 + col0;
#pragma unroll
                for (int bj = 0; bj < 2; ++bj)
#pragma unroll
                    for (int n = 0; n < 2; ++n) { const f32x4 xs = *(const f32x4*)(X + off + bj * HALF + n * 16);
                        *(f32x4*)(T + off + bj * HALF + n * 16) = xs * alpha + gv[bj][n] * acc[ai][bj][m][n]; }
                asm volatile("" ::: "memory"); }
    }
};
struct EpiColScale {
    static constexpr bool PERM = true, AFTER_DRAIN = false;
    bf16_t* O; int ldc; const float* scale;
    __device__ __forceinline__ void operator()(const f32x4 (&acc)[2][2][4][2], const Unit& u, int wr, int wc, int fr, int fq) const {
        const int row0 = u.pm * BM + wr * 64 + fr, col0 = u.pn * BM + wc * 32 + 8 * fq;
        f32x4 sv[2][2];
#pragma unroll
        for (int bj = 0; bj < 2; ++bj)
#pragma unroll
            for (int n = 0; n < 2; ++n) sv[bj][n] = *(const f32x4*)(scale + col0 + bj * HALF + 4 * n) + 1.0f;
#pragma unroll
        for (int ai = 0; ai < 2; ++ai)
#pragma unroll
            for (int m = 0; m < 4; ++m) { const size_t r = (size_t)(row0 + ai * HALF + m * 16);
#pragma unroll
                for (int bj = 0; bj < 2; ++bj) { const f32x4 v0 = acc[ai][bj][m][0] * sv[bj][0], v1 = acc[ai][bj][m][1] * sv[bj][1];
                    u32x4 w; w.x = cvt_pk_bf16(v0[0], v0[1]); w.y = cvt_pk_bf16(v0[2], v0[3]); w.z = cvt_pk_bf16(v1[0], v1[1]); w.w = cvt_pk_bf16(v1[2], v1[3]);
                    *(u32x4*)(O + r * ldc + col0 + bj * HALF) = w; } }
    }
};

template <class Epi, class Sched, bool ALIGN_EPI>
__device__ __forceinline__ void gemm_phase(PG8_LAS unsigned char* lds, const Gemm g, const Sched& S, const Epi& E) {
    int tid = threadIdx.x; asm volatile("" : "+v"(tid));
    const int wid = __builtin_amdgcn_readfirstlane(tid >> 6), lane = tid & 63, wr = wid >> 2, wc = wid & 3, fr = lane & 15, fq = lane >> 4;
    const int K = g.K, nt = K / BK;
    unsigned voffA[2], voffB[2];
#pragma unroll
    for (int i = 0; i < 2; ++i) { int R, C; stage_rc(tid * 16 + i * 8192, R, C); const int Rb = Epi::PERM ? ((R & ~31) + perm32(R & 31)) : R;
        voffA[i] = (unsigned)(R * g.lda + C) * 2u; voffB[i] = (unsigned)(Rb * g.ldb + C) * 2u; }
    const size_t kstep = (size_t)(BK * 2);
    const size_t hstepA = (size_t)HALF * g.lda * 2, hstepB = (size_t)HALF * g.ldb * 2;
    const size_t tstepA = 2 * hstepA, tstepB = 2 * hstepB;
    const unsigned ldsw = (unsigned)wid * 1024u;
    const int aoff = lds_byte(wr * 64 + fr, fq * 8), boff = lds_byte(wc * 32 + fr, fq * 8);
#define PG8_UA(u) ((const char*)g.A + (size_t)(u).pm * tstepA + (g.grp_tiles ? (size_t)((u).pn / g.grp_tiles) * (size_t)K * 2 : (size_t)0))
#define PG8_UB(u) ((const char*)g.Bt + (size_t)(u).pn * tstepB + (g.grpb_tiles ? (size_t)((u).pm / g.grpb_tiles) * (size_t)K * 2 : (size_t)0))
#define PG8_SA(b, h) (((b) * 2 + (h)) * HTB)
#define PG8_SB(b, h) ((4 + (b) * 2 + (h)) * HTB)
#define PG8_STAGE(bufoff, gbase, voff) do { _Pragma("unroll") for (int _i = 0; _i < 2; ++_i) \
        __builtin_amdgcn_global_load_lds((const unsigned*)((const char*)(gbase) + (voff)[_i]), (PG8_LAS unsigned*)(lds + (bufoff) + ldsw + _i * 8192), 16, 0, 0); } while (0)
#define PG8_LDA(dst, b, h) do { _Pragma("unroll") for (int m = 0; m < 4; ++m) _Pragma("unroll") for (int k = 0; k < 2; ++k) dst[m][k] = *(const PG8_LAS bf16x8*)(lds + PG8_SA(b, h) + aoff + m * 2048 + k * 1024); } while (0)
#define PG8_LDB(dst, b, h) do { _Pragma("unroll") for (int n = 0; n < 2; ++n) _Pragma("unroll") for (int k = 0; k < 2; ++k) dst[n][k] = *(const PG8_LAS bf16x8*)(lds + PG8_SB(b, h) + boff + n * 2048 + k * 1024); } while (0)
#define PG8_MMA(ai, bj, At, Bt) do { __builtin_amdgcn_s_setprio(1); _Pragma("unroll") for (int m = 0; m < 4; ++m) _Pragma("unroll") for (int n = 0; n < 2; ++n) _Pragma("unroll") for (int k = 0; k < 2; ++k) \
        acc[ai][bj][m][n] = __builtin_amdgcn_mfma_f32_16x16x32_bf16(Bt[n][k], At[m][k], acc[ai][bj][m][n], 0, 0, 0); __builtin_amdgcn_s_setprio(0); } while (0)
#define PG8_WAIT_V(n) asm volatile("s_waitcnt vmcnt(" #n ")" ::: "memory")
#define PG8_WAIT_L(n) asm volatile("s_waitcnt lgkmcnt(" #n ")" ::: "memory")
#define PG8_BAR __builtin_amdgcn_s_barrier()
#define PG8_SCHED __builtin_amdgcn_sched_barrier(0)
    Unit cur, nxt; int ui = 0;
    if (!S.next(0, cur)) return;
    f32x4 acc[2][2][4][2];
#pragma unroll
    for (int a = 0; a < 2; ++a)
#pragma unroll
        for (int b = 0; b < 2; ++b)
#pragma unroll
            for (int m = 0; m < 4; ++m)
#pragma unroll
                for (int n = 0; n < 2; ++n) acc[a][b][m][n] = (f32x4){0.f, 0.f, 0.f, 0.f};
    bf16x8 At[4][2], B0[2][2], B1[2][2];
    const char* cA = PG8_UA(cur); const char* cB = PG8_UB(cur);
    S.a_ready(cur);
    PG8_STAGE(PG8_SB(0, 0), cB, voffB); PG8_STAGE(PG8_SB(0, 1), cB + hstepB, voffB); PG8_STAGE(PG8_SA(0, 0), cA, voffA); PG8_STAGE(PG8_SA(0, 1), cA + hstepA, voffA);
    if (wr == 1) PG8_BAR;
    PG8_WAIT_V(2); PG8_BAR;
    PG8_STAGE(PG8_SB(1, 0), cB + kstep, voffB); PG8_STAGE(PG8_SA(1, 0), cA + kstep, voffA); PG8_STAGE(PG8_SB(1, 1), cB + hstepB + kstep, voffB);
    PG8_WAIT_V(6); PG8_BAR;
    for (;;) {
        const bool has_next = S.next(ui + 1, nxt);
        const char* nA = has_next ? PG8_UA(nxt) : cA; const char* nB = has_next ? PG8_UB(nxt) : cB;
        for (int t = 0; t < nt; t += 2) {
            const bool last = (t == nt - 2);
            const char* a1 = cA + (size_t)(t + 1) * kstep;
            const char* a2 = last ? nA : cA + (size_t)(t + 2) * kstep; const char* b2 = last ? nB : cB + (size_t)(t + 2) * kstep;
            const char* a3 = a2 + kstep; const char* b3 = b2 + kstep;
            if (last && has_next) S.a_ready(nxt);
            PG8_LDB(B0, 0, 0); PG8_LDB(B1, 0, 1); PG8_SCHED; PG8_LDA(At, 0, 0); PG8_STAGE(PG8_SA(1, 1), a1 + hstepA, voffA);
            PG8_WAIT_V(8); PG8_WAIT_L(0); PG8_BAR; PG8_MMA(0, 0, At, B0); PG8_MMA(0, 1, At, B1); PG8_BAR; PG8_SCHED;
            PG8_LDA(At, 0, 1); PG8_STAGE(PG8_SB(0, 0), b2, voffB); PG8_STAGE(PG8_SB(0, 1), b2 + hstepB, voffB); PG8_STAGE(PG8_SA(0, 0), a2, voffA);
            PG8_WAIT_V(8); PG8_WAIT_L(0); PG8_BAR; PG8_MMA(1, 0, At, B0); PG8_MMA(1, 1, At, B1); PG8_BAR; PG8_SCHED;
            PG8_LDB(B0, 1, 0); PG8_LDB(B1, 1, 1); PG8_SCHED; PG8_LDA(At, 1, 0); PG8_STAGE(PG8_SA(0, 1), a2 + hstepA, voffA);
            PG8_WAIT_V(8); PG8_WAIT_L(0); PG8_BAR; PG8_MMA(0, 0, At, B0); PG8_MMA(0, 1, At, B1); PG8_BAR; PG8_SCHED;
            PG8_LDA(At, 1, 1); PG8_STAGE(PG8_SB(1, 0), b3, voffB); PG8_STAGE(PG8_SB(1, 1), b3 + hstepB, voffB); PG8_STAGE(PG8_SA(1, 0), a3, voffA);
            PG8_WAIT_V(8); PG8_WAIT_L(0); PG8_BAR; PG8_MMA(1, 0, At, B0); PG8_MMA(1, 1, At, B1); PG8_BAR; PG8_SCHED;
        }
        if constexpr (ALIGN_EPI) { if (wr == 0) PG8_BAR; }
        E(acc, cur, wr, wc, fr, fq); S.done(cur);
        if (!has_next) break;
#pragma unroll
        for (int a = 0; a < 2; ++a)
#pragma unroll
            for (int b = 0; b < 2; ++b)
#pragma unroll
                for (int m = 0; m < 4; ++m)
#pragma unroll
                    for (int n = 0; n < 2; ++n) acc[a][b][m][n] = (f32x4){0.f, 0.f, 0.f, 0.f};
        cur = nxt; cA = nA; cB = nB; ++ui;
        if constexpr (ALIGN_EPI) { if (wr == 1) PG8_BAR; }
    }
    PG8_WAIT_V(0);
    if constexpr (!ALIGN_EPI) { if (wr == 0) PG8_BAR; }
    PG8_BAR;
#undef PG8_UA
#undef PG8_UB
#undef PG8_SA
#undef PG8_SB
#undef PG8_STAGE
#undef PG8_LDA
#undef PG8_LDB
#undef PG8_MMA
#undef PG8_WAIT_V
#undef PG8_WAIT_L
#undef PG8_BAR
#undef PG8_SCHED
}
}

constexpr int NWAVES = 8, NTHR = 512;
constexpr int M = 16384, D = 4096;
constexpr int EVEN_IN = 12296, EVEN_N = 12288, EVEN_MIX = 3072, ODD_IN = 8192;
constexpr float LN_EPS = 1e-5f;
constexpr float DN_ALPHA = 1.6817928305074290861f;
constexpr float SB_EXIT = 104.0f;

constexpr size_t MiB = 1u << 20;
constexpr size_t WS_CTL = 0, CTL_ZERO_BYTES = 1 * MiB;
constexpr size_t WS_MOD = 1 * MiB;
constexpr size_t WS_WG = 2 * MiB;
constexpr size_t WS_GATES = 3 * MiB;
constexpr size_t WS_WINTER = 4 * MiB;
constexpr size_t WS_EMT = 5 * MiB;
constexpr size_t WS_CDEC = 6 * MiB;
constexpr size_t WS_DENR = 7 * MiB;
constexpr size_t WS_S = 8 * MiB;
constexpr size_t WS_QC = 16 * MiB;
constexpr size_t WS_KC = 48 * MiB;
constexpr size_t WS_U = 80 * MiB;
constexpr size_t WS_T = 208 * MiB;
constexpr size_t WS_P = 464 * MiB;
constexpr size_t WS_MIX = 848 * MiB;
constexpr size_t WS_NUM = 976 * MiB;
constexpr size_t WS_W = 1104 * MiB;
constexpr size_t W_IN_E = 96 * MiB, W_OUT_E = 24 * MiB, W_IN_O = 64 * MiB, W_POOL = 8 * MiB, W_OUT_O = 32 * MiB, W_PAIR = W_IN_E + W_OUT_E + W_IN_O + W_POOL + W_OUT_O;
constexpr size_t WS_VT = WS_W + 2 * W_PAIR;
constexpr size_t WS_VBT = WS_VT + 64 * MiB;
constexpr size_t WS_NUM2 = WS_VBT + 32 * MiB;
constexpr size_t WS_END = WS_NUM2 + 256 * MiB;
constexpr int CW_BAR = 4096;
constexpr size_t WS_BIAS = WS_CTL + 65536;

constexpr int RING_BYTES = 149504, LDSCTL_OFF = RING_BYTES, MISC_OFF = LDSCTL_OFF + 320, LDS_BYTES = 155648;

#define LAS __attribute__((address_space(3)))
typedef unsigned short bf16;
typedef float f32x4 __attribute__((ext_vector_type(4)));
typedef float f32x2 __attribute__((ext_vector_type(2)));
typedef unsigned u32x4 __attribute__((ext_vector_type(4)));
typedef unsigned u32x2 __attribute__((ext_vector_type(2)));
typedef short bf16x8 __attribute__((ext_vector_type(8)));
typedef __bf16 bf16x2n __attribute__((ext_vector_type(2)));

__device__ __forceinline__ unsigned f2bf(float f) { unsigned u = __builtin_bit_cast(unsigned, f); return (u + 0x7fffu + ((u >> 16) & 1u)) >> 16; }
__device__ __forceinline__ unsigned pk2(float lo, float hi) { return pg8::cvt_pk_bf16(lo, hi); }
__device__ __forceinline__ unsigned pk2n(float lo, float hi) { return __builtin_bit_cast(unsigned, __builtin_convertvector((f32x2){lo, hi}, bf16x2n)); }
__device__ __forceinline__ unsigned pkh(float lo, float hi) { return (unsigned)__builtin_bit_cast(unsigned short, (_Float16)lo) | ((unsigned)__builtin_bit_cast(unsigned short, (_Float16)hi) << 16); }
__device__ __forceinline__ float hlo(unsigned w) { return (float)__builtin_bit_cast(_Float16, (unsigned short)(w & 0xffffu)); }
__device__ __forceinline__ float hhi(unsigned w) { return (float)__builtin_bit_cast(_Float16, (unsigned short)(w >> 16)); }
__device__ __forceinline__ float bflo(unsigned w) { return __uint_as_float(w << 16); }
__device__ __forceinline__ float bfhi(unsigned w) { return __uint_as_float(w & 0xffff0000u); }
__device__ __forceinline__ float wave_sum(float v) {
#pragma unroll
    for (int o = 1; o < 64; o <<= 1) v += __shfl_xor(v, o);
    return v;
}
__device__ __forceinline__ float wave_max(float v) {
#pragma unroll
    for (int o = 1; o < 64; o <<= 1) v = fmaxf(v, __shfl_xor(v, o));
    return v;
}
__device__ __forceinline__ float wave_min(float v) {
#pragma unroll
    for (int o = 1; o < 64; o <<= 1) v = fminf(v, __shfl_xor(v, o));
    return v;
}
__device__ __forceinline__ float wave_incl_sum(float v, int lane) {
#pragma unroll
    for (int o = 1; o < 64; o <<= 1) { const float t = __shfl_up(v, o); if (lane >= o) v += t; }
    return v;
}
__device__ __forceinline__ float wave_incl_max(float v, int lane) {
#pragma unroll
    for (int o = 1; o < 64; o <<= 1) { const float t = __shfl_up(v, o); if (lane >= o) v = fmaxf(v, t); }
    return v;
}
__device__ __forceinline__ float logsigmoidf_acc(float x) { return x >= 0.f ? -log1pf(expf(-x)) : x - log1pf(expf(x)); }
__device__ __forceinline__ float softplusf_acc(float z) { return fmaxf(z, 0.f) + log1pf(expf(-fabsf(z))); }
__device__ __forceinline__ float softplusf_fast(float z) { return fmaxf(z, 0.f) + __logf(1.0f + __expf(-fabsf(z))); }
__device__ __forceinline__ void unpack8(const u32x4 w, float (&f)[8]) { f[0] = bflo(w.x); f[1] = bfhi(w.x); f[2] = bflo(w.y); f[3] = bfhi(w.y); f[4] = bflo(w.z); f[5] = bfhi(w.z); f[6] = bflo(w.w); f[7] = bfhi(w.w); }

#define XB_TMO      128
#define XB_XCNT(j)  (256  + 64 * (j))
#define XB_XSUB(j)  (1280 + 64 * (j))
#define XB_XGEN(j)  (2304 + 64 * (j))
#define XB_TOP      3328
#define XB_TOPGEN   3392
#define XCD_BAR_WORDS 3456
#define XB_SPIN_CAP (1u << 18)
__device__ __forceinline__ unsigned xb_ld(unsigned* p)              { return __hip_atomic_load(p, __ATOMIC_RELAXED, __HIP_MEMORY_SCOPE_AGENT); }
__device__ __forceinline__ unsigned xb_add(unsigned* p, unsigned v) { return __hip_atomic_fetch_add(p, v, __ATOMIC_RELAXED, __HIP_MEMORY_SCOPE_AGENT); }
__device__ __forceinline__ unsigned xb_xcc_id() { return (unsigned)__builtin_amdgcn_s_getreg((3 << 11) | 20) & 0xFu; }
#define XB_SPIN(cond, bar) do { unsigned _sp = 0; while (cond) { __builtin_amdgcn_s_sleep(1); \
    if ((++_sp & 255u) == 0u) { if (xb_ld(&(bar)[XB_TMO])) break; if (_sp > XB_SPIN_CAP) { atomicAdd(&(bar)[XB_TMO], 1u); break; } } } } while (0)
struct XcdBarrier { unsigned* bar; unsigned x; volatile LAS unsigned* st; };
__device__ __forceinline__ XcdBarrier xcd_barrier_post(unsigned* bar, volatile LAS unsigned* st) {
    XcdBarrier b; b.bar = bar; b.x = xb_xcc_id(); b.st = st;
    if (threadIdx.x == 0) (void)xb_add(&bar[XB_XCNT(b.x)], 1u);
    return b;
}
__device__ __forceinline__ void xcd_barrier_complete(unsigned* bar, unsigned x, unsigned& nloc, unsigned& nx) {
    const unsigned G = gridDim.x * gridDim.y * gridDim.z;
    unsigned sum, cnt, mine, sp = 0u;
    for (;;) {
        sum = 0u; cnt = 0u; mine = 0u;
#pragma unroll
        for (unsigned j = 0; j < 16; ++j) { const unsigned c = xb_ld(&bar[XB_XCNT(j)]); sum += c; cnt += (c > 0u) ? 1u : 0u; mine = (j == x) ? c : mine; }
        if (sum == G) break;
        __builtin_amdgcn_s_sleep(1);
        if ((++sp & 255u) == 0u) { if (xb_ld(&bar[XB_TMO])) break; if (sp > XB_SPIN_CAP) { atomicAdd(&bar[XB_TMO], 1u); break; } }
    }
    nloc = mine > 0u ? mine : 1u; nx = cnt > 0u ? cnt : 1u;
}
__device__ __forceinline__ void xcd_barrier(const XcdBarrier& b) {
    asm volatile("s_waitcnt vmcnt(0)" ::: "memory");
    __syncthreads();
    if (threadIdx.x == 0) {
        unsigned* bar = b.bar;
        __builtin_amdgcn_s_waitcnt(0);
        unsigned nloc = b.st[0], nx = b.st[1];
        if (nloc == 0u) { xcd_barrier_complete(bar, b.x, nloc, nx); b.st[0] = nloc; b.st[1] = nx; }
        const unsigned old = xb_add(&bar[XB_XSUB(b.x)], 1u);
        const unsigned gen = old / nloc;
        if (old + 1u == (gen + 1u) * nloc) {
            __builtin_amdgcn_fence(__ATOMIC_RELEASE, "agent");
            asm volatile("s_waitcnt vmcnt(0)" ::: "memory");
            const unsigned og = xb_add(&bar[XB_TOP], 1u);
            const unsigned tg = og / nx;
            if (og + 1u == (tg + 1u) * nx) xb_add(&bar[XB_TOPGEN], 1u);
            else XB_SPIN(xb_ld(&bar[XB_TOPGEN]) == tg, bar);
            __builtin_amdgcn_fence(__ATOMIC_ACQUIRE, "agent");
            xb_add(&bar[XB_XGEN(b.x)], 1u);
            asm volatile("s_waitcnt vmcnt(0)" ::: "memory");
        } else {
            XB_SPIN(xb_ld(&bar[XB_XGEN(b.x)]) == gen, bar);
            __builtin_amdgcn_fence(__ATOMIC_ACQUIRE, "agent");
            asm volatile("s_waitcnt vmcnt(0)" ::: "memory");
        }
    }
    __syncthreads();
}

__device__ __forceinline__ void xcd_barrier_next(const XcdBarrier& b) {
    asm volatile("s_waitcnt vmcnt(0)" ::: "memory");
    __syncthreads();
    if (threadIdx.x == 0) {
        unsigned* bar = b.bar;
        __builtin_amdgcn_s_waitcnt(0);
        const unsigned nloc = b.st[0], nx = b.st[1];
        const unsigned old = xb_add(&bar[XB_XSUB(b.x)], 1u);
        const unsigned gen = old / nloc;
        if (old + 1u == (gen + 1u) * nloc) {
            __builtin_amdgcn_fence(__ATOMIC_RELEASE, "agent");
            asm volatile("s_waitcnt vmcnt(0)" ::: "memory");
            const unsigned og = xb_add(&bar[XB_TOP], 1u);
            const unsigned tg = og / nx;
            if (og + 1u == (tg + 1u) * nx) xb_add(&bar[XB_TOPGEN], 1u);
            else XB_SPIN(xb_ld(&bar[XB_TOPGEN]) == tg, bar);
            __builtin_amdgcn_fence(__ATOMIC_ACQUIRE, "agent");
            xb_add(&bar[XB_XGEN(b.x)], 1u);
            asm volatile("s_waitcnt vmcnt(0)" ::: "memory");
        } else {
            XB_SPIN(xb_ld(&bar[XB_XGEN(b.x)]) == gen, bar);
            __builtin_amdgcn_fence(__ATOMIC_ACQUIRE, "agent");
            asm volatile("s_waitcnt vmcnt(0)" ::: "memory");
        }
    }
    __syncthreads();
}

struct Args { const float* in[40]; float* out; unsigned char* ws; int ph_lo, ph_hi; };
constexpr int I_X = 0, I_C = 1;

__device__ __forceinline__ void p0_transpose_item(const float* W, int ldw, int src_col0, bf16* WT, int ldt, int dst_row0, int nblk, LAS float* scr, int item, int lane,
                                                  const float* scl, const float* shf, float* bias) {
    const int kb = item / nblk, nb = item % nblk, k0 = 64 * kb, n0 = 32 * nb;
    float bacc = 0.f;
    LAS float* sms = scr + 64 * 33;
    if (scl) { sms[lane] = 1.0f + scl[k0 + lane]; sms[64 + lane] = shf[k0 + lane]; asm volatile("s_waitcnt lgkmcnt(0)" ::: "memory"); }
#pragma unroll 8
    for (int i = 0; i < 32; ++i) { const int kk = 2 * i + (lane >> 5); const float wv = W[(size_t)(k0 + kk) * ldw + src_col0 + n0 + (lane & 31)];
        if (scl) { scr[kk * 33 + (lane & 31)] = wv * sms[kk]; bacc += sms[64 + kk] * wv; } else scr[kk * 33 + (lane & 31)] = wv; }
    if (scl) { bacc += __shfl_xor(bacc, 32); if (lane < 32) atomicAdd(bias + dst_row0 + n0 + lane, bacc); }
    asm volatile("s_waitcnt lgkmcnt(0)" ::: "memory");
    const int c = lane & 7;
#pragma unroll
    for (int j = 0; j < 4; ++j) { const int n = (lane >> 3) + 8 * j; const LAS float* s = scr + (8 * c) * 33 + n;
        u32x4 o; o.x = pk2(s[0 * 33], s[1 * 33]); o.y = pk2(s[2 * 33], s[3 * 33]); o.z = pk2(s[4 * 33], s[5 * 33]); o.w = pk2(s[6 * 33], s[7 * 33]);
        *(u32x4*)(WT + (size_t)(dst_row0 + n0 + n) * ldt + k0 + 8 * c) = o; }
    asm volatile("s_waitcnt lgkmcnt(0)" ::: "memory");
}
__device__ __forceinline__ void p0_convert(const float* W, int K, int ldw, int src_col0, int ncols, bf16* WT, int dst_row0, LAS float* scr, int gw, int NGW, int lane,
                                           const float* scl, const float* shf, float* bias) {
    const int nblk = ncols / 32, nitems = (K / 64) * nblk;
    for (int it = gw; it < nitems; it += NGW) p0_transpose_item(W, ldw, src_col0, WT, K, dst_row0, nblk, scr, it, lane, scl, shf, bias);
}
__device__ __forceinline__ void phase_mods(const Args& a, LAS unsigned char* lds, int G) {
    __syncthreads();
    int tid = threadIdx.x; asm volatile("" : "+v"(tid));
    const int lane = tid & 63, wave = tid >> 6;
    LAS float* cact = (LAS float*)lds; LAS float* red = (LAS float*)(lds + 16384);
    for (int i = tid; i < D; i += NTHR) { const float c = a.in[I_C][i]; cact[i] = c / (1.0f + expf(-c)); }
    __syncthreads();
    float* MOD = (float*)(a.ws + WS_MOD);
    if (blockIdx.x == 0) ((u32x4*)(a.ws + WS_CDEC + 131072))[tid] = (u32x4){0x3F803F80u, 0x3F803F80u, 0x3F803F80u, 0x3F803F80u};
    for (int item = blockIdx.x; item < 4 * 192; item += G) {
        const int l = item / 192, col = (item % 192) * 64 + lane;
        const float* Wl = l == 0 ? a.in[2] : l == 1 ? a.in[12] : l == 2 ? a.in[21] : a.in[31];
        const float* bl = l == 0 ? a.in[3] : l == 1 ? a.in[13] : l == 2 ? a.in[22] : a.in[32];
        const float* Wp = Wl + (size_t)(wave * 512) * 12288 + col; const LAS float* cp = cact + wave * 512;
        float acc = 0.f;
#pragma unroll 16
        for (int k = 0; k < 512; ++k) acc += cp[k] * Wp[(size_t)k * 12288];
        red[wave * 64 + lane] = acc;
        __syncthreads();
        if (wave == 0) { float s = 0.f;
#pragma unroll
            for (int w = 0; w < 8; ++w) s += red[w * 64 + lane];
            MOD[l * 12288 + col] = s + bl[col]; }
        __syncthreads();
    }
}
__device__ __forceinline__ void phase_weights(const Args& a, LAS unsigned char* lds, int G) {
    __syncthreads();
    int tid = threadIdx.x; asm volatile("" : "+v"(tid));
    const int lane = tid & 63, wave = tid >> 6;
    unsigned char* ws = a.ws;
    const float* MOD = (const float*)(ws + WS_MOD); float* BIAS = (float*)(ws + WS_BIAS);
    LAS float* scr = (LAS float*)(lds + wave * 16384);
    const int gw = blockIdx.x * NWAVES + wave, NGW = G * NWAVES;
#pragma unroll 1
    for (int lp = 0; lp < 2; ++lp) {
        bf16* wb = (bf16*)(ws + WS_W + (size_t)lp * W_PAIR);
        const float* w_in_e = lp ? a.in[23] : a.in[4]; const float* w_out_e = lp ? a.in[28] : a.in[9];
        const float* w_in_o = lp ? a.in[33] : a.in[14]; const float* pool_w = lp ? a.in[34] : a.in[15]; const float* w_out_o = lp ? a.in[37] : a.in[18];
        bf16* Wt_in_e = wb; bf16* Wt_out_e = (bf16*)((unsigned char*)wb + W_IN_E); bf16* Wt_in_o = (bf16*)((unsigned char*)wb + W_IN_E + W_OUT_E);
        bf16* Wt_pool = (bf16*)((unsigned char*)wb + W_IN_E + W_OUT_E + W_IN_O); bf16* Wt_out_o = (bf16*)((unsigned char*)wb + W_IN_E + W_OUT_E + W_IN_O + W_POOL);
        const float* mod_e = MOD + (2 * lp) * 12288; const float* mod_o = MOD + (2 * lp + 1) * 12288;
        p0_convert(w_in_e, D, EVEN_IN, 0, 8192, Wt_in_e, 0, scr, gw, NGW, lane, mod_e + D, mod_e, BIAS + (2 * lp) * 12288);
        p0_convert(w_in_e, D, EVEN_IN, 8200, 4096, Wt_in_e, 8192, scr, gw, NGW, lane, mod_e + D, mod_e, BIAS + (2 * lp) * 12288);
        p0_convert(w_out_e, EVEN_MIX, D, 0, D, Wt_out_e, 0, scr, gw, NGW, lane, nullptr, nullptr, nullptr);
        p0_convert(w_in_o, D, ODD_IN, 4096, 4096, Wt_in_o, 4096, scr, gw, NGW, lane, mod_o + D, mod_o, BIAS + (2 * lp + 1) * 12288);
        {
            bf16* WV = (bf16*)(ws + WS_P) + (size_t)lp * D * D;
            for (size_t i = (size_t)blockIdx.x * NTHR + tid; i < (size_t)D * D / 8; i += (size_t)G * NTHR) { const size_t k = i / 512, c8 = i % 512;
                const f32x4 a0 = *(const f32x4*)(w_in_o + k * ODD_IN + c8 * 8), a1 = *(const f32x4*)(w_in_o + k * ODD_IN + c8 * 8 + 4);
                *(u32x4*)(WV + k * D + c8 * 8) = (u32x4){pk2(a0.x, a0.y), pk2(a0.z, a0.w), pk2(a1.x, a1.y), pk2(a1.z, a1.w)}; }
        }
#pragma unroll 1
        for (int g = 0; g < 4; ++g) p0_convert(pool_w + (size_t)g * 1024 * 1024, 1024, 1024, 0, 1024, Wt_pool, g * 1024, scr, gw, NGW, lane, nullptr, nullptr, nullptr);
        p0_convert(w_out_o, D, D, 0, D, Wt_out_o, 0, scr, gw, NGW, lane, nullptr, nullptr, nullptr);
        bf16* WGB = (bf16*)(ws + WS_WG) + lp * 8 * D; float* GB = (float*)(ws + WS_WG + 262144) + lp * 8;
        for (int i = blockIdx.x * NTHR + tid; i < 8 * D; i += G * NTHR) { const int j = i / D, k = i % D; WGB[i] = (bf16)f2bf(w_in_e[(size_t)k * EVEN_IN + 8192 + j] * (1.0f + mod_e[D + k])); }
        if (gw < 8) { float acc = 0.f; for (int k = lane; k < D; k += 64) acc += mod_e[k] * w_in_e[(size_t)k * EVEN_IN + 8192 + gw]; acc = wave_sum(acc); if (lane == 0) GB[gw] = acc; }
    }
}

constexpr int RW_G1 = 0, RW_LG = 16384, RW_LB = 32768, RW_WG = 49152;
template <bool FIRST, bool SRCB, bool DSTF>
__device__ __forceinline__ void phase_rows(const void* src, const bf16* Y, const float* gate, const float* lng, const float* lnb, void* xout, bf16* xh, const bf16* wgb, const float* gb, float* GATES,
                                           LAS unsigned char* lds, int G) {
    int tid = threadIdx.x; asm volatile("" : "+v"(tid));
    const int lane = tid & 63, wave = tid >> 6;
    __syncthreads();
    if (!FIRST) { for (int i = tid; i < 1024; i += NTHR) { ((LAS f32x4*)(lds + RW_G1))[i] = ((const f32x4*)gate)[i] + 1.0f; ((LAS f32x4*)(lds + RW_LG))[i] = ((const f32x4*)lng)[i]; ((LAS f32x4*)(lds + RW_LB))[i] = ((const f32x4*)lnb)[i]; } }
    if (wgb) { for (int i = tid; i < 4096; i += NTHR) ((LAS u32x4*)(lds + RW_WG))[i] = ((const u32x4*)wgb)[i]; }
    __syncthreads();
    const int gw = blockIdx.x * NWAVES + wave, NGW = G * NWAVES;
#pragma unroll 1
    for (int m = gw; m < M; m += NGW) {
        int ln = lane; asm volatile("" : "+v"(ln));
        f32x4 v[16]; u32x2 yy[16];
        if (SRCB) { const u32x2* xr = (const u32x2*)((const bf16*)src + (size_t)m * D) + ln; u32x2 xx[16];
#pragma unroll
            for (int j = 0; j < 16; ++j) xx[j] = xr[64 * j];
            if (!FIRST) { const u32x2* yr = (const u32x2*)(Y + (size_t)m * D) + ln;
#pragma unroll
                for (int j = 0; j < 16; ++j) yy[j] = yr[64 * j]; }
#pragma unroll
            for (int j = 0; j < 16; ++j) v[j] = (f32x4){hlo(xx[j].x), hhi(xx[j].x), hlo(xx[j].y), hhi(xx[j].y)}; }
        else { const f32x4* xr = (const f32x4*)((const float*)src + (size_t)m * D) + ln;
#pragma unroll
            for (int j = 0; j < 16; ++j) v[j] = xr[64 * j];
            if (!FIRST) { const u32x2* yr = (const u32x2*)(Y + (size_t)m * D) + ln;
#pragma unroll
                for (int j = 0; j < 16; ++j) yy[j] = yr[64 * j]; } }
        if (!FIRST) {
            const LAS f32x4* g1 = (const LAS f32x4*)(lds + RW_G1) + ln; const LAS f32x4* lg = (const LAS f32x4*)(lds + RW_LG) + ln; const LAS f32x4* lb = (const LAS f32x4*)(lds + RW_LB) + ln;
            float s = 0.f;
#pragma unroll
            for (int j = 0; j < 16; ++j) { const f32x4 yv = (f32x4){bflo(yy[j].x), bfhi(yy[j].x), bflo(yy[j].y), bfhi(yy[j].y)}; v[j] = v[j] * DN_ALPHA + g1[64 * j] * yv; s += (v[j].x + v[j].y) + (v[j].z + v[j].w); }
            const float mean = wave_sum(s) * (1.f / D); float s2 = 0.f;
#pragma unroll
            for (int j = 0; j < 16; ++j) { v[j] = v[j] - mean; s2 += (v[j].x * v[j].x + v[j].y * v[j].y) + (v[j].z * v[j].z + v[j].w * v[j].w); }
            const float rstd = 1.f / sqrtf(wave_sum(s2) * (1.f / D) + LN_EPS);
#pragma unroll
            for (int j = 0; j < 16; ++j) { v[j] = v[j] * rstd * lg[64 * j] + lb[64 * j];
                if (DSTF) ((f32x4*)((float*)xout + (size_t)m * D) + ln)[64 * j] = v[j]; }
        }
        if (!DSTF) { u32x2* xo = (u32x2*)((bf16*)xout + (size_t)m * D) + ln;
#pragma unroll
            for (int j = 0; j < 16; ++j) { u32x2 o; o.x = pk2(v[j].x, v[j].y); o.y = pk2(v[j].z, v[j].w); xo[64 * j] = o; }
            if (xh) { u32x2* ho = (u32x2*)(xh + (size_t)m * D) + ln;
#pragma unroll
                for (int j = 0; j < 16; ++j) { u32x2 o; o.x = pkh(v[j].x, v[j].y); o.y = pkh(v[j].z, v[j].w); ho[64 * j] = o; } } }
        if (wgb) {
            float keep = 0.f;
#pragma unroll 1
            for (int jg = 0; jg < 8; ++jg) { float p = 0.f; const LAS u32x2* wr = (const LAS u32x2*)(lds + RW_WG) + jg * 1024 + ln;
#pragma unroll
                for (int j = 0; j < 16; ++j) { const u32x2 w = wr[64 * j]; p += (v[j].x * bflo(w.x) + v[j].y * bfhi(w.x)) + (v[j].z * bflo(w.y) + v[j].w * bfhi(w.y)); }
                p = wave_sum(p); if (lane == jg) keep = p + gb[jg]; }
            if (lane < 8) GATES[(size_t)m * 8 + lane] = keep;
        }
    }
}

constexpr int E2_BL = 0, E2_WM = 4096, E2_MP = 8192;
constexpr int E2_SQ = 16384, E2_SK = E2_SQ + 64 * 528;
constexpr int E2_VC = 16384, E2_VC_PITCH = 1544;
constexpr int E2_SS = 115712, E2_SC = 123904;
static_assert(E2_SK + 64 * 528 <= E2_SS && E2_VC + 64 * E2_VC_PITCH <= E2_SS && E2_SC + 1280 <= RING_BYTES, "E2 LDS map");

__device__ __forceinline__ void chunk_gate_sums(const float* GATES, const float* igb, const float* fgb, float* BLWM, int G) {
    int tid = threadIdx.x; asm volatile("" : "+v"(tid));
    const int lane = tid & 63, wave = tid >> 6;
    for (int pair = blockIdx.x * NWAVES + wave; pair < 1024; pair += G * NWAVES) {
        const int c = pair >> 2, h = pair & 3, m = 64 * c + lane;
        const float lf = logsigmoidf_acc(GATES[(size_t)m * 8 + 4 + h] + fgb[h]), li = GATES[(size_t)m * 8 + h] + igb[h];
        const float b = wave_incl_sum(lf, lane), gmax = wave_max(li - b), blast = __shfl(b, 63);
        if (lane == 0) { BLWM[(h * 256 + c) * 2] = blast; BLWM[(h * 256 + c) * 2 + 1] = blast + gmax; }
    }
}
__device__ __forceinline__ void e2_preamble(const float* BLWM, LAS unsigned char* lds) {
    int tid = threadIdx.x; asm volatile("" : "+v"(tid));
    LAS float* sBL = (LAS float*)(lds + E2_BL); LAS float* sWM = (LAS float*)(lds + E2_WM); LAS float* sMP = (LAS float*)(lds + E2_MP);
    __syncthreads();
    for (int i = tid; i < 1024; i += NTHR) { const f32x2 v = *(const f32x2*)(BLWM + 2 * i); sBL[i] = v.x; sWM[i] = v.y; }
    __syncthreads();
    if (tid < 256) { const int hh = tid >> 6, ln = tid & 63;
        float av[4], bv[4];
#pragma unroll
        for (int i = 0; i < 4; ++i) { av[i] = sBL[hh * 256 + 4 * ln + i]; bv[i] = sWM[hh * 256 + 4 * ln + i]; }
        float A = av[0], B = bv[0];
#pragma unroll
        for (int i = 1; i < 4; ++i) { B = fmaxf(B + av[i], bv[i]); A += av[i]; }
#pragma unroll
        for (int o = 1; o < 64; o <<= 1) { const float Ap = __shfl_up(A, o), Bp = __shfl_up(B, o); if (ln >= o) { B = fmaxf(Bp + A, B); A = Ap + A; } }
        const float Ae = __shfl_up(A, 1), Be = __shfl_up(B, 1);
        float mm = ln ? fmaxf(0.f + Ae, Be) : 0.f;
#pragma unroll
        for (int i = 0; i < 4; ++i) { sMP[hh * 256 + 4 * ln + i] = mm; mm = fmaxf(av[i] + mm, bv[i]); } }
    __syncthreads();
}
__device__ __forceinline__ void e2_prep_item(int c, int h, const bf16* P, const float* conv_w, const float* GATES, const float* igb, const float* fgb,
                                             bf16* QC, bf16* KCT, bf16* SB, bf16* VT, bf16* VBT, bf16* QB2, bf16* KB2, float* WINTER, float* EMT, float* CDEC, LAS unsigned char* lds) {
    int tid = threadIdx.x; asm volatile("" : "+v"(tid));
    const int lane = tid & 63, wave = tid >> 6;
    LAS float* sMP = (LAS float*)(lds + E2_MP);
    LAS float* sb = (LAS float*)(lds + E2_SC); LAS float* sli = sb + 64; LAS float* smt = sb + 128; LAS float* sws = sb + 192;
    LAS unsigned char* sq = lds + E2_SQ; LAS unsigned char* sk = lds + E2_SK; LAS unsigned char* sS = lds + E2_SS; LAS unsigned char* sVc = lds + E2_VC;
    const int item = c * 4 + h;
    u32x4 vreg[12];
#pragma unroll
    for (int i = 0; i < 12; ++i) { const int idx = tid + NTHR * i, s = idx / 96, p = idx % 96;
        vreg[i] = *(const u32x4*)(P + (size_t)(64 * c + s) * EVEN_N + (p < 64 ? 2048 + h * 512 + p * 8 : 10240 + h * 256 + (p - 64) * 8)); }
    __syncthreads();
    if (wave == 0) {
        const int m = 64 * c + lane;
        const float lf = logsigmoidf_acc(GATES[(size_t)m * 8 + 4 + h] + fgb[h]), li = GATES[(size_t)m * 8 + h] + igb[h];
        const float b = wave_incl_sum(lf, lane), g = li - b, pm = wave_incl_max(g, lane), gmax = __shfl(pm, 63), blast = __shfl(b, 63);
        const float mprev = sMP[h * 256 + c];
        const float mt = fmaxf(b + mprev, b + pm);
        const float mnew = fmaxf(blast + mprev, blast + gmax);
        sb[lane] = b; sli[lane] = li; smt[lane] = mt; sws[lane] = expf(blast + g - mnew);
        sb[256 + lane] = expf(b + mprev - mt);
        EMT[(size_t)m * 4 + h] = expf(-mt);
        if (lane == 0) CDEC[c * 4 + h] = expf(blast + mprev - mnew);
    }
    __syncthreads();
    {
        const int d2 = tid & 127, tq = tid >> 7;
        const int dk = 2 * d2, r5 = dk & 31, pos = (dk & ~31) + 8 * ((r5 >> 2) & 3) + 4 * (r5 >> 4) + (r5 & 3);
        unsigned xw[2][19]; float cw0[2][4], cw1[2][4];
#pragma unroll
        for (int part = 0; part < 2; ++part) { const int col = part * 1024 + h * 256 + 2 * d2;
#pragma unroll
            for (int j = 0; j < 19; ++j) { const int mr = 64 * c + 16 * tq - 3 + j; xw[part][j] = (mr >= 0) ? *(const unsigned*)(P + (size_t)(mr >= 0 ? mr : 0) * EVEN_N + col) : 0u; }
#pragma unroll
            for (int j = 0; j < 4; ++j) { cw0[part][j] = conv_w[j * 2048 + col]; cw1[part][j] = conv_w[j * 2048 + col + 1]; } }
#pragma unroll
        for (int part = 0; part < 2; ++part) {
            unsigned kw0[8], kw1[8]; float p0 = 0.f, p1 = 0.f;
#pragma unroll
            for (int tt = 0; tt < 16; ++tt) {
                const int t = 16 * tq + tt, mr = 64 * c + t;
                float y0 = 0.f, y1 = 0.f;
#pragma unroll
                for (int j = 0; j < 4; ++j) { const unsigned w = xw[part][tt + j]; y0 += cw0[part][j] * bflo(w); y1 += cw1[part][j] * bfhi(w); }
                y0 = y0 * pg8::sigmoidf_fast(y0); y1 = y1 * pg8::sigmoidf_fast(y1);
                if (part == 0) { const float wq = sb[256 + t] * 0.0625f; *(LAS unsigned*)(sq + t * 528 + d2 * 4) = pk2(y0 * 0.0625f, y1 * 0.0625f); *(unsigned*)(QC + (size_t)mr * 1024 + h * 256 + pos) = pk2(y0 * wq, y1 * wq); }
                else { const float wsv = sws[t]; *(LAS unsigned*)(sk + t * 528 + d2 * 4) = pk2(y0, y1);
                    const float s0 = y0 * wsv, s1 = y1 * wsv;
                    if (tt & 1) { kw0[tt >> 1] = pk2(p0, s0); kw1[tt >> 1] = pk2(p1, s1); } else { p0 = s0; p1 = s1; } }
            }
            if (part == 1) { bf16* kr = KCT + (size_t)item * 16384 + (size_t)dk * 64 + 16 * tq;
                *(u32x4*)(kr) = (u32x4){kw0[0], kw0[1], kw0[2], kw0[3]}; *(u32x4*)(kr + 8) = (u32x4){kw0[4], kw0[5], kw0[6], kw0[7]};
                *(u32x4*)(kr + 64) = (u32x4){kw1[0], kw1[1], kw1[2], kw1[3]}; *(u32x4*)(kr + 72) = (u32x4){kw1[4], kw1[5], kw1[6], kw1[7]}; }
        }
    }
    __syncthreads();
    {
        const int wv = __builtin_amdgcn_readfirstlane(tid >> 6), ta = wv & 3, wh = wv >> 2, fr = lane & 15, fq = lane >> 4;
        f32x4 z0 = (f32x4){0.f, 0.f, 0.f, 0.f}, z1 = z0;
#pragma unroll
        for (int kk = 0; kk < 8; ++kk) { const bf16x8 af = *(const LAS bf16x8*)(sq + (16 * ta + fr) * 528 + (32 * kk + 8 * fq) * 2);
            const bf16x8 b0 = *(const LAS bf16x8*)(sk + (32 * wh + fr) * 528 + (32 * kk + 8 * fq) * 2), b1 = *(const LAS bf16x8*)(sk + (32 * wh + 16 + fr) * 528 + (32 * kk + 8 * fq) * 2);
            z0 = __builtin_amdgcn_mfma_f32_16x16x32_bf16(af, b0, z0, 0, 0, 0); z1 = __builtin_amdgcn_mfma_f32_16x16x32_bf16(af, b1, z1, 0, 0, 0); }
        const int s0 = 32 * wh + fr, s1 = s0 + 16; const float e0 = sli[s0] - sb[s0], e1 = sli[s1] - sb[s1];
#pragma unroll
        for (int r = 0; r < 4; ++r) { const int t = 16 * ta + 4 * fq + r; const float bm = sb[t] - smt[t];
            const float w0 = (s0 <= t) ? expf(bm + e0) : 0.f, w1 = (s1 <= t) ? expf(bm + e1) : 0.f;
            *(LAS unsigned short*)(sS + (t * 64 + s0) * 2) = (unsigned short)f2bf(z0[r] * w0); *(LAS unsigned short*)(sS + (t * 64 + s1) * 2) = (unsigned short)f2bf(z1[r] * w1); }
    }
    __syncthreads();
    *(u32x4*)(SB + (size_t)item * 4096 + tid * 8) = *(const LAS u32x4*)(sS + tid * 16);
#pragma unroll
    for (int i = 0; i < 12; ++i) { const int idx = tid + NTHR * i, s = idx / 96, p = idx % 96; LAS unsigned char* d = sVc + s * E2_VC_PITCH + p * 16;
        *(LAS u32x2*)d = (u32x2){vreg[i].x, vreg[i].y}; *(LAS u32x2*)(d + 8) = (u32x2){vreg[i].z, vreg[i].w}; }
    __syncthreads();
    {
        const int cp = lane >> 3, pc = lane & 7;
#pragma unroll
        for (int rd = 0; rd < 6; ++rd) {
            const int R = wave * 6 + rd, v0 = 16 * R + 2 * cp;
            unsigned x[8];
#pragma unroll
            for (int j = 0; j < 8; ++j) x[j] = *(const LAS unsigned*)(sVc + (8 * pc + j) * E2_VC_PITCH + v0 * 2);
            const u32x4 lo = (u32x4){__builtin_amdgcn_perm(x[1], x[0], 0x05040100u), __builtin_amdgcn_perm(x[3], x[2], 0x05040100u), __builtin_amdgcn_perm(x[5], x[4], 0x05040100u), __builtin_amdgcn_perm(x[7], x[6], 0x05040100u)};
            const u32x4 hi = (u32x4){__builtin_amdgcn_perm(x[1], x[0], 0x07060302u), __builtin_amdgcn_perm(x[3], x[2], 0x07060302u), __builtin_amdgcn_perm(x[5], x[4], 0x07060302u), __builtin_amdgcn_perm(x[7], x[6], 0x07060302u)};
            bf16* dst;
            if (R < 32) dst = VT + (size_t)item * 32768 + (size_t)v0 * 64 + 8 * pc;
            else { const int vb = v0 - 512; dst = VBT + ((size_t)(c * 8 + 2 * h + (vb >> 7)) * 128 + (vb & 127)) * 64 + 8 * pc; }
            *(u32x4*)dst = lo; *(u32x4*)(dst + 64) = hi;
        }
    }
}

constexpr int AT_Q = 0, AT_K = AT_Q + 64 * 272, AT_VT = AT_K + 64 * 272, AT_Z = AT_VT + 128 * 144, AT_W = AT_Z + 64 * 272, AT_MIN = AT_W + 64 * 144, AT_O = 0;
static_assert(AT_MIN + 64 <= RING_BYTES && 64 * 528 <= AT_VT, "attention LDS map");
#define AT_BAR() do { asm volatile("s_waitcnt lgkmcnt(0)" ::: "memory"); __builtin_amdgcn_s_barrier(); asm volatile("" ::: "memory"); } while (0)
__device__ __forceinline__ void e3_attn_item(int hb, int qt, const bf16* P, const bf16* QB2, const bf16* KB2, const bf16* VBT, bf16* MIX, LAS unsigned char* lds) {
    int tid = threadIdx.x; asm volatile("" : "+v"(tid));
    const int lane = tid & 63, wave = __builtin_amdgcn_readfirstlane(tid >> 6), fr = lane & 15, fq = lane >> 4;
    LAS unsigned char* sQ = lds + AT_Q; LAS unsigned char* sK = lds + AT_K; LAS unsigned char* sVT = lds + AT_VT; LAS unsigned char* sW = lds + AT_W;
    LAS float* sZ = (LAS float*)(lds + AT_Z); LAS float* sMin = (LAS float*)(lds + AT_MIN); LAS float* sO = (LAS float*)(lds + AT_O);
    const int q0 = qt * 64, t = tid >> 3, sg = tid & 7;
    const int ta = wave & 3, wh = wave >> 2;
    u32x4 rk[2], rv[2];
#pragma unroll
    for (int i = 0; i < 2; ++i) { const int idx = tid + NTHR * i; rk[i] = *(const u32x4*)(P + (size_t)(64 * qt + (idx >> 4)) * EVEN_N + 9216 + hb * 128 + (idx & 15) * 8); rv[i] = *(const u32x4*)(VBT + (size_t)(qt * 8 + hb) * 8192 + idx * 8); }
    __syncthreads();
#pragma unroll
    for (int i = 0; i < 2; ++i) { const int idx = tid + NTHR * i, row = idx >> 4, p = idx & 15;
        *(LAS u32x4*)(sQ + row * 272 + p * 16) = *(const u32x4*)(P + (size_t)(64 * qt + row) * EVEN_N + 8192 + hb * 128 + p * 8); }
    float R = 0.f; f32x4 acc[4];
#pragma unroll
    for (int e = 0; e < 4; ++e) acc[e] = (f32x4){0.f, 0.f, 0.f, 0.f};
    for (int kb = qt; kb >= 0; --kb) {
        const int k0 = kb * 64;
        AT_BAR();
#pragma unroll
        for (int i = 0; i < 2; ++i) { const int idx = tid + NTHR * i;
            *(LAS u32x4*)(sK + (idx >> 4) * 272 + (idx & 15) * 16) = rk[i];
            *(LAS u32x4*)(sVT + (idx >> 3) * 144 + (idx & 7) * 16) = rv[i]; }
        { const int kn = kb > 0 ? kb - 1 : 0;
#pragma unroll
            for (int i = 0; i < 2; ++i) { const int idx = tid + NTHR * i; rk[i] = *(const u32x4*)(P + (size_t)(64 * kn + (idx >> 4)) * EVEN_N + 9216 + hb * 128 + (idx & 15) * 8); rv[i] = *(const u32x4*)(VBT + (size_t)(kn * 8 + hb) * 8192 + idx * 8); } }
        AT_BAR();
        {
            f32x4 z0 = (f32x4){0.f, 0.f, 0.f, 0.f}, z1 = z0;
#pragma unroll
            for (int kk = 0; kk < 4; ++kk) { const bf16x8 af = *(const LAS bf16x8*)(sQ + (16 * ta + fr) * 272 + (32 * kk + 8 * fq) * 2);
                const bf16x8 b0 = *(const LAS bf16x8*)(sK + (32 * wh + fr) * 272 + (32 * kk + 8 * fq) * 2), b1 = *(const LAS bf16x8*)(sK + (32 * wh + 16 + fr) * 272 + (32 * kk + 8 * fq) * 2);
                z0 = __builtin_amdgcn_mfma_f32_16x16x32_bf16(af, b0, z0, 0, 0, 0); z1 = __builtin_amdgcn_mfma_f32_16x16x32_bf16(af, b1, z1, 0, 0, 0); }
#pragma unroll
            for (int r = 0; r < 4; ++r) { sZ[(16 * ta + 4 * fq + r) * 68 + 32 * wh + fr] = z0[r]; sZ[(16 * ta + 4 * fq + r) * 68 + 32 * wh + 16 + fr] = z1[r]; }
        }
        AT_BAR();
        {
            const f32x4 za = *(const LAS f32x4*)(sZ + t * 68 + 8 * sg), zb = *(const LAS f32x4*)(sZ + t * 68 + 8 * sg + 4);
            const float z[8] = {za.x, za.y, za.z, za.w, zb.x, zb.y, zb.z, zb.w};
            float sp[8], tot = 0.f;
#pragma unroll
            for (int i = 0; i < 8; ++i) { const bool ok = (k0 + 8 * sg + i) < (q0 + t); sp[i] = ok ? softplusf_fast(z[i]) : 0.f; tot += sp[i]; }
            float v = tot;
#pragma unroll
            for (int o = 1; o < 8; o <<= 1) { const float u = __shfl_down(v, o, 8); if (sg + o < 8) v += u; }
            const float rowtot = __shfl(v, 0, 8);
            float suf = R + (v - tot);
            float w[8];
#pragma unroll
            for (int i = 7; i >= 0; --i) { const bool ok = (k0 + 8 * sg + i) < (q0 + t); w[i] = ok ? __expf(z[i] - sp[i] - suf) : 0.f; suf += sp[i]; }
            *(LAS u32x4*)(sW + t * 144 + sg * 16) = (u32x4){pk2(w[0], w[1]), pk2(w[2], w[3]), pk2(w[4], w[5]), pk2(w[6], w[7])};
            R += rowtot;
            const float mn = wave_min(R);
            if (lane == 0) sMin[wave] = mn;
        }
        AT_BAR();
        {
#pragma unroll
            for (int kk = 0; kk < 2; ++kk) { const bf16x8 af = *(const LAS bf16x8*)(sW + (16 * ta + fr) * 144 + (32 * kk + 8 * fq) * 2);
#pragma unroll
                for (int e = 0; e < 4; ++e) { const bf16x8 bfr = *(const LAS bf16x8*)(sVT + (16 * (4 * wh + e) + fr) * 144 + (32 * kk + 8 * fq) * 2);
                    acc[e] = __builtin_amdgcn_mfma_f32_16x16x32_bf16(af, bfr, acc[e], 0, 0, 0); } }
        }
        float mn = sMin[0];
#pragma unroll
        for (int w = 1; w < 8; ++w) mn = fminf(mn, sMin[w]);
        if (mn > SB_EXIT) break;
    }
    __syncthreads();
#pragma unroll
    for (int e = 0; e < 4; ++e)
#pragma unroll
        for (int r = 0; r < 4; ++r) sO[(16 * ta + 4 * fq + r) * 132 + 16 * (4 * wh + e) + fr] = acc[e][r];
    __syncthreads();
    {
        const size_t m = (size_t)(q0 + t);
#pragma unroll
        for (int half = 0; half < 2; ++half) { const int d0 = 64 * half + 8 * sg;
            const f32x4 oa = *(const LAS f32x4*)(sO + t * 132 + d0), ob = *(const LAS f32x4*)(sO + t * 132 + d0 + 4);
            float zf[8]; unpack8(*(const u32x4*)(P + m * EVEN_N + 11264 + hb * 128 + d0), zf);
            u32x4 o; o.x = pk2(oa.x * zf[0], oa.y * zf[1]); o.y = pk2(oa.z * zf[2], oa.w * zf[3]); o.z = pk2(ob.x * zf[4], ob.y * zf[5]); o.w = pk2(ob.z * zf[6], ob.w * zf[7]);
            *(u32x4*)(MIX + m * EVEN_MIX + 2048 + hb * 128 + d0) = o; }
    }
}

#define SC_BAR() do { asm volatile("s_waitcnt lgkmcnt(0)" ::: "memory"); __builtin_amdgcn_s_barrier(); asm volatile("" ::: "memory"); } while (0)
constexpr int SC_SLICES = 8, SC_ITEMS = 4 * (SC_SLICES + 1) * 2;
constexpr int SC_SQ = 0, SC_SS = 16384, SC_SWI = 24576, SC_SVT = 25088, SC_SKT = 33280, SC_SET = 49664;
constexpr int SC_NSET = 3, SC_PUB = 32;
static_assert(SC_NSET * SC_SET <= RING_BYTES, "scan LDS map");
__device__ __forceinline__ void e3_scan_item(int h, int sl, int half, const bf16* QC, const bf16* KCT, const bf16* SB, const bf16* VT, const float* WINTER, const float* CDEC,
                                             float* NUM, float* DENR, const bf16* ONES, unsigned* prog, LAS unsigned char* lds) {
    int tid = threadIdx.x; asm volatile("" : "+v"(tid));
    const int lane = tid & 63, wave = __builtin_amdgcn_readfirstlane(tid >> 6), fr = lane & 15, fq = lane >> 4;
    const bool ones = (sl == SC_SLICES);
    __syncthreads();
    if (wave & 2) {
        const int wl = (wave & 1) | ((wave >> 2) << 1), rr = lane >> 2, q = (lane & 3) ^ ((rr & 8) ? 2 : 0);
        const unsigned offQ = (unsigned)(rr * 1024 + q * 8) * 2u, off64 = (unsigned)(rr * 64 + q * 8) * 2u;
        const char* gQ = (const char*)(QC + (size_t)(16 * wl) * 1024 + h * 256 + 128 * half) + offQ;
        const char* gK = (const char*)(KCT + (size_t)h * 16384 + (size_t)(128 * half + 32 * wl) * 64) + off64;
        const char* gS = (const char*)(SB + (size_t)h * 4096 + (size_t)(16 * (2 * half + (wl >> 1))) * 64) + off64 + (wl & 1) * 64;
        const int vrow = 32 * (wl >> 1) + 8 * (rr >> 2) + 4 * (wl & 1) + (rr & 3);
        const char* gV = (ones ? (const char*)ONES + (size_t)(16 * wl) * 128 + off64 : (const char*)(VT + (size_t)h * 32768 + (size_t)(64 * sl) * 64) + (size_t)vrow * 128 + (size_t)(q * 16));
        const float* gC = CDEC + h;
#define SC_DMA16(src, dstoff) __builtin_amdgcn_global_load_lds((const unsigned*)(src), (LAS unsigned*)(lds + (dstoff)), 16, 0, 0)
#define SC_DMA4(src, dstoff) __builtin_amdgcn_global_load_lds((const unsigned*)(src), (LAS unsigned*)(lds + (dstoff)), 4, 0, 0)
#define SC_DMA(cc, setoff) do { const int _c = (cc) < 255 ? (cc) : 255; const int _so = (setoff); \
            _Pragma("unroll") for (int kt = 0; kt < 4; ++kt) SC_DMA16(gQ + (size_t)_c * 131072 + kt * 64, _so + SC_SQ + (wl * 4 + kt) * 1024); \
            _Pragma("unroll") for (int j = 0; j < 4; ++j) SC_DMA16(gK + (size_t)_c * 131072 + (j >> 1) * 2048 + (j & 1) * 64, _so + SC_SKT + ((2 * wl + (j >> 1)) * 2 + (j & 1)) * 1024); \
            SC_DMA16(gS + (size_t)_c * 32768, _so + SC_SS + wl * 1024); \
            _Pragma("unroll") for (int k2 = 0; k2 < 2; ++k2) SC_DMA16(gV + (ones ? (size_t)0 : (size_t)_c * 262144) + k2 * 64, _so + SC_SVT + (wl * 2 + k2) * 1024); \
            SC_DMA4(gC + _c * 4, _so + SC_SWI + 256); } while (0)
        SC_DMA(0, 0); SC_DMA(1, SC_SET);
        asm volatile("s_waitcnt vmcnt(12)" ::: "memory");
        int so2 = 2 * SC_SET;
        for (int c = 0; c < 256; ++c) {
            SC_BAR();
            SC_DMA(c + 2, so2);
            asm volatile("s_waitcnt vmcnt(12)" ::: "memory");
            so2 = (so2 == 2 * SC_SET) ? 0 : so2 + SC_SET;
        }
        asm volatile("s_waitcnt vmcnt(0)" ::: "memory");
        SC_BAR();
#undef SC_DMA16
#undef SC_DMA4
#undef SC_DMA
    } else if (wave < 2) {
        f32x4 C[2][8];
#pragma unroll
        for (int u = 0; u < 2; ++u)
#pragma unroll
            for (int i = 0; i < 8; ++i) C[u][i] = (f32x4){0.f, 0.f, 0.f, 0.f};
        const int lo = fr * 64 + ((fq ^ ((fr >> 3) << 1)) * 16);
        int sco = 0;
        bf16* NUMh = (bf16*)NUM + (size_t)half * ((size_t)M * 2048); float* DENRh = DENR + (size_t)half * ((size_t)M * 4);
        __builtin_amdgcn_s_setprio(2);
        for (int c = 0; c < 256; ++c) {
            if (c > 0 && (c & (SC_PUB - 1)) == 0) asm volatile("s_waitcnt vmcnt(0)" ::: "memory");
            SC_BAR();
            const LAS unsigned char* sb_ = lds + sco; sco = (sco == 2 * SC_SET) ? 0 : sco + SC_SET;
            const LAS unsigned char* qbase = sb_ + SC_SQ + lo; const LAS unsigned char* sbase = sb_ + SC_SS + lo; const LAS unsigned char* kbase = sb_ + SC_SKT + lo;
            const LAS float* sWI = (const LAS float*)(sb_ + SC_SWI);
#define SC_LD4(F, base, s1) do { _Pragma("unroll") for (int _j = 0; _j < 4; ++_j) F[_j] = *(const LAS bf16x8*)((base) + _j * (s1)); } while (0)
#define SC_SB __builtin_amdgcn_sched_barrier(0)
#define SC_USE4(F) asm volatile("" :: "v"(F[0]), "v"(F[1]), "v"(F[2]), "v"(F[3]))
#define SC_CVT(dst, t) do { _Pragma("unroll") for (int _u = 0; _u < 2; ++_u) { \
                const u32x4 _w = (u32x4){pk2n(C[_u][t][0], C[_u][t][1]), pk2n(C[_u][t][2], C[_u][t][3]), pk2n(C[_u][(t) + 1][0], C[_u][(t) + 1][1]), pk2n(C[_u][(t) + 1][2], C[_u][(t) + 1][3])}; dst[_u] = __builtin_bit_cast(bf16x8, _w); } } while (0)
#define SC_INTER(cbv, F) do { _Pragma("unroll") for (int _u = 0; _u < 2; ++_u) _Pragma("unroll") for (int _a = 0; _a < 4; ++_a) o[_u][_a] = __builtin_amdgcn_mfma_f32_16x16x32_bf16(cbv[_u], F[_a], o[_u][_a], 0, 0, 0); } while (0)
#define SC_SCALE(t) do { _Pragma("unroll") for (int _u = 0; _u < 2; ++_u) { C[_u][t] = C[_u][t] * cdec; C[_u][(t) + 1] = C[_u][(t) + 1] * cdec; asm volatile("" : "+v"(C[_u][t]), "+v"(C[_u][(t) + 1])); } } while (0)
#define SC_MIX(nv) do { _Pragma("unroll") for (int _g = 0; _g < 8; ++_g) { __builtin_amdgcn_sched_group_barrier(0x008, 1, 0); __builtin_amdgcn_sched_group_barrier(0x002, nv, 0); } } while (0)
#define SC_UPD(F, b, k) do { _Pragma("unroll") for (int _i = 0; _i < 4; ++_i) _Pragma("unroll") for (int _u = 0; _u < 2; ++_u) \
                C[_u][4 * (b) + _i] = __builtin_amdgcn_mfma_f32_16x16x32_bf16(F[_i], v[_u][k], C[_u][4 * (b) + _i], 0, 0, 0); } while (0)
            {
                bf16x8 v[2][2], F0[4], F1[4], cba[2], cbb[2]; f32x4 o[2][4];
                const float cdec = sWI[64];
#pragma unroll
                for (int u = 0; u < 2; ++u)
#pragma unroll
                    for (int a = 0; a < 4; ++a) o[u][a] = (f32x4){0.f, 0.f, 0.f, 0.f};
                SC_LD4(F0, qbase, 4096);
                SC_CVT(cba, 0);
                SC_SB;
                SC_USE4(F0); SC_SB; SC_LD4(F1, qbase + 1024, 4096);
#pragma unroll
                for (int u = 0; u < 2; ++u)
#pragma unroll
                    for (int k2 = 0; k2 < 2; ++k2) v[u][k2] = *(const LAS bf16x8*)(sb_ + SC_SVT + (2 * (2 * wave + u) + k2) * 1024 + lo);
                SC_SB; SC_INTER(cba, F0); SC_CVT(cbb, 2); SC_SCALE(0); SC_MIX(2); SC_SB;
                SC_USE4(F1); SC_SB; SC_LD4(F0, qbase + 2048, 4096); SC_SB; SC_INTER(cbb, F1); SC_CVT(cba, 4); SC_SCALE(2); SC_MIX(2); SC_SB;
                SC_USE4(F0); SC_SB; SC_LD4(F1, qbase + 3072, 4096); SC_SB; SC_INTER(cba, F0); SC_CVT(cbb, 6); SC_SCALE(4); SC_MIX(2); SC_SB;
                SC_USE4(F1); SC_SB; SC_LD4(F0, sbase, 1024); SC_SB; SC_INTER(cbb, F1); SC_SCALE(6); SC_MIX(1); SC_SB;
                SC_USE4(F0); SC_SB; SC_LD4(F1, kbase, 2048); SC_SB;
                if (half == 0) {
#pragma unroll
                    for (int k2 = 0; k2 < 2; ++k2)
#pragma unroll
                        for (int a = 0; a < 2; ++a)
#pragma unroll
                            for (int u = 0; u < 2; ++u) o[u][a] = __builtin_amdgcn_mfma_f32_16x16x32_bf16(v[u][k2], F0[a * 2 + k2], o[u][a], 0, 0, 0);
                } else {
#pragma unroll
                    for (int k2 = 0; k2 < 2; ++k2)
#pragma unroll
                        for (int a = 0; a < 2; ++a)
#pragma unroll
                            for (int u = 0; u < 2; ++u) o[u][2 + a] = __builtin_amdgcn_mfma_f32_16x16x32_bf16(v[u][k2], F0[a * 2 + k2], o[u][2 + a], 0, 0, 0);
                }
                SC_SB;
                SC_USE4(F1); SC_SB; SC_LD4(F0, kbase + 1024, 2048); SC_SB;
                if (!ones) {
                    SC_UPD(F1, 0, 0);
#pragma unroll
                    for (int a = 0; a < 4; ++a) { const size_t mrow = (size_t)(64 * c + 16 * a + fr);
                        *(u32x4*)(NUMh + mrow * 2048 + h * 512 + 64 * sl + 32 * wave + 8 * fq) = (u32x4){pk2n(o[0][a][0], o[0][a][1]), pk2n(o[0][a][2], o[0][a][3]), pk2n(o[1][a][0], o[1][a][1]), pk2n(o[1][a][2], o[1][a][3])}; }
                    SC_MIX(2);
                } else {
                    SC_UPD(F1, 0, 0);
#pragma unroll
                    for (int a = 0; a < 4; ++a) { const size_t mrow = (size_t)(64 * c + 16 * a + fr); if (wave == 0 && fq == 0) DENRh[mrow * 4 + h] = o[0][a][0]; }
                }
                SC_SB;
                SC_USE4(F0); SC_SB; SC_LD4(F1, kbase + 8192, 2048); SC_SB; SC_UPD(F0, 0, 1); SC_SB;
                SC_USE4(F1); SC_SB; SC_LD4(F0, kbase + 8192 + 1024, 2048); SC_SB; SC_UPD(F1, 1, 0); SC_SB;
                SC_UPD(F0, 1, 1); SC_SB;
            }
#undef SC_LD4
#undef SC_SB
#undef SC_USE4
#undef SC_INTER
#undef SC_CVT
#undef SC_SCALE
#undef SC_MIX
#undef SC_UPD
        }
        __builtin_amdgcn_s_setprio(0);
        asm volatile("s_waitcnt vmcnt(0)" ::: "memory");
        SC_BAR();
    } else {
        for (int c = 0; c <= 256; ++c) {
            SC_BAR();
            if (wave == 4 && c > 0 && (c & (SC_PUB - 1)) == 0) {
                __builtin_amdgcn_fence(__ATOMIC_RELEASE, "agent");
                asm volatile("s_waitcnt vmcnt(0)" ::: "memory");
                if (lane == 0) __hip_atomic_store(prog, (unsigned)c, __ATOMIC_RELAXED, __HIP_MEMORY_SCOPE_AGENT);
            }
        }
    }
}

__device__ __forceinline__ void e4_step(int it0, int stride, const float* NUM, const float* DENR, const float* EMT, const bf16* P, const float* hnw, bf16* MIX, int lane) {
    u32x4 ra[2], rb[2], ro[2], rz[2]; float dn[2], em[2]; f32x4 w0[2], w1[2];
#pragma unroll
    for (int q = 0; q < 2; ++q) { const int it = it0 + q * stride < M * 4 ? it0 + q * stride : it0; const int m = it >> 2, h = it & 3;
        const bf16* NB0 = (const bf16*)NUM + (size_t)m * 2048 + h * 512 + lane * 8;
        ra[q] = *(const u32x4*)NB0; rb[q] = *(const u32x4*)(NB0 + (size_t)M * 2048);
        ro[q] = *(const u32x4*)(P + (size_t)m * EVEN_N + 4096 + h * 512 + lane * 8); rz[q] = *(const u32x4*)(P + (size_t)m * EVEN_N + 6144 + h * 512 + lane * 8);
        dn[q] = DENR[(size_t)m * 4 + h] + DENR[(size_t)M * 4 + (size_t)m * 4 + h]; em[q] = EMT[(size_t)m * 4 + h];
        w0[q] = *(const f32x4*)(hnw + h * 512 + lane * 8); w1[q] = *(const f32x4*)(hnw + h * 512 + lane * 8 + 4); }
#pragma unroll
    for (int q = 0; q < 2; ++q) { const int it = it0 + q * stride; if (it >= M * 4) break; const int m = it >> 2, h = it & 3;
        float na[8], nb[8], og[8], zg[8]; unpack8(ra[q], na); unpack8(rb[q], nb); unpack8(ro[q], og); unpack8(rz[q], zg);
        const float rd = 1.0f / fmaxf(fabsf(dn[q]), em[q]);
        float v[8]; float s = 0.f;
#pragma unroll
        for (int e = 0; e < 8; ++e) { v[e] = (na[e] + nb[e]) * rd * og[e]; s += v[e]; }
        const float mean = wave_sum(s) * (1.f / 512.f); float s2 = 0.f;
#pragma unroll
        for (int e = 0; e < 8; ++e) { v[e] -= mean; s2 += v[e] * v[e]; }
        const float rstd = 1.f / sqrtf(wave_sum(s2) * (1.f / 512.f) + LN_EPS);
        const float wv[8] = {w0[q].x, w0[q].y, w0[q].z, w0[q].w, w1[q].x, w1[q].y, w1[q].z, w1[q].w};
#pragma unroll
        for (int e = 0; e < 8; ++e) v[e] = v[e] * rstd * wv[e] * zg[e];
        u32x4 o; o.x = pk2(v[0], v[1]); o.y = pk2(v[2], v[3]); o.z = pk2(v[4], v[5]); o.w = pk2(v[6], v[7]);
        *(u32x4*)(MIX + (size_t)m * EVEN_MIX + h * 512 + lane * 8) = o; }
}
__device__ __forceinline__ void phase_e4(const float* NUM, const float* DENR, const float* EMT, const bf16* P, const float* hnw, bf16* MIX, int G) {
    int tid = threadIdx.x; asm volatile("" : "+v"(tid));
    const int lane = tid & 63, wave = tid >> 6;
    const int gw = blockIdx.x * NWAVES + wave, NGW = G * NWAVES;
    for (int it0 = gw; it0 < M * 4; it0 += 2 * NGW) e4_step(it0, NGW, NUM, DENR, EMT, P, hnw, MIX, lane);
}
__device__ __forceinline__ void e4_fused(int bq, int nb, const unsigned* prog, const float* NUM, const float* DENR, const float* EMT, const bf16* P, const float* hnw, bf16* MIX, LAS unsigned char* lds) {
    int tid = threadIdx.x; asm volatile("" : "+v"(tid));
    const int lane = tid & 63, wave = __builtin_amdgcn_readfirstlane(tid >> 6);
    const int NGW = nb * NWAVES;
    volatile LAS unsigned* sHave = (volatile LAS unsigned*)(lds + MISC_OFF) + 16;
    unsigned have = 0u;
    for (int base = bq * NWAVES; base < M * 4; base += 2 * NGW) {
        int last = base + NWAVES - 1 + NGW; last = last < M * 4 ? last : M * 4 - 1;
        const unsigned need = (unsigned)((last >> 2) >> 6) + 1u;
        if (have < need) {
            __syncthreads();
            if (wave == 0) {
                unsigned mn, sp = 0u;
                for (;;) {
                    unsigned a0 = __hip_atomic_load(prog + lane, __ATOMIC_RELAXED, __HIP_MEMORY_SCOPE_AGENT);
                    unsigned a1 = (lane < SC_ITEMS - 64) ? __hip_atomic_load(prog + 64 + lane, __ATOMIC_RELAXED, __HIP_MEMORY_SCOPE_AGENT) : 256u;
                    a0 = a0 < a1 ? a0 : a1;
#pragma unroll
                    for (int o = 32; o >= 1; o >>= 1) { const unsigned u = (unsigned)__shfl_xor((int)a0, o); a0 = a0 < u ? a0 : u; }
                    mn = a0;
                    if (mn >= need || ++sp > (1u << 16)) break;
                    __builtin_amdgcn_s_sleep(64);
                }
                __builtin_amdgcn_fence(__ATOMIC_ACQUIRE, "agent");
                asm volatile("s_waitcnt vmcnt(0)" ::: "memory");
                if (lane == 0) sHave[0] = mn;
            }
            __syncthreads();
            have = sHave[0];
        }
        e4_step(base + wave, NGW, NUM, DENR, EMT, P, hnw, MIX, lane);
    }
}

__device__ __forceinline__ void phase_o2(const bf16* P2, const float* pool_b, const float* pool_s, bf16* H, int G) {
    int tid = threadIdx.x; asm volatile("" : "+v"(tid));
    const int gt = blockIdx.x * NTHR + tid, NT = G * NTHR;
    for (int idx = gt; idx < 256 * 512; idx += NT) {
        const int cg = idx & 511, run = idx >> 9, g = cg >> 7, w = 2 << g, t0 = run * 64;
        const bf16* src = P2 + cg * 8;
        const f32x4 b0 = *(const f32x4*)(pool_b + cg * 8), b1 = *(const f32x4*)(pool_b + cg * 8 + 4), s0 = *(const f32x4*)(pool_s + cg * 8), s1 = *(const f32x4*)(pool_s + cg * 8 + 4);
        const float pb[8] = {b0.x, b0.y, b0.z, b0.w, b1.x, b1.y, b1.z, b1.w}, ps[8] = {s0.x, s0.y, s0.z, s0.w, s1.x, s1.y, s1.z, s1.w};
        float sum[8];
#pragma unroll
        for (int e = 0; e < 8; ++e) sum[e] = 0.f;
        for (int t = t0 - w + 1; t < t0; ++t) if (t >= 0) { float f[8]; unpack8(*(const u32x4*)(src + (size_t)t * ODD_IN), f);
#pragma unroll
            for (int e = 0; e < 8; ++e) sum[e] += f[e]; }
        for (int t = t0; t < t0 + 64; t += 4) {
            u32x4 rc[4], rz[4], ro[4];
#pragma unroll
            for (int j = 0; j < 4; ++j) { rc[j] = *(const u32x4*)(src + (size_t)(t + j) * ODD_IN); rz[j] = *(const u32x4*)(src + (size_t)(t + j) * ODD_IN + 4096);
                const int to = t + j - w + 1; ro[j] = *(const u32x4*)(src + (size_t)(to >= 0 ? to : 0) * ODD_IN); }
#pragma unroll
            for (int j = 0; j < 4; ++j) {
                float cur[8], zf[8]; unpack8(rc[j], cur); unpack8(rz[j], zf);
#pragma unroll
                for (int e = 0; e < 8; ++e) sum[e] += cur[e];
                const int tt = t + j; const float inv = 1.0f / (float)((tt + 1) < w ? (tt + 1) : w);
                float o[8];
#pragma unroll
                for (int e = 0; e < 8; ++e) o[e] = ((sum[e] * inv - cur[e]) + pb[e]) * ps[e] * zf[e];
                *(u32x4*)(H + (size_t)tt * D + cg * 8) = (u32x4){pk2(o[0], o[1]), pk2(o[2], o[3]), pk2(o[4], o[5]), pk2(o[6], o[7])};
                if (tt - w + 1 >= 0) { float old[8]; unpack8(ro[j], old);
#pragma unroll
                    for (int e = 0; e < 8; ++e) sum[e] -= old[e]; }
            }
        }
    }
}

constexpr int N_PHASES = 24;
__global__ void __launch_bounds__(NTHR, 2) fwd_kernel(Args a) {
    extern __shared__ __attribute__((aligned(16))) unsigned char lds_raw[];
    LAS unsigned char* lds = (LAS unsigned char*)lds_raw;
    const int tid = threadIdx.x, G = gridDim.x;
    unsigned char* ws = a.ws;
    for (int u = tid; u < (LDS_BYTES - LDSCTL_OFF) / 4; u += NTHR) ((LAS unsigned*)(lds + LDSCTL_OFF))[u] = 0u;
    __syncthreads();
    unsigned* barw = (unsigned*)(ws + WS_CTL) + CW_BAR;
    XcdBarrier bar; bar.bar = barw; bar.x = 0; bar.st = nullptr;
    if (!MK_MULTI) bar = xcd_barrier_post(barw, (volatile LAS unsigned*)(lds + MISC_OFF) + 8);
    const int lo = a.ph_lo, hi = a.ph_hi;
#define IN(k) (lo <= (k) && (k) < hi)
#define SEAM(k) do { if (!MK_MULTI && IN(k) && IN((k) + 1)) xcd_barrier_next(bar); } while (0)
#define SEAM0(k) do { if (!MK_MULTI && IN(k) && IN((k) + 1)) xcd_barrier(bar); } while (0)

    float* MOD = (float*)(ws + WS_MOD); float* GATES = (float*)(ws + WS_GATES);
    bf16* U = (bf16*)(ws + WS_U); float* T = (float*)(ws + WS_T); bf16* YB = (bf16*)(ws + WS_T); bf16* XH = (bf16*)(ws + WS_T + 128 * MiB);     bf16* P = (bf16*)(ws + WS_P); bf16* MIX = (bf16*)(ws + WS_MIX);
    float* NUM = (float*)(ws + WS_NUM2); bf16* POOLED = (bf16*)(ws + WS_NUM);
    float* WINTER = (float*)(ws + WS_WINTER); float* EMT = (float*)(ws + WS_EMT); float* CDEC = (float*)(ws + WS_CDEC); float* DENR = (float*)(ws + WS_DENR); float* BLWM = (float*)(ws + WS_CDEC + 65536);
    bf16* SB = (bf16*)(ws + WS_S); bf16* QC = (bf16*)(ws + WS_QC); bf16* KC = (bf16*)(ws + WS_KC); bf16* VT = (bf16*)(ws + WS_VT); bf16* VBT = (bf16*)(ws + WS_VBT); bf16* QB2 = (bf16*)(ws + WS_T); bf16* KB2 = (bf16*)(ws + WS_T + 32 * MiB);

    float* BIAS = (float*)(ws + WS_BIAS);
    if (IN(0)) { phase_mods(a, lds, G); } SEAM0(0);
    if (IN(1)) { for (int rep = 0; rep < REP_P0; ++rep) phase_weights(a, lds, G); } SEAM(1);
    if (IN(2)) {
#pragma unroll 1
        for (int lp = 0; lp < 2; ++lp) {
            const bf16* wbp = (const bf16*)(ws + WS_W + (size_t)lp * W_PAIR);
            const bf16* Wt_pool_ = (const bf16*)((const unsigned char*)wbp + W_IN_E + W_OUT_E + W_IN_O); bf16* Wt_in_o_ = (bf16*)((unsigned char*)wbp + W_IN_E + W_OUT_E);
            pg8::Gemm g{Wt_pool_, (const bf16*)(ws + WS_P) + (size_t)lp * D * D, D, D, 1024, 1024, D, 0, 4}; pg8::StaticOrder S; S.init(D, D, G, (int)blockIdx.x);
            pg8::EpiColScale E{Wt_in_o_, D, MOD + (2 * lp + 1) * 12288 + D}; pg8::gemm_phase<pg8::EpiColScale, pg8::StaticOrder, true>(lds, g, S, E);
        }
    }
    if (IN(3)) { phase_rows<true, false, false>(a.in[I_X], nullptr, nullptr, nullptr, nullptr, U, nullptr, (const bf16*)(ws + WS_WG), (const float*)(ws + WS_WG + 262144), GATES, lds, G); } SEAM(3);

#pragma unroll 1
    for (int lp = 0; lp < 2; ++lp) {
        const int pb = 4 + 10 * lp;
        const bf16* wb = (const bf16*)(ws + WS_W + (size_t)lp * W_PAIR);
        const bf16* Wt_in_e = wb; const bf16* Wt_out_e = (const bf16*)((const unsigned char*)wb + W_IN_E); const bf16* Wt_in_o = (const bf16*)((const unsigned char*)wb + W_IN_E + W_OUT_E);
        const bf16* Wt_pool = (const bf16*)((const unsigned char*)wb + W_IN_E + W_OUT_E + W_IN_O); const bf16* Wt_out_o = (const bf16*)((const unsigned char*)wb + W_IN_E + W_OUT_E + W_IN_O + W_POOL);
        const float* conv_w = lp ? a.in[24] : a.in[5]; const float* igb = lp ? a.in[25] : a.in[6]; const float* fgb = lp ? a.in[26] : a.in[7]; const float* hnw = lp ? a.in[27] : a.in[8];
        const float* lng_e = lp ? a.in[29] : a.in[10]; const float* lnb_e = lp ? a.in[30] : a.in[11];
        const float* pool_b = lp ? a.in[35] : a.in[16]; const float* pool_s = lp ? a.in[36] : a.in[17];
        const float* lng_o = lp ? a.in[38] : a.in[19]; const float* lnb_o = lp ? a.in[39] : a.in[20];
        const float* xcur_e = lp ? (const float*)a.out : a.in[I_X];
        const float* mod_e = MOD + (2 * lp) * 12288; const float* mod_o = MOD + (2 * lp + 1) * 12288;

        if (IN(pb + 0)) { chunk_gate_sums(GATES, igb, fgb, BLWM, G);
            pg8::Gemm g{U, Wt_in_e, M, EVEN_N, D, D, D, 0, 0}; pg8::StaticOrder S; S.init(M, EVEN_N, G, (int)blockIdx.x);
            pg8::EpiAct E{P, EVEN_N, 0, BIAS + (2 * lp) * 12288}; pg8::gemm_phase<pg8::EpiAct, pg8::StaticOrder, true>(lds, g, S, E); }
        SEAM(pb + 0);
        if (IN(pb + 1)) for (int rep = 0; rep < REP_E2; ++rep) {
            e2_preamble(BLWM, lds);
            for (int it = blockIdx.x; it < 1024; it += G) e2_prep_item(it >> 2, it & 3, P, conv_w, GATES, igb, fgb, QC, KC, SB, VT, VBT, QB2, KB2, WINTER, EMT, CDEC, lds);
        }
        SEAM(pb + 1);
        const bool fusedE4 = G > 2 * SC_ITEMS;
        unsigned* PROG = (unsigned*)(ws + WS_CTL + 32768) + lp * 128;
        if (IN(pb + 2)) for (int rep = 0; rep < REP_E3; ++rep) {
            const int nscan = G > 2 * SC_ITEMS ? SC_ITEMS : 0;
#define SC_CALL(it) e3_scan_item(((it) >> 1) / (SC_SLICES + 1), ((it) >> 1) % (SC_SLICES + 1), (it) & 1, QC, KC, SB, VT, WINTER, CDEC, NUM, DENR, (const bf16*)(ws + WS_CDEC + 131072), PROG + (it), lds)
            if ((int)blockIdx.x < nscan) { const int g_ = (int)blockIdx.x & 7, s_ = (int)blockIdx.x >> 3; SC_CALL(((g_ >> 1) * (SC_SLICES + 1) + s_) * 2 + (g_ & 1)); }
            else {
                if (nscan == 0) for (int it = blockIdx.x; it < SC_ITEMS; it += G) SC_CALL(it);
                for (int it = blockIdx.x - nscan; it < 2048; it += G - nscan) { const int r = 2047 - it; e3_attn_item(r & 7, r >> 3, P, QB2, KB2, VBT, MIX, lds); }
                if (nscan) e4_fused((int)blockIdx.x - nscan, G - nscan, PROG, NUM, DENR, EMT, P, hnw, MIX, lds);
            }
#undef SC_CALL
        }
        if (!fusedE4 || MK_MULTI) SEAM(pb + 2);
        if (IN(pb + 3) && !fusedE4) { phase_e4(NUM, DENR, EMT, P, hnw, MIX, G); }
        SEAM(pb + 3);
        if (IN(pb + 4)) { pg8::Gemm g{MIX, Wt_out_e, M, D, EVEN_MIX, EVEN_MIX, EVEN_MIX, 0, 0}; pg8::StaticOrder S; S.init(M, D, G, (int)blockIdx.x);
            pg8::EpiAct E{YB, D, 2, nullptr}; pg8::gemm_phase<pg8::EpiAct, pg8::StaticOrder, true>(lds, g, S, E); }
        SEAM(pb + 4);
        if (IN(pb + 5)) for (int rep = 0; rep < REP_ROWS; ++rep) {
            if (lp == 0) phase_rows<false, false, false>(a.in[I_X], YB, mod_e + 2 * D, lng_e, lnb_e, U, XH, nullptr, nullptr, nullptr, lds, G);
            else phase_rows<false, true, false>(XH, YB, mod_e + 2 * D, lng_e, lnb_e, U, XH, nullptr, nullptr, nullptr, lds, G);
        }
        SEAM(pb + 5);
        if (IN(pb + 6)) { pg8::Gemm g{U, Wt_in_o, M, ODD_IN, D, D, D, 0, 0}; pg8::StaticOrder S; S.init(M, ODD_IN, G, (int)blockIdx.x);
            pg8::EpiAct E{P, ODD_IN, 1, BIAS + (2 * lp + 1) * 12288}; pg8::gemm_phase<pg8::EpiAct, pg8::StaticOrder, true>(lds, g, S, E); }
        SEAM(pb + 6);
        if (IN(pb + 7)) { phase_o2(P, pool_b, pool_s, MIX, G); }
        SEAM(pb + 7);
        if (IN(pb + 8)) for (int rep = 0; rep < REP_GEMM; ++rep) { pg8::Gemm g{MIX, Wt_out_o, M, D, D, D, D, 0, 0}; pg8::StaticOrder S; S.init(M, D, G, (int)blockIdx.x);
            pg8::EpiAct E{YB, D, 2, nullptr}; pg8::gemm_phase<pg8::EpiAct, pg8::StaticOrder, true>(lds, g, S, E); }
        SEAM(pb + 8);
        if (IN(pb + 9)) {
            if (lp == 0) phase_rows<false, true, false>(XH, YB, mod_o + 2 * D, lng_o, lnb_o, U, XH, (const bf16*)(ws + WS_WG) + 8 * D, (const float*)(ws + WS_WG + 262144) + 8, GATES, lds, G);
            else phase_rows<false, true, true>(XH, YB, mod_o + 2 * D, lng_o, lnb_o, a.out, nullptr, nullptr, nullptr, nullptr, lds, G);
        }
        SEAM(pb + 9);
    }
#undef IN
#undef SEAM
}

extern "C" void kernel_launch(void* const* d_in, const int* in_sizes, int n_in, void* d_out, int out_size, void* d_ws, size_t ws_size, hipStream_t stream) {
    static int grid = 0;
    if (grid == 0) {
        if (n_in != 40 || in_sizes[0] != M * D || out_size != M * D || ws_size < WS_END) { fprintf(stderr, "kernel_launch: unexpected shapes (n_in %d, in0 %d, out %d, ws %zu < %zu)\n", n_in, n_in > 0 ? in_sizes[0] : -1, out_size, ws_size, (size_t)WS_END); grid = -1; return; }
        int dev = 0, cus = 0, per_cu = 0;
        if (hipGetDevice(&dev) != hipSuccess || hipDeviceGetAttribute(&cus, hipDeviceAttributeMultiprocessorCount, dev) != hipSuccess) { grid = -1; return; }
        if (hipFuncSetAttribute((const void*)fwd_kernel, hipFuncAttributeMaxDynamicSharedMemorySize, LDS_BYTES) != hipSuccess) { fprintf(stderr, "kernel_launch: hipFuncSetAttribute failed\n"); grid = -1; return; }
        if (hipOccupancyMaxActiveBlocksPerMultiprocessor(&per_cu, (const void*)fwd_kernel, NTHR, LDS_BYTES) != hipSuccess || per_cu < 1)
            fprintf(stderr, "kernel_launch: note: occupancy query reports %d workgroups per CU\n", per_cu);
        (void)hipGetLastError();
        grid = cus;
    }
    if (grid < 0) return;
    if (hipMemsetAsync((char*)d_ws + WS_CTL, 0, CTL_ZERO_BYTES, stream) != hipSuccess) return;
    Args a{};
    for (int i = 0; i < 40; ++i) a.in[i] = (const float*)d_in[i];
    a.out = (float*)d_out; a.ws = (unsigned char*)d_ws;
#if MK_MULTI
    for (int p = 0; p < N_PHASES; ++p) { a.ph_lo = p; a.ph_hi = p + 1; hipLaunchKernelGGL(fwd_kernel, dim3(grid), dim3(NTHR), LDS_BYTES, stream, a); }
#else
    a.ph_lo = 0; a.ph_hi = N_PHASES; hipLaunchKernelGGL(fwd_kernel, dim3(grid), dim3(NTHR), LDS_BYTES, stream, a);
#endif
}
```

```cpp
#include <hip/hip_runtime.h>
#include <cstdio>
#include <cstdint>

#ifndef REP_P0
#define REP_P0 1
#endif
#ifndef REP_E2
#define REP_E2 1
#endif
#ifndef REP_E3
#define REP_E3 1
#endif
#ifndef REP_ROWS
#define REP_ROWS 1
#endif
#ifndef REP_GEMM
#define REP_GEMM 1
#endif
#ifndef MK_MULTI
#define MK_MULTI 0
#endif

namespace pg8 {
#define PG8_LAS __attribute__((address_space(3)))
typedef unsigned short bf16_t;
typedef short bf16x8 __attribute__((ext_vector_type(8)));
typedef float f32x4 __attribute__((ext_vector_type(4)));
typedef unsigned u32x4 __attribute__((ext_vector_type(4)));
constexpr int BM = 256, BK = 64, HALF = 128, HTB = HALF * BK * 2, STAGE_BYTES = 8 * HTB, NXCD = 8, WGM = 8;

__host__ __device__ __forceinline__ int lds_byte(int r, int c) { const int st = (r >> 4) * 2 + (c >> 5), rr = r & 15, cc = c & 31, ob = rr * 64 + cc * 2; return st * 1024 + (ob ^ (((ob >> 9) & 1) << 5)); }
__host__ __device__ __forceinline__ void stage_rc(int b, int& R, int& C) { const int st = b / 1024, sb = b % 1024, swz = sb ^ (((sb >> 9) & 1) << 5); R = (st >> 1) * 16 + swz / 64; C = (st & 1) * 32 + (swz % 64) / 2; }
__host__ __device__ __forceinline__ int perm32(int rho) { const int n = rho >> 4, i = rho & 15; return 8 * (i >> 2) + 4 * n + (i & 3); }

struct Unit { int pm, pn; };
struct Gemm { const bf16_t* A; const bf16_t* Bt; int M, N, K, lda, ldb, grp_tiles, grpb_tiles; };

struct StaticOrder {
    int nM, nN, nwg, G, c;
    __host__ __device__ void init(int M, int N, int G_, int c_) { nM = M / BM; nN = N / BM; nwg = nM * nN; G = G_; c = c_; }
    __host__ __device__ bool next(int i, Unit& u) const {
        const long L = (long)i * G + c; if (L >= nwg) return false;
        int wgid = (int)L; { const int q = nwg / NXCD, r = nwg % NXCD, xcd = wgid % NXCD, off = wgid / NXCD; wgid = (xcd < r ? xcd * (q + 1) : r * (q + 1) + (xcd - r) * q) + off; }
        const int nig = WGM * nN, gid = wgid / nig, fm = gid * WGM, gsz = (nM - fm) < WGM ? (nM - fm) : WGM;
        u.pm = fm + ((wgid % nig) % gsz); u.pn = (wgid % nig) / gsz; return true;
    }
    __device__ __forceinline__ void a_ready(const Unit&) const {}
    __device__ __forceinline__ void done(const Unit&) const {}
};

__device__ __forceinline__ unsigned cvt_pk_bf16(float lo, float hi) { unsigned r; asm volatile("v_cvt_pk_bf16_f32 %0, %1, %2" : "=v"(r) : "v"(lo), "v"(hi)); return r; }
__device__ __forceinline__ float sigmoidf_fast(float x) { return __builtin_amdgcn_rcpf(1.0f + __expf(-x)); }

struct EpiAct {
    static constexpr bool PERM = true, AFTER_DRAIN = false;
    bf16_t* O; int ldc; int mode; const float* bias;
    __device__ __forceinline__ void operator()(const f32x4 (&acc)[2][2][4][2], const Unit& u, int wr, int wc, int fr, int fq) const {
        const int row0 = u.pm * BM + wr * 64 + fr, colt = u.pn * BM;
        int act = 0; float sc = 1.f;
        if (mode == 0) { if (colt >= 4096 && colt < 6144) act = 1; else if ((colt >= 6144 && colt < 8192) || colt >= 11264) act = 2; else if (colt >= 8192 && colt < 9216) sc = 0.08838834764831845f; }
        else if (mode == 1) { if (colt >= 4096) act = 2; }
        const int col0 = colt + wc * 32 + 8 * fq;
        f32x4 bv[2][2];
#pragma unroll
        for (int bj = 0; bj < 2; ++bj)
#pragma unroll
            for (int n = 0; n < 2; ++n) bv[bj][n] = bias ? *(const f32x4*)(bias + col0 + bj * HALF + 4 * n) : (f32x4){0.f, 0.f, 0.f, 0.f};
#pragma unroll
        for (int ai = 0; ai < 2; ++ai)
#pragma unroll
            for (int m = 0; m < 4; ++m) { bf16_t* rowp = O + (size_t)(row0 + ai * HALF + m * 16) * ldc + col0;
#pragma unroll
                for (int bj = 0; bj < 2; ++bj) { f32x4 v0 = acc[ai][bj][m][0] + bv[bj][0], v1 = acc[ai][bj][m][1] + bv[bj][1];
                    if (act == 1) {
#pragma unroll
                        for (int j = 0; j < 4; ++j) { v0[j] = sigmoidf_fast(v0[j]); v1[j] = sigmoidf_fast(v1[j]); } }
                    else if (act == 2) {
#pragma unroll
                        for (int j = 0; j < 4; ++j) { v0[j] = v0[j] * sigmoidf_fast(v0[j]); v1[j] = v1[j] * sigmoidf_fast(v1[j]); } }
                    v0 = v0 * sc; v1 = v1 * sc;
                    u32x4 w; w.x = cvt_pk_bf16(v0[0], v0[1]); w.y = cvt_pk_bf16(v0[2], v0[3]); w.z = cvt_pk_bf16(v1[0], v1[1]); w.w = cvt_pk_bf16(v1[2], v1[3]);
                    *(u32x4*)(rowp + bj * HALF) = w; } }
    }
};
struct EpiRes {
    static constexpr bool PERM = false, AFTER_DRAIN = false;
    const float* X; float* T; const float* gate; float alpha;
    __device__ __forceinline__ void operator()(const f32x4 (&acc)[2][2][4][2], const Unit& u, int wr, int wc, int fr, int fq) const {
        const int row0 = u.pm * BM + wr * 64 + fr, col0 = u.pn * BM + wc * 32 + 4 * fq;
        f32x4 gv[2][2];
#pragma unroll
        for (int bj = 0; bj < 2; ++bj)
#pragma unroll
            for (int n = 0; n < 2; ++n) gv[bj][n] = *(const f32x4*)(gate + col0 + bj * HALF + n * 16) + 1.0f;
#pragma unroll
        for (int ai = 0; ai < 2; ++ai)
#pragma unroll
            for (int m = 0; m < 4; ++m) { const size_t off = (size_t)(row0 + ai * HALF + m * 16) * 4096 + col0;
#pragma unroll
                for (int bj = 0; bj < 2; ++bj)
#pragma unroll
                    for (int n = 0; n < 2; ++n) { const f32x4 xs = *(const f32x4*)(X + off + bj * HALF + n * 16);
                        *(f32x4*)(T + off + bj * HALF + n * 16) = xs * alpha + gv[bj][n] * acc[ai][bj][m][n]; }
                asm volatile("" ::: "memory"); }
    }
};
struct EpiColScale {
    static constexpr bool PERM = true, AFTER_DRAIN = false;
    bf16_t* O; int ldc; const float* scale;
    __device__ __forceinline__ void operator()(const f32x4 (&acc)[2][2][4][2], const Unit& u, int wr, int wc, int fr, int fq) const {
        const int row0 = u.pm * BM + wr * 64 + fr, col0 = u.pn * BM + wc * 32 + 8 * fq;
        f32x4 sv[2][2];
#pragma unroll
        for (int bj = 0; bj < 2; ++bj)
#pragma unroll
            for (int n = 0; n < 2; ++n) sv[bj][n] = *(const f32x4*)(scale + col0 + bj * HALF + 4 * n) + 1.0f;
#pragma unroll
        for (int ai = 0; ai < 2; ++ai)
#pragma unroll
            for (int m = 0; m < 4; ++m) { const size_t r = (size_t)(row0 + ai * HALF + m * 16);
#pragma unroll
                for (int bj = 0; bj < 2; ++bj) { const f32x4 v0 = acc[ai][bj][m][0] * sv[bj][0], v1 = acc[ai][bj][m][1] * sv[bj][1];
                    u32x4 w; w.x = cvt_pk_bf16(v0[0], v0[1]); w.y = cvt_pk_bf16(v0[2], v0[3]); w.z = cvt_pk_bf16(v1[0], v1[1]); w.w = cvt_pk_bf16(v1[2], v1[3]);
                    *(u32x4*)(O + r * ldc + col0 + bj * HALF) = w; } }
    }
};

template <class Epi, class Sched, bool ALIGN_EPI>
__device__ __forceinline__ void gemm_phase(PG8_LAS unsigned char* lds, const Gemm g, const Sched& S, const Epi& E) {
    int tid = threadIdx.x; asm volatile("" : "+v"(tid));
    const int wid = __builtin_amdgcn_readfirstlane(tid >> 6), lane = tid & 63, wr = wid >> 2, wc = wid & 3, fr = lane & 15, fq = lane >> 4;
    const int K = g.K, nt = K / BK;
    unsigned voffA[2], voffB[2];
#pragma unroll
    for (int i = 0; i < 2; ++i) { int R, C; stage_rc(tid * 16 + i * 8192, R, C); const int Rb = Epi::PERM ? ((R & ~31) + perm32(R & 31)) : R;
        voffA[i] = (unsigned)(R * g.lda + C) * 2u; voffB[i] = (unsigned)(Rb * g.ldb + C) * 2u; }
    const size_t kstep = (size_t)(BK * 2);
    const size_t hstepA = (size_t)HALF * g.lda * 2, hstepB = (size_t)HALF * g.ldb * 2;
    const size_t tstepA = 2 * hstepA, tstepB = 2 * hstepB;
    const unsigned ldsw = (unsigned)wid * 1024u;
    const int aoff = lds_byte(wr * 64 + fr, fq * 8), boff = lds_byte(wc * 32 + fr, fq * 8);
#define PG8_UA(u) ((const char*)g.A + (size_t)(u).pm * tstepA + (g.grp_tiles ? (size_t)((u).pn / g.grp_tiles) * (size_t)K * 2 : (size_t)0))
#define PG8_UB(u) ((const char*)g.Bt + (size_t)(u).pn * tstepB + (g.grpb_tiles ? (size_t)((u).pm / g.grpb_tiles) * (size_t)K * 2 : (size_t)0))
#define PG8_SA(b, h) (((b) * 2 + (h)) * HTB)
#define PG8_SB(b, h) ((4 + (b) * 2 + (h)) * HTB)
#define PG8_STAGE(bufoff, gbase, voff) do { _Pragma("unroll") for (int _i = 0; _i < 2; ++_i) \
        __builtin_amdgcn_global_load_lds((const unsigned*)((const char*)(gbase) + (voff)[_i]), (PG8_LAS unsigned*)(lds + (bufoff) + ldsw + _i * 8192), 16, 0, 0); } while (0)
#define PG8_LDA(dst, b, h) do { _Pragma("unroll") for (int m = 0; m < 4; ++m) _Pragma("unroll") for (int k = 0; k < 2; ++k) dst[m][k] = *(const PG8_LAS bf16x8*)(lds + PG8_SA(b, h) + aoff + m * 2048 + k * 1024); } while (0)
#define PG8_LDB(dst, b, h) do { _Pragma("unroll") for (int n = 0; n < 2; ++n) _Pragma("unroll") for (int k = 0; k < 2; ++k) dst[n][k] = *(const PG8_LAS bf16x8*)(lds + PG8_SB(b, h) + boff + n * 2048 + k * 1024); } while (0)
#define PG8_MMA(ai, bj, At, Bt) do { __builtin_amdgcn_s_setprio(1); _Pragma("unroll") for (int m = 0; m < 4; ++m) _Pragma("unroll") for (int n = 0; n < 2; ++n) _Pragma("unroll") for (int k = 0; k < 2; ++k) \
        acc[ai][bj][m][n] = __builtin_amdgcn_mfma_f32_16x16x32_bf16(Bt[n][k], At[m][k], acc[ai][bj][m][n], 0, 0, 0); __builtin_amdgcn_s_setprio(0); } while (0)
#define PG8_WAIT_V(n) asm volatile("s_waitcnt vmcnt(" #n ")" ::: "memory")
#define PG8_WAIT_L(n) asm volatile("s_waitcnt lgkmcnt(" #n ")" ::: "memory")
#define PG8_BAR __builtin_amdgcn_s_barrier()
#define PG8_SCHED __builtin_amdgcn_sched_barrier(0)
    Unit cur, nxt; int ui = 0;
    if (!S.next(0, cur)) return;
    f32x4 acc[2][2][4][2];
#pragma unroll
    for (int a = 0; a < 2; ++a)
#pragma unroll
        for (int b = 0; b < 2; ++b)
#pragma unroll
            for (int m = 0; m < 4; ++m)
#pragma unroll
                for (int n = 0; n < 2; ++n) acc[a][b][m][n] = (f32x4){0.f, 0.f, 0.f, 0.f};
    bf16x8 At[4][2], B0[2][2], B1[2][2];
    const char* cA = PG8_UA(cur); const char* cB = PG8_UB(cur);
    S.a_ready(cur);
    PG8_STAGE(PG8_SB(0, 0), cB, voffB); PG8_STAGE(PG8_SB(0, 1), cB + hstepB, voffB); PG8_STAGE(PG8_SA(0, 0), cA, voffA); PG8_STAGE(PG8_SA(0, 1), cA + hstepA, voffA);
    if (wr == 1) PG8_BAR;
    PG8_WAIT_V(2); PG8_BAR;
    PG8_STAGE(PG8_SB(1, 0), cB + kstep, voffB); PG8_STAGE(PG8_SA(1, 0), cA + kstep, voffA); PG8_STAGE(PG8_SB(1, 1), cB + hstepB + kstep, voffB);
    PG8_WAIT_V(6); PG8_BAR;
    for (;;) {
        const bool has_next = S.next(ui + 1, nxt);
        const char* nA = has_next ? PG8_UA(nxt) : cA; const char* nB = has_next ? PG8_UB(nxt) : cB;
        for (int t = 0; t < nt; t += 2) {
            const bool last = (t == nt - 2);
            const char* a1 = cA + (size_t)(t + 1) * kstep;
            const char* a2 = last ? nA : cA + (size_t)(t + 2) * kstep; const char* b2 = last ? nB : cB + (size_t)(t + 2) * kstep;
            const char* a3 = a2 + kstep; const char* b3 = b2 + kstep;
            if (last && has_next) S.a_ready(nxt);
            PG8_LDB(B0, 0, 0); PG8_LDB(B1, 0, 1); PG8_SCHED; PG8_LDA(At, 0, 0); PG8_STAGE(PG8_SA(1, 1), a1 + hstepA, voffA);
            PG8_WAIT_V(8); PG8_WAIT_L(0); PG8_BAR; PG8_MMA(0, 0, At, B0); PG8_MMA(0, 1, At, B1); PG8_BAR; PG8_SCHED;
            PG8_LDA(At, 0, 1); PG8_STAGE(PG8_SB(0, 0), b2, voffB); PG8_STAGE(PG8_SB(0, 1), b2 + hstepB, voffB); PG8_STAGE(PG8_SA(0, 0), a2, voffA);
            PG8_WAIT_V(8); PG8_WAIT_L(0); PG8_BAR; PG8_MMA(1, 0, At, B0); PG8_MMA(1, 1, At, B1); PG8_BAR; PG8_SCHED;
            PG8_LDB(B0, 1, 0); PG8_LDB(B1, 1, 1); PG8_SCHED; PG8_LDA(At, 1, 0); PG8_STAGE(PG8_SA(0, 1), a2 + hstepA, voffA);
            PG8_WAIT_V(8); PG8_WAIT_L(0); PG8_BAR; PG8_MMA(0, 0, At, B0); PG8_MMA(0, 1, At, B1); PG8_BAR; PG8_SCHED;
            PG8_LDA(At, 1, 1); PG8_STAGE(PG8_SB(1, 0), b3, voffB); PG8_STAGE(PG8_SB(1, 1), b3 + hstepB, voffB); PG8_STAGE(PG8_SA(1, 0), a3, voffA);
            PG8_WAIT_V(8); PG8_WAIT_L(0); PG8_BAR; PG8_MMA(1, 0, At, B0); PG8_MMA(1, 1, At, B1); PG8_BAR; PG8_SCHED;
        }
        if constexpr (ALIGN_EPI) { if (wr == 0) PG8_BAR; }
        E(acc, cur, wr, wc, fr, fq); S.done(cur);
        if (!has_next) break;
#pragma unroll
        for (int a = 0; a < 2; ++a)
#pragma unroll
            for (int b = 0; b < 2; ++b)
#pragma unroll
                for (int m = 0; m < 4; ++m)
#pragma unroll
                    for (int n = 0; n < 2; ++n) acc[a][b][m][n] = (f32x4){0.f, 0.f, 0.f, 0.f};
        cur = nxt; cA = nA; cB = nB; ++ui;
        if constexpr (ALIGN_EPI) { if (wr == 1) PG8_BAR; }
    }
    PG8_WAIT_V(0);
    if constexpr (!ALIGN_EPI) { if (wr == 0) PG8_BAR; }
    PG8_BAR;
#undef PG8_UA
#undef PG8_UB
#undef PG8_SA
#undef PG8_SB
#undef PG8_STAGE
#undef PG8_LDA
#undef PG8_LDB
#undef PG8_MMA
#undef PG8_WAIT_V
#undef PG8_WAIT_L
#undef PG8_BAR
#undef PG8_SCHED
}
}

constexpr int NWAVES = 8, NTHR = 512;
constexpr int M = 16384, D = 4096;
constexpr int EVEN_IN = 12296, EVEN_N = 12288, EVEN_MIX = 3072, ODD_IN = 8192;
constexpr float LN_EPS = 1e-5f;
constexpr float DN_ALPHA = 1.6817928305074290861f;
constexpr float SB_EXIT = 104.0f;

constexpr size_t MiB = 1u << 20;
constexpr size_t WS_CTL = 0, CTL_ZERO_BYTES = 1 * MiB;
constexpr size_t WS_MOD = 1 * MiB;
constexpr size_t WS_WG = 2 * MiB;
constexpr size_t WS_GATES = 3 * MiB;
constexpr size_t WS_WINTER = 4 * MiB;
constexpr size_t WS_EMT = 5 * MiB;
constexpr size_t WS_CDEC = 6 * MiB;
constexpr size_t WS_DENR = 7 * MiB;
constexpr size_t WS_S = 8 * MiB;
constexpr size_t WS_QC = 16 * MiB;
constexpr size_t WS_KC = 48 * MiB;
constexpr size_t WS_U = 80 * MiB;
constexpr size_t WS_T = 208 * MiB;
constexpr size_t WS_P = 464 * MiB;
constexpr size_t WS_MIX = 848 * MiB;
constexpr size_t WS_NUM = 976 * MiB;
constexpr size_t WS_W = 1104 * MiB;
constexpr size_t W_IN_E = 96 * MiB, W_OUT_E = 24 * MiB, W_IN_O = 64 * MiB, W_POOL = 8 * MiB, W_OUT_O = 32 * MiB, W_PAIR = W_IN_E + W_OUT_E + W_IN_O + W_POOL + W_OUT_O;
constexpr size_t WS_VT = WS_W + 2 * W_PAIR;
constexpr size_t WS_VBT = WS_VT + 64 * MiB;
constexpr size_t WS_NUM2 = WS_VBT + 32 * MiB;
constexpr size_t WS_END = WS_NUM2 + 256 * MiB;
constexpr int CW_BAR = 4096;
constexpr size_t WS_BIAS = WS_CTL + 65536;

constexpr int RING_BYTES = 149504, LDSCTL_OFF = RING_BYTES, MISC_OFF = LDSCTL_OFF + 320, LDS_BYTES = 155648;

#define LAS __attribute__((address_space(3)))
typedef unsigned short bf16;
typedef float f32x4 __attribute__((ext_vector_type(4)));
typedef float f32x2 __attribute__((ext_vector_type(2)));
typedef unsigned u32x4 __attribute__((ext_vector_type(4)));
typedef unsigned u32x2 __attribute__((ext_vector_type(2)));
typedef short bf16x8 __attribute__((ext_vector_type(8)));
typedef __bf16 bf16x2n __attribute__((ext_vector_type(2)));

__device__ __forceinline__ unsigned f2bf(float f) { unsigned u = __builtin_bit_cast(unsigned, f); return (u + 0x7fffu + ((u >> 16) & 1u)) >> 16; }
__device__ __forceinline__ unsigned pk2(float lo, float hi) { return pg8::cvt_pk_bf16(lo, hi); }
__device__ __forceinline__ unsigned pk2n(float lo, float hi) { return __builtin_bit_cast(unsigned, __builtin_convertvector((f32x2){lo, hi}, bf16x2n)); }
__device__ __forceinline__ unsigned pkh(float lo, float hi) { return (unsigned)__builtin_bit_cast(unsigned short, (_Float16)lo) | ((unsigned)__builtin_bit_cast(unsigned short, (_Float16)hi) << 16); }
__device__ __forceinline__ float hlo(unsigned w) { return (float)__builtin_bit_cast(_Float16, (unsigned short)(w & 0xffffu)); }
__device__ __forceinline__ float hhi(unsigned w) { return (float)__builtin_bit_cast(_Float16, (unsigned short)(w >> 16)); }
__device__ __forceinline__ float bflo(unsigned w) { return __uint_as_float(w << 16); }
__device__ __forceinline__ float bfhi(unsigned w) { return __uint_as_float(w & 0xffff0000u); }
__device__ __forceinline__ float wave_sum(float v) {
#pragma unroll
    for (int o = 1; o < 64; o <<= 1) v += __shfl_xor(v, o);
    return v;
}
__device__ __forceinline__ float wave_max(float v) {
#pragma unroll
    for (int o = 1; o < 64; o <<= 1) v = fmaxf(v, __shfl_xor(v, o));
    return v;
}
__device__ __forceinline__ float wave_min(float v) {
#pragma unroll
    for (int o = 1; o < 64; o <<= 1) v = fminf(v, __shfl_xor(v, o));
    return v;
}
__device__ __forceinline__ float wave_incl_sum(float v, int lane) {
#pragma unroll
    for (int o = 1; o < 64; o <<= 1) { const float t = __shfl_up(v, o); if (lane >= o) v += t; }
    return v;
}
__device__ __forceinline__ float wave_incl_max(float v, int lane) {
#pragma unroll
    for (int o = 1; o < 64; o <<= 1) { const float t = __shfl_up(v, o); if (lane >= o) v = fmaxf(v, t); }
    return v;
}
__device__ __forceinline__ float logsigmoidf_acc(float x) { return x >= 0.f ? -log1pf(expf(-x)) : x - log1pf(expf(x)); }
__device__ __forceinline__ float softplusf_acc(float z) { return fmaxf(z, 0.f) + log1pf(expf(-fabsf(z))); }
__device__ __forceinline__ float softplusf_fast(float z) { return fmaxf(z, 0.f) + __logf(1.0f + __expf(-fabsf(z))); }
__device__ __forceinline__ void unpack8(const u32x4 w, float (&f)[8]) { f[0] = bflo(w.x); f[1] = bfhi(w.x); f[2] = bflo(w.y); f[3] = bfhi(w.y); f[4] = bflo(w.z); f[5] = bfhi(w.z); f[6] = bflo(w.w); f[7] = bfhi(w.w); }

#define XB_TMO      128
#define XB_XCNT(j)  (256  + 64 * (j))
#define XB_XSUB(j)  (1280 + 64 * (j))
#define XB_XGEN(j)  (2304 + 64 * (j))
#define XB_TOP      3328
#define XB_TOPGEN   3392
#define XCD_BAR_WORDS 3456
#define XB_SPIN_CAP (1u << 18)
__device__ __forceinline__ unsigned xb_ld(unsigned* p)              { return __hip_atomic_load(p, __ATOMIC_RELAXED, __HIP_MEMORY_SCOPE_AGENT); }
__device__ __forceinline__ unsigned xb_add(unsigned* p, unsigned v) { return __hip_atomic_fetch_add(p, v, __ATOMIC_RELAXED, __HIP_MEMORY_SCOPE_AGENT); }
__device__ __forceinline__ unsigned xb_xcc_id() { return (unsigned)__builtin_amdgcn_s_getreg((3 << 11) | 20) & 0xFu; }
#define XB_SPIN(cond, bar) do { unsigned _sp = 0; while (cond) { __builtin_amdgcn_s_sleep(1); \
    if ((++_sp & 255u) == 0u) { if (xb_ld(&(bar)[XB_TMO])) break; if (_sp > XB_SPIN_CAP) { atomicAdd(&(bar)[XB_TMO], 1u); break; } } } } while (0)
struct XcdBarrier { unsigned* bar; unsigned x; volatile LAS unsigned* st; };
__device__ __forceinline__ XcdBarrier xcd_barrier_post(unsigned* bar, volatile LAS unsigned* st) {
    XcdBarrier b; b.bar = bar; b.x = xb_xcc_id(); b.st = st;
    if (threadIdx.x == 0) (void)xb_add(&bar[XB_XCNT(b.x)], 1u);
    return b;
}
__device__ __forceinline__ void xcd_barrier_complete(unsigned* bar, unsigned x, unsigned& nloc, unsigned& nx) {
    const unsigned G = gridDim.x * gridDim.y * gridDim.z;
    unsigned sum, cnt, mine, sp = 0u;
    for (;;) {
        sum = 0u; cnt = 0u; mine = 0u;
#pragma unroll
        for (unsigned j = 0; j < 16; ++j) { const unsigned c = xb_ld(&bar[XB_XCNT(j)]); sum += c; cnt += (c > 0u) ? 1u : 0u; mine = (j == x) ? c : mine; }
        if (sum == G) break;
        __builtin_amdgcn_s_sleep(1);
        if ((++sp & 255u) == 0u) { if (xb_ld(&bar[XB_TMO])) break; if (sp > XB_SPIN_CAP) { atomicAdd(&bar[XB_TMO], 1u); break; } }
    }
    nloc = mine > 0u ? mine : 1u; nx = cnt > 0u ? cnt : 1u;
}
__device__ __forceinline__ void xcd_barrier(const XcdBarrier& b) {
    asm volatile("s_waitcnt vmcnt(0)" ::: "memory");
    __syncthreads();
    if (threadIdx.x == 0) {
        unsigned* bar = b.bar;
        __builtin_amdgcn_s_waitcnt(0);
        unsigned nloc = b.st[0], nx = b.st[1];
        if (nloc == 0u) { xcd_barrier_complete(bar, b.x, nloc, nx); b.st[0] = nloc; b.st[1] = nx; }
        const unsigned old = xb_add(&bar[XB_XSUB(b.x)], 1u);
        const unsigned gen = old / nloc;
        if (old + 1u == (gen + 1u) * nloc) {
            __builtin_amdgcn_fence(__ATOMIC_RELEASE, "agent");
            asm volatile("s_waitcnt vmcnt(0)" ::: "memory");
            const unsigned og = xb_add(&bar[XB_TOP], 1u);
            const unsigned tg = og / nx;
            if (og + 1u == (tg + 1u) * nx) xb_add(&bar[XB_TOPGEN], 1u);
            else XB_SPIN(xb_ld(&bar[XB_TOPGEN]) == tg, bar);
            __builtin_amdgcn_fence(__ATOMIC_ACQUIRE, "agent");
            xb_add(&bar[XB_XGEN(b.x)], 1u);
            asm volatile("s_waitcnt vmcnt(0)" ::: "memory");
        } else {
            XB_SPIN(xb_ld(&bar[XB_XGEN(b.x)]) == gen, bar);
            __builtin_amdgcn_fence(__ATOMIC_ACQUIRE, "agent");
            asm volatile("s_waitcnt vmcnt(0)" ::: "memory");
        }
    }
    __syncthreads();
}

__device__ __forceinline__ void xcd_barrier_next(const XcdBarrier& b) {
    asm volatile("s_waitcnt vmcnt(0)" ::: "memory");
    __syncthreads();
    if (threadIdx.x == 0) {
        unsigned* bar = b.bar;
        __builtin_amdgcn_s_waitcnt(0);
        const unsigned nloc = b.st[0], nx = b.st[1];
        const unsigned old = xb_add(&bar[XB_XSUB(b.x)], 1u);
        const unsigned gen = old / nloc;
        if (old + 1u == (gen + 1u) * nloc) {
            __builtin_amdgcn_fence(__ATOMIC_RELEASE, "agent");
            asm volatile("s_waitcnt vmcnt(0)" ::: "memory");
            const unsigned og = xb_add(&bar[XB_TOP], 1u);
            const unsigned tg = og / nx;
            if (og + 1u == (tg + 1u) * nx) xb_add(&bar[XB_TOPGEN], 1u);
            else XB_SPIN(xb_ld(&bar[XB_TOPGEN]) == tg, bar);
            __builtin_amdgcn_fence(__ATOMIC_ACQUIRE, "agent");
            xb_add(&bar[XB_XGEN(b.x)], 1u);
            asm volatile("s_waitcnt vmcnt(0)" ::: "memory");
        } else {
            XB_SPIN(xb_ld(&bar[XB_XGEN(b.x)]) == gen, bar);
            __builtin_amdgcn_fence(__ATOMIC_ACQUIRE, "agent");
            asm volatile("s_waitcnt vmcnt(0)" ::: "memory");
        }
    }
    __syncthreads();
}

struct Args { const float* in[40]; float* out; unsigned char* ws; int ph_lo, ph_hi; };
constexpr int I_X = 0, I_C = 1;

__device__ __forceinline__ void p0_transpose_item(const float* W, int ldw, int src_col0, bf16* WT, int ldt, int dst_row0, int nblk, LAS float* scr, int item, int lane,
                                                  const float* scl, const float* shf, float* bias) {
    const int kb = item / nblk, nb = item % nblk, k0 = 64 * kb, n0 = 32 * nb;
    float bacc = 0.f;
    LAS float* sms = scr + 64 * 33;
    if (scl) { sms[lane] = 1.0f + scl[k0 + lane]; sms[64 + lane] = shf[k0 + lane]; asm volatile("s_waitcnt lgkmcnt(0)" ::: "memory"); }
#pragma unroll 8
    for (int i = 0; i < 32; ++i) { const int kk = 2 * i + (lane >> 5); const float wv = W[(size_t)(k0 + kk) * ldw + src_col0 + n0 + (lane & 31)];
        if (scl) { scr[kk * 33 + (lane & 31)] = wv * sms[kk]; bacc += sms[64 + kk] * wv; } else scr[kk * 33 + (lane & 31)] = wv; }
    if (scl) { bacc += __shfl_xor(bacc, 32); if (lane < 32) atomicAdd(bias + dst_row0 + n0 + lane, bacc); }
    asm volatile("s_waitcnt lgkmcnt(0)" ::: "memory");
    const int c = lane & 7;
#pragma unroll
    for (int j = 0; j < 4; ++j) { const int n = (lane >> 3) + 8 * j; const LAS float* s = scr + (8 * c) * 33 + n;
        u32x4 o; o.x = pk2(s[0 * 33], s[1 * 33]); o.y = pk2(s[2 * 33], s[3 * 33]); o.z = pk2(s[4 * 33], s[5 * 33]); o.w = pk2(s[6 * 33], s[7 * 33]);
        *(u32x4*)(WT + (size_t)(dst_row0 + n0 + n) * ldt + k0 + 8 * c) = o; }
    asm volatile("s_waitcnt lgkmcnt(0)" ::: "memory");
}
__device__ __forceinline__ void p0_convert(const float* W, int K, int ldw, int src_col0, int ncols, bf16* WT, int dst_row0, LAS float* scr, int gw, int NGW, int lane,
                                           const float* scl, const float* shf, float* bias) {
    const int nblk = ncols / 32, nitems = (K / 64) * nblk;
    for (int it = gw; it < nitems; it += NGW) p0_transpose_item(W, ldw, src_col0, WT, K, dst_row0, nblk, scr, it, lane, scl, shf, bias);
}
__device__ __forceinline__ void phase_mods(const Args& a, LAS unsigned char* lds, int G) {
    __syncthreads();
    int tid = threadIdx.x; asm volatile("" : "+v"(tid));
    const int lane = tid & 63, wave = tid >> 6;
    LAS float* cact = (LAS float*)lds; LAS float* red = (LAS float*)(lds + 16384);
    for (int i = tid; i < D; i += NTHR) { const float c = a.in[I_C][i]; cact[i] = c / (1.0f + expf(-c)); }
    __syncthreads();
    float* MOD = (float*)(a.ws + WS_MOD);
    if (blockIdx.x == 0) ((u32x4*)(a.ws + WS_CDEC + 131072))[tid] = (u32x4){0x3F803F80u, 0x3F803F80u, 0x3F803F80u, 0x3F803F80u};
    for (int item = blockIdx.x; item < 4 * 192; item += G) {
        const int l = item / 192, col = (item % 192) * 64 + lane;
        const float* Wl = l == 0 ? a.in[2] : l == 1 ? a.in[12] : l == 2 ? a.in[21] : a.in[31];
        const float* bl = l == 0 ? a.in[3] : l == 1 ? a.in[13] : l == 2 ? a.in[22] : a.in[32];
        const float* Wp = Wl + (size_t)(wave * 512) * 12288 + col; const LAS float* cp = cact + wave * 512;
        float acc = 0.f;
#pragma unroll 16
        for (int k = 0; k < 512; ++k) acc += cp[k] * Wp[(size_t)k * 12288];
        red[wave * 64 + lane] = acc;
        __syncthreads();
        if (wave == 0) { float s = 0.f;
#pragma unroll
            for (int w = 0; w < 8; ++w) s += red[w * 64 + lane];
            MOD[l * 12288 + col] = s + bl[col]; }
        __syncthreads();
    }
}
__device__ __forceinline__ void phase_weights(const Args& a, LAS unsigned char* lds, int G) {
    __syncthreads();
    int tid = threadIdx.x; asm volatile("" : "+v"(tid));
    const int lane = tid & 63, wave = tid >> 6;
    unsigned char* ws = a.ws;
    const float* MOD = (const float*)(ws + WS_MOD); float* BIAS = (float*)(ws + WS_BIAS);
    LAS float* scr = (LAS float*)(lds + wave * 16384);
    const int gw = blockIdx.x * NWAVES + wave, NGW = G * NWAVES;
#pragma unroll 1
    for (int lp = 0; lp < 2; ++lp) {
        bf16* wb = (bf16*)(ws + WS_W + (size_t)lp * W_PAIR);
        const float* w_in_e = lp ? a.in[23] : a.in[4]; const float* w_out_e = lp ? a.in[28] : a.in[9];
        const float* w_in_o = lp ? a.in[33] : a.in[14]; const float* pool_w = lp ? a.in[34] : a.in[15]; const float* w_out_o = lp ? a.in[37] : a.in[18];
        bf16* Wt_in_e = wb; bf16* Wt_out_e = (bf16*)((unsigned char*)wb + W_IN_E); bf16* Wt_in_o = (bf16*)((unsigned char*)wb + W_IN_E + W_OUT_E);
        bf16* Wt_pool = (bf16*)((unsigned char*)wb + W_IN_E + W_OUT_E + W_IN_O); bf16* Wt_out_o = (bf16*)((unsigned char*)wb + W_IN_E + W_OUT_E + W_IN_O + W_POOL);
        const float* mod_e = MOD + (2 * lp) * 12288; const float* mod_o = MOD + (2 * lp + 1) * 12288;
        p0_convert(w_in_e, D, EVEN_IN, 0, 8192, Wt_in_e, 0, scr, gw, NGW, lane, mod_e + D, mod_e, BIAS + (2 * lp) * 12288);
        p0_convert(w_in_e, D, EVEN_IN, 8200, 4096, Wt_in_e, 8192, scr, gw, NGW, lane, mod_e + D, mod_e, BIAS + (2 * lp) * 12288);
        p0_convert(w_out_e, EVEN_MIX, D, 0, D, Wt_out_e, 0, scr, gw, NGW, lane, nullptr, nullptr, nullptr);
        p0_convert(w_in_o, D, ODD_IN, 4096, 4096, Wt_in_o, 4096, scr, gw, NGW, lane, mod_o + D, mod_o, BIAS + (2 * lp + 1) * 12288);
        {
            bf16* WV = (bf16*)(ws + WS_P) + (size_t)lp * D * D;
            for (size_t i = (size_t)blockIdx.x * NTHR + tid; i < (size_t)D * D / 8; i += (size_t)G * NTHR) { const size_t k = i / 512, c8 = i % 512;
                const f32x4 a0 = *(const f32x4*)(w_in_o + k * ODD_IN + c8 * 8), a1 = *(const f32x4*)(w_in_o + k * ODD_IN + c8 * 8 + 4);
                *(u32x4*)(WV + k * D + c8 * 8) = (u32x4){pk2(a0.x, a0.y), pk2(a0.z, a0.w), pk2(a1.x, a1.y), pk2(a1.z, a1.w)}; }
        }
#pragma unroll 1
        for (int g = 0; g < 4; ++g) p0_convert(pool_w + (size_t)g * 1024 * 1024, 1024, 1024, 0, 1024, Wt_pool, g * 1024, scr, gw, NGW, lane, nullptr, nullptr, nullptr);
        p0_convert(w_out_o, D, D, 0, D, Wt_out_o, 0, scr, gw, NGW, lane, nullptr, nullptr, nullptr);
        bf16* WGB = (bf16*)(ws + WS_WG) + lp * 8 * D; float* GB = (float*)(ws + WS_WG + 262144) + lp * 8;
        for (int i = blockIdx.x * NTHR + tid; i < 8 * D; i += G * NTHR) { const int j = i / D, k = i % D; WGB[i] = (bf16)f2bf(w_in_e[(size_t)k * EVEN_IN + 8192 + j] * (1.0f + mod_e[D + k])); }
        if (gw < 8) { float acc = 0.f; for (int k = lane; k < D; k += 64) acc += mod_e[k] * w_in_e[(size_t)k * EVEN_IN + 8192 + gw]; acc = wave_sum(acc); if (lane == 0) GB[gw] = acc; }
    }
}

constexpr int RW_G1 = 0, RW_LG = 16384, RW_LB = 32768, RW_WG = 49152;
template <bool FIRST, bool SRCB, bool DSTF>
__device__ __forceinline__ void phase_rows(const void* src, const bf16* Y, const float* gate, const float* lng, const float* lnb, void* xout, bf16* xh, const bf16* wgb, const float* gb, float* GATES,
                                           LAS unsigned char* lds, int G) {
    int tid = threadIdx.x; asm volatile("" : "+v"(tid));
    const int lane = tid & 63, wave = tid >> 6;
    __syncthreads();
    if (!FIRST) { for (int i = tid; i < 1024; i += NTHR) { ((LAS f32x4*)(lds + RW_G1))[i] = ((const f32x4*)gate)[i] + 1.0f; ((LAS f32x4*)(lds + RW_LG))[i] = ((const f32x4*)lng)[i]; ((LAS f32x4*)(lds + RW_LB))[i] = ((const f32x4*)lnb)[i]; } }
    if (wgb) { for (int i = tid; i < 4096; i += NTHR) ((LAS u32x4*)(lds + RW_WG))[i] = ((const u32x4*)wgb)[i]; }
    __syncthreads();
    const int gw = blockIdx.x * NWAVES + wave, NGW = G * NWAVES;
#pragma unroll 1
    for (int m = gw; m < M; m += NGW) {
        int ln = lane; asm volatile("" : "+v"(ln));
        f32x4 v[16]; u32x2 yy[16];
        if (SRCB) { const u32x2* xr = (const u32x2*)((const bf16*)src + (size_t)m * D) + ln; u32x2 xx[16];
#pragma unroll
            for (int j = 0; j < 16; ++j) xx[j] = xr[64 * j];
            if (!FIRST) { const u32x2* yr = (const u32x2*)(Y + (size_t)m * D) + ln;
#pragma unroll
                for (int j = 0; j < 16; ++j) yy[j] = yr[64 * j]; }
#pragma unroll
            for (int j = 0; j < 16; ++j) v[j] = (f32x4){hlo(xx[j].x), hhi(xx[j].x), hlo(xx[j].y), hhi(xx[j].y)}; }
        else { const f32x4* xr = (const f32x4*)((const float*)src + (size_t)m * D) + ln;
#pragma unroll
            for (int j = 0; j < 16; ++j) v[j] = xr[64 * j];
            if (!FIRST) { const u32x2* yr = (const u32x2*)(Y + (size_t)m * D) + ln;
#pragma unroll
                for (int j = 0; j < 16; ++j) yy[j] = yr[64 * j]; } }
        if (!FIRST) {
            const LAS f32x4* g1 = (const LAS f32x4*)(lds + RW_G1) + ln; const LAS f32x4* lg = (const LAS f32x4*)(lds + RW_LG) + ln; const LAS f32x4* lb = (const LAS f32x4*)(lds + RW_LB) + ln;
            float s = 0.f;
#pragma unroll
            for (int j = 0; j < 16; ++j) { const f32x4 yv = (f32x4){bflo(yy[j].x), bfhi(yy[j].x), bflo(yy[j].y), bfhi(yy[j].y)}; v[j] = v[j] * DN_ALPHA + g1[64 * j] * yv; s += (v[j].x + v[j].y) + (v[j].z + v[j].w); }
            const float mean = wave_sum(s) * (1.f / D); float s2 = 0.f;
#pragma unroll
            for (int j = 0; j < 16; ++j) { v[j] = v[j] - mean; s2 += (v[j].x * v[j].x + v[j].y * v[j].y) + (v[j].z * v[j].z + v[j].w * v[j].w); }
            const float rstd = 1.f / sqrtf(wave_sum(s2) * (1.f / D) + LN_EPS);
#pragma unroll
            for (int j = 0; j < 16; ++j) { v[j] = v[j] * rstd * lg[64 * j] + lb[64 * j];
                if (DSTF) ((f32x4*)((float*)xout + (size_t)m * D) + ln)[64 * j] = v[j]; }
        }
        if (!DSTF) { u32x2* xo = (u32x2*)((bf16*)xout + (size_t)m * D) + ln;
#pragma unroll
            for (int j = 0; j < 16; ++j) { u32x2 o; o.x = pk2(v[j].x, v[j].y); o.y = pk2(v[j].z, v[j].w); xo[64 * j] = o; }
            if (xh) { u32x2* ho = (u32x2*)(xh + (size_t)m * D) + ln;
#pragma unroll
                for (int j = 0; j < 16; ++j) { u32x2 o; o.x = pkh(v[j].x, v[j].y); o.y = pkh(v[j].z, v[j].w); ho[64 * j] = o; } } }
        if (wgb) {
            float keep = 0.f;
#pragma unroll 1
            for (int jg = 0; jg < 8; ++jg) { float p = 0.f; const LAS u32x2* wr = (const LAS u32x2*)(lds + RW_WG) + jg * 1024 + ln;
#pragma unroll
                for (int j = 0; j < 16; ++j) { const u32x2 w = wr[64 * j]; p += (v[j].x * bflo(w.x) + v[j].y * bfhi(w.x)) + (v[j].z * bflo(w.y) + v[j].w * bfhi(w.y)); }
                p = wave_sum(p); if (lane == jg) keep = p + gb[jg]; }
            if (lane < 8) GATES[(size_t)m * 8 + lane] = keep;
        }
    }
}

constexpr int E2_BL = 0, E2_WM = 4096, E2_MP = 8192;
constexpr int E2_SQ = 16384, E2_SK = E2_SQ + 64 * 528;
constexpr int E2_VC = 16384, E2_VC_PITCH = 1544;
constexpr int E2_SS = 115712, E2_SC = 123904;
static_assert(E2_SK + 64 * 528 <= E2_SS && E2_VC + 64 * E2_VC_PITCH <= E2_SS && E2_SC + 1280 <= RING_BYTES, "E2 LDS map");

__device__ __forceinline__ void chunk_gate_sums(const float* GATES, const float* igb, const float* fgb, float* BLWM, int G) {
    int tid = threadIdx.x; asm volatile("" : "+v"(tid));
    const int lane = tid & 63, wave = tid >> 6;
    for (int pair = blockIdx.x * NWAVES + wave; pair < 1024; pair += G * NWAVES) {
        const int c = pair >> 2, h = pair & 3, m = 64 * c + lane;
        const float lf = logsigmoidf_acc(GATES[(size_t)m * 8 + 4 + h] + fgb[h]), li = GATES[(size_t)m * 8 + h] + igb[h];
        const float b = wave_incl_sum(lf, lane), gmax = wave_max(li - b), blast = __shfl(b, 63);
        if (lane == 0) { BLWM[(h * 256 + c) * 2] = blast; BLWM[(h * 256 + c) * 2 + 1] = blast + gmax; }
    }
}
__device__ __forceinline__ void e2_preamble(const float* BLWM, LAS unsigned char* lds) {
    int tid = threadIdx.x; asm volatile("" : "+v"(tid));
    LAS float* sBL = (LAS float*)(lds + E2_BL); LAS float* sWM = (LAS float*)(lds + E2_WM); LAS float* sMP = (LAS float*)(lds + E2_MP);
    __syncthreads();
    for (int i = tid; i < 1024; i += NTHR) { const f32x2 v = *(const f32x2*)(BLWM + 2 * i); sBL[i] = v.x; sWM[i] = v.y; }
    __syncthreads();
    if (tid < 256) { const int hh = tid >> 6, ln = tid & 63;
        float av[4], bv[4];
#pragma unroll
        for (int i = 0; i < 4; ++i) { av[i] = sBL[hh * 256 + 4 * ln + i]; bv[i] = sWM[hh * 256 + 4 * ln + i]; }
        float A = av[0], B = bv[0];
#pragma unroll
        for (int i = 1; i < 4; ++i) { B = fmaxf(B + av[i], bv[i]); A += av[i]; }
#pragma unroll
        for (int o = 1; o < 64; o <<= 1) { const float Ap = __shfl_up(A, o), Bp = __shfl_up(B, o); if (ln >= o) { B = fmaxf(Bp + A, B); A = Ap + A; } }
        const float Ae = __shfl_up(A, 1), Be = __shfl_up(B, 1);
        float mm = ln ? fmaxf(0.f + Ae, Be) : 0.f;
#pragma unroll
        for (int i = 0; i < 4; ++i) { sMP[hh * 256 + 4 * ln + i] = mm; mm = fmaxf(av[i] + mm, bv[i]); } }
    __syncthreads();
}
__device__ __forceinline__ void e2_prep_item(int c, int h, const bf16* P, const float* conv_w, const float* GATES, const float* igb, const float* fgb,
                                             bf16* QC, bf16* KCT, bf16* SB, bf16* VT, bf16* VBT, bf16* QB2, bf16* KB2, float* WINTER, float* EMT, float* CDEC, LAS unsigned char* lds) {
    int tid = threadIdx.x; asm volatile("" : "+v"(tid));
    const int lane = tid & 63, wave = tid >> 6;
    LAS float* sMP = (LAS float*)(lds + E2_MP);
    LAS float* sb = (LAS float*)(lds + E2_SC); LAS float* sli = sb + 64; LAS float* smt = sb + 128; LAS float* sws = sb + 192;
    LAS unsigned char* sq = lds + E2_SQ; LAS unsigned char* sk = lds + E2_SK; LAS unsigned char* sS = lds + E2_SS; LAS unsigned char* sVc = lds + E2_VC;
    const int item = c * 4 + h;
    u32x4 vreg[12];
#pragma unroll
    for (int i = 0; i < 12; ++i) { const int idx = tid + NTHR * i, s = idx / 96, p = idx % 96;
        vreg[i] = *(const u32x4*)(P + (size_t)(64 * c + s) * EVEN_N + (p < 64 ? 2048 + h * 512 + p * 8 : 10240 + h * 256 + (p - 64) * 8)); }
    __syncthreads();
    if (wave == 0) {
        const int m = 64 * c + lane;
        const float lf = logsigmoidf_acc(GATES[(size_t)m * 8 + 4 + h] + fgb[h]), li = GATES[(size_t)m * 8 + h] + igb[h];
        const float b = wave_incl_sum(lf, lane), g = li - b, pm = wave_incl_max(g, lane), gmax = __shfl(pm, 63), blast = __shfl(b, 63);
        const float mprev = sMP[h * 256 + c];
        const float mt = fmaxf(b + mprev, b + pm);
        const float mnew = fmaxf(blast + mprev, blast + gmax);
        sb[lane] = b; sli[lane] = li; smt[lane] = mt; sws[lane] = expf(blast + g - mnew);
        sb[256 + lane] = expf(b + mprev - mt);
        EMT[(size_t)m * 4 + h] = expf(-mt);
        if (lane == 0) CDEC[c * 4 + h] = expf(blast + mprev - mnew);
    }
    __syncthreads();
    {
        const int d2 = tid & 127, tq = tid >> 7;
        const int dk = 2 * d2, r5 = dk & 31, pos = (dk & ~31) + 8 * ((r5 >> 2) & 3) + 4 * (r5 >> 4) + (r5 & 3);
        unsigned xw[2][19]; float cw0[2][4], cw1[2][4];
#pragma unroll
        for (int part = 0; part < 2; ++part) { const int col = part * 1024 + h * 256 + 2 * d2;
#pragma unroll
            for (int j = 0; j < 19; ++j) { const int mr = 64 * c + 16 * tq - 3 + j; xw[part][j] = (mr >= 0) ? *(const unsigned*)(P + (size_t)(mr >= 0 ? mr : 0) * EVEN_N + col) : 0u; }
#pragma unroll
            for (int j = 0; j < 4; ++j) { cw0[part][j] = conv_w[j * 2048 + col]; cw1[part][j] = conv_w[j * 2048 + col + 1]; } }
#pragma unroll
        for (int part = 0; part < 2; ++part) {
            unsigned kw0[8], kw1[8]; float p0 = 0.f, p1 = 0.f;
#pragma unroll
            for (int tt = 0; tt < 16; ++tt) {
                const int t = 16 * tq + tt, mr = 64 * c + t;
                float y0 = 0.f, y1 = 0.f;
#pragma unroll
                for (int j = 0; j < 4; ++j) { const unsigned w = xw[part][tt + j]; y0 += cw0[part][j] * bflo(w); y1 += cw1[part][j] * bfhi(w); }
                y0 = y0 * pg8::sigmoidf_fast(y0); y1 = y1 * pg8::sigmoidf_fast(y1);
                if (part == 0) { const float wq = sb[256 + t] * 0.0625f; *(LAS unsigned*)(sq + t * 528 + d2 * 4) = pk2(y0 * 0.0625f, y1 * 0.0625f); *(unsigned*)(QC + (size_t)mr * 1024 + h * 256 + pos) = pk2(y0 * wq, y1 * wq); }
                else { const float wsv = sws[t]; *(LAS unsigned*)(sk + t * 528 + d2 * 4) = pk2(y0, y1);
                    const float s0 = y0 * wsv, s1 = y1 * wsv;
                    if (tt & 1) { kw0[tt >> 1] = pk2(p0, s0); kw1[tt >> 1] = pk2(p1, s1); } else { p0 = s0; p1 = s1; } }
            }
            if (part == 1) { bf16* kr = KCT + (size_t)item * 16384 + (size_t)dk * 64 + 16 * tq;
                *(u32x4*)(kr) = (u32x4){kw0[0], kw0[1], kw0[2], kw0[3]}; *(u32x4*)(kr + 8) = (u32x4){kw0[4], kw0[5], kw0[6], kw0[7]};
                *(u32x4*)(kr + 64) = (u32x4){kw1[0], kw1[1], kw1[2], kw1[3]}; *(u32x4*)(kr + 72) = (u32x4){kw1[4], kw1[5], kw1[6], kw1[7]}; }
        }
    }
    __syncthreads();
    {
        const int wv = __builtin_amdgcn_readfirstlane(tid >> 6), ta = wv & 3, wh = wv >> 2, fr = lane & 15, fq = lane >> 4;
        f32x4 z0 = (f32x4){0.f, 0.f, 0.f, 0.f}, z1 = z0;
#pragma unroll
        for (int kk = 0; kk < 8; ++kk) { const bf16x8 af = *(const LAS bf16x8*)(sq + (16 * ta + fr) * 528 + (32 * kk + 8 * fq) * 2);
            const bf16x8 b0 = *(const LAS bf16x8*)(sk + (32 * wh + fr) * 528 + (32 * kk + 8 * fq) * 2), b1 = *(const LAS bf16x8*)(sk + (32 * wh + 16 + fr) * 528 + (32 * kk + 8 * fq) * 2);
            z0 = __builtin_amdgcn_mfma_f32_16x16x32_bf16(af, b0, z0, 0, 0, 0); z1 = __builtin_amdgcn_mfma_f32_16x16x32_bf16(af, b1, z1, 0, 0, 0); }
        const int s0 = 32 * wh + fr, s1 = s0 + 16; const float e0 = sli[s0] - sb[s0], e1 = sli[s1] - sb[s1];
#pragma unroll
        for (int r = 0; r < 4; ++r) { const int t = 16 * ta + 4 * fq + r; const float bm = sb[t] - smt[t];
            const float w0 = (s0 <= t) ? expf(bm + e0) : 0.f, w1 = (s1 <= t) ? expf(bm + e1) : 0.f;
            *(LAS unsigned short*)(sS + (t * 64 + s0) * 2) = (unsigned short)f2bf(z0[r] * w0); *(LAS unsigned short*)(sS + (t * 64 + s1) * 2) = (unsigned short)f2bf(z1[r] * w1); }
    }
    __syncthreads();
    *(u32x4*)(SB + (size_t)item * 4096 + tid * 8) = *(const LAS u32x4*)(sS + tid * 16);
#pragma unroll
    for (int i = 0; i < 12; ++i) { const int idx = tid + NTHR * i, s = idx / 96, p = idx % 96; LAS unsigned char* d = sVc + s * E2_VC_PITCH + p * 16;
        *(LAS u32x2*)d = (u32x2){vreg[i].x, vreg[i].y}; *(LAS u32x2*)(d + 8) = (u32x2){vreg[i].z, vreg[i].w}; }
    __syncthreads();
    {
        const int cp = lane >> 3, pc = lane & 7;
#pragma unroll
        for (int rd = 0; rd < 6; ++rd) {
            const int R = wave * 6 + rd, v0 = 16 * R + 2 * cp;
            unsigned x[8];
#pragma unroll
            for (int j = 0; j < 8; ++j) x[j] = *(const LAS unsigned*)(sVc + (8 * pc + j) * E2_VC_PITCH + v0 * 2);
            const u32x4 lo = (u32x4){__builtin_amdgcn_perm(x[1], x[0], 0x05040100u), __builtin_amdgcn_perm(x[3], x[2], 0x05040100u), __builtin_amdgcn_perm(x[5], x[4], 0x05040100u), __builtin_amdgcn_perm(x[7], x[6], 0x05040100u)};
            const u32x4 hi = (u32x4){__builtin_amdgcn_perm(x[1], x[0], 0x07060302u), __builtin_amdgcn_perm(x[3], x[2], 0x07060302u), __builtin_amdgcn_perm(x[5], x[4], 0x07060302u), __builtin_amdgcn_perm(x[7], x[6], 0x07060302u)};
            bf16* dst;
            if (R < 32) dst = VT + (size_t)item * 32768 + (size_t)v0 * 64 + 8 * pc;
            else { const int vb = v0 - 512; dst = VBT + ((size_t)(c * 8 + 2 * h + (vb >> 7)) * 128 + (vb & 127)) * 64 + 8 * pc; }
            *(u32x4*)dst = lo; *(u32x4*)(dst + 64) = hi;
        }
    }
}

constexpr int AT_Q = 0, AT_K = AT_Q + 64 * 272, AT_VT = AT_K + 64 * 272, AT_Z = AT_VT + 128 * 144, AT_W = AT_Z + 64 * 272, AT_MIN = AT_W + 64 * 144, AT_O = 0;
static_assert(AT_MIN + 64 <= RING_BYTES && 64 * 528 <= AT_VT, "attention LDS map");
#define AT_BAR() do { asm volatile("s_waitcnt lgkmcnt(0)" ::: "memory"); __builtin_amdgcn_s_barrier(); asm volatile("" ::: "memory"); } while (0)
__device__ __forceinline__ void e3_attn_item(int hb, int qt, const bf16* P, const bf16* QB2, const bf16* KB2, const bf16* VBT, bf16* MIX, LAS unsigned char* lds) {
    int tid = threadIdx.x; asm volatile("" : "+v"(tid));
    const int lane = tid & 63, wave = __builtin_amdgcn_readfirstlane(tid >> 6), fr = lane & 15, fq = lane >> 4;
    LAS unsigned char* sQ = lds + AT_Q; LAS unsigned char* sK = lds + AT_K; LAS unsigned char* sVT = lds + AT_VT; LAS unsigned char* sW = lds + AT_W;
    LAS float* sZ = (LAS float*)(lds + AT_Z); LAS float* sMin = (LAS float*)(lds + AT_MIN); LAS float* sO = (LAS float*)(lds + AT_O);
    const int q0 = qt * 64, t = tid >> 3, sg = tid & 7;
    const int ta = wave & 3, wh = wave >> 2;
    u32x4 rk[2], rv[2];
#pragma unroll
    for (int i = 0; i < 2; ++i) { const int idx = tid + NTHR * i; rk[i] = *(const u32x4*)(P + (size_t)(64 * qt + (idx >> 4)) * EVEN_N + 9216 + hb * 128 + (idx & 15) * 8); rv[i] = *(const u32x4*)(VBT + (size_t)(qt * 8 + hb) * 8192 + idx * 8); }
    __syncthreads();
#pragma unroll
    for (int i = 0; i < 2; ++i) { const int idx = tid + NTHR * i, row = idx >> 4, p = idx & 15;
        *(LAS u32x4*)(sQ + row * 272 + p * 16) = *(const u32x4*)(P + (size_t)(64 * qt + row) * EVEN_N + 8192 + hb * 128 + p * 8); }
    float R = 0.f; f32x4 acc[4];
#pragma unroll
    for (int e = 0; e < 4; ++e) acc[e] = (f32x4){0.f, 0.f, 0.f, 0.f};
    for (int kb = qt; kb >= 0; --kb) {
        const int k0 = kb * 64;
        AT_BAR();
#pragma unroll
        for (int i = 0; i < 2; ++i) { const int idx = tid + NTHR * i;
            *(LAS u32x4*)(sK + (idx >> 4) * 272 + (idx & 15) * 16) = rk[i];
            *(LAS u32x4*)(sVT + (idx >> 3) * 144 + (idx & 7) * 16) = rv[i]; }
        { const int kn = kb > 0 ? kb - 1 : 0;
#pragma unroll
            for (int i = 0; i < 2; ++i) { const int idx = tid + NTHR * i; rk[i] = *(const u32x4*)(P + (size_t)(64 * kn + (idx >> 4)) * EVEN_N + 9216 + hb * 128 + (idx & 15) * 8); rv[i] = *(const u32x4*)(VBT + (size_t)(kn * 8 + hb) * 8192 + idx * 8); } }
        AT_BAR();
        {
            f32x4 z0 = (f32x4){0.f, 0.f, 0.f, 0.f}, z1 = z0;
#pragma unroll
            for (int kk = 0; kk < 4; ++kk) { const bf16x8 af = *(const LAS bf16x8*)(sQ + (16 * ta + fr) * 272 + (32 * kk + 8 * fq) * 2);
                const bf16x8 b0 = *(const LAS bf16x8*)(sK + (32 * wh + fr) * 272 + (32 * kk + 8 * fq) * 2), b1 = *(const LAS bf16x8*)(sK + (32 * wh + 16 + fr) * 272 + (32 * kk + 8 * fq) * 2);
                z0 = __builtin_amdgcn_mfma_f32_16x16x32_bf16(af, b0, z0, 0, 0, 0); z1 = __builtin_amdgcn_mfma_f32_16x16x32_bf16(af, b1, z1, 0, 0, 0); }
#pragma unroll
            for (int r = 0; r < 4; ++r) { sZ[(16 * ta + 4 * fq + r) * 68 + 32 * wh + fr] = z0[r]; sZ[(16 * ta + 4 * fq + r) * 68 + 32 * wh + 16 + fr] = z1[r]; }
        }
        AT_BAR();
        {
            const f32x4 za = *(const LAS f32x4*)(sZ + t * 68 + 8 * sg), zb = *(const LAS f32x4*)(sZ + t * 68 + 8 * sg + 4);
            const float z[8] = {za.x, za.y, za.z, za.w, zb.x, zb.y, zb.z, zb.w};
            float sp[8], tot = 0.f;
#pragma unroll
            for (int i = 0; i < 8; ++i) { const bool ok = (k0 + 8 * sg + i) < (q0 + t); sp[i] = ok ? softplusf_fast(z[i]) : 0.f; tot += sp[i]; }
            float v = tot;
#pragma unroll
            for (int o = 1; o < 8; o <<= 1) { const float u = __shfl_down(v, o, 8); if (sg + o < 8) v += u; }
            const float rowtot = __shfl(v, 0, 8);
            float suf = R + (v - tot);
            float w[8];
#pragma unroll
            for (int i = 7; i >= 0; --i) { const bool ok = (k0 + 8 * sg + i) < (q0 + t); w[i] = ok ? __expf(z[i] - sp[i] - suf) : 0.f; suf += sp[i]; }
            *(LAS u32x4*)(sW + t * 144 + sg * 16) = (u32x4){pk2(w[0], w[1]), pk2(w[2], w[3]), pk2(w[4], w[5]), pk2(w[6], w[7])};
            R += rowtot;
            const float mn = wave_min(R);
            if (lane == 0) sMin[wave] = mn;
        }
        AT_BAR();
        {
#pragma unroll
            for (int kk = 0; kk < 2; ++kk) { const bf16x8 af = *(const LAS bf16x8*)(sW + (16 * ta + fr) * 144 + (32 * kk + 8 * fq) * 2);
#pragma unroll
                for (int e = 0; e < 4; ++e) { const bf16x8 bfr = *(const LAS bf16x8*)(sVT + (16 * (4 * wh + e) + fr) * 144 + (32 * kk + 8 * fq) * 2);
                    acc[e] = __builtin_amdgcn_mfma_f32_16x16x32_bf16(af, bfr, acc[e], 0, 0, 0); } }
        }
        float mn = sMin[0];
#pragma unroll
        for (int w = 1; w < 8; ++w) mn = fminf(mn, sMin[w]);
        if (mn > SB_EXIT) break;
    }
    __syncthreads();
#pragma unroll
    for (int e = 0; e < 4; ++e)
#pragma unroll
        for (int r = 0; r < 4; ++r) sO[(16 * ta + 4 * fq + r) * 132 + 16 * (4 * wh + e) + fr] = acc[e][r];
    __syncthreads();
    {
        const size_t m = (size_t)(q0 + t);
#pragma unroll
        for (int half = 0; half < 2; ++half) { const int d0 = 64 * half + 8 * sg;
            const f32x4 oa = *(const LAS f32x4*)(sO + t * 132 + d0), ob = *(const LAS f32x4*)(sO + t * 132 + d0 + 4);
            float zf[8]; unpack8(*(const u32x4*)(P + m * EVEN_N + 11264 + hb * 128 + d0), zf);
            u32x4 o; o.x = pk2(oa.x * zf[0], oa.y * zf[1]); o.y = pk2(oa.z * zf[2], oa.w * zf[3]); o.z = pk2(ob.x * zf[4], ob.y * zf[5]); o.w = pk2(ob.z * zf[6], ob.w * zf[7]);
            *(u32x4*)(MIX + m * EVEN_MIX + 2048 + hb * 128 + d0) = o; }
    }
}

#define SC_BAR() do { asm volatile("s_waitcnt lgkmcnt(0)" ::: "memory"); __builtin_amdgcn_s_barrier(); asm volatile("" ::: "memory"); } while (0)
constexpr int SC_SLICES = 8, SC_ITEMS = 4 * (SC_SLICES + 1) * 2;
constexpr int SC_SQ = 0, SC_SS = 16384, SC_SWI = 24576, SC_SVT = 25088, SC_SKT = 33280, SC_SET = 49664;
constexpr int SC_NSET = 3, SC_PUB = 32;
static_assert(SC_NSET * SC_SET <= RING_BYTES, "scan LDS map");
__device__ __forceinline__ void e3_scan_item(int h, int sl, int half, const bf16* QC, const bf16* KCT, const bf16* SB, const bf16* VT, const float* WINTER, const float* CDEC,
                                             float* NUM, float* DENR, const bf16* ONES, unsigned* prog, LAS unsigned char* lds) {
    int tid = threadIdx.x; asm volatile("" : "+v"(tid));
    const int lane = tid & 63, wave = __builtin_amdgcn_readfirstlane(tid >> 6), fr = lane & 15, fq = lane >> 4;
    const bool ones = (sl == SC_SLICES);
    __syncthreads();
    if (wave & 2) {
        const int wl = (wave & 1) | ((wave >> 2) << 1), rr = lane >> 2, q = (lane & 3) ^ ((rr & 8) ? 2 : 0);
        const unsigned offQ = (unsigned)(rr * 1024 + q * 8) * 2u, off64 = (unsigned)(rr * 64 + q * 8) * 2u;
        const char* gQ = (const char*)(QC + (size_t)(16 * wl) * 1024 + h * 256 + 128 * half) + offQ;
        const char* gK = (const char*)(KCT + (size_t)h * 16384 + (size_t)(128 * half + 32 * wl) * 64) + off64;
        const char* gS = (const char*)(SB + (size_t)h * 4096 + (size_t)(16 * (2 * half + (wl >> 1))) * 64) + off64 + (wl & 1) * 64;
        const int vrow = 32 * (wl >> 1) + 8 * (rr >> 2) + 4 * (wl & 1) + (rr & 3);
        const char* gV = (ones ? (const char*)ONES + (size_t)(16 * wl) * 128 + off64 : (const char*)(VT + (size_t)h * 32768 + (size_t)(64 * sl) * 64) + (size_t)vrow * 128 + (size_t)(q * 16));
        const float* gC = CDEC + h;
#define SC_DMA16(src, dstoff) __builtin_amdgcn_global_load_lds((const unsigned*)(src), (LAS unsigned*)(lds + (dstoff)), 16, 0, 0)
#define SC_DMA4(src, dstoff) __builtin_amdgcn_global_load_lds((const unsigned*)(src), (LAS unsigned*)(lds + (dstoff)), 4, 0, 0)
#define SC_DMA(cc, setoff) do { const int _c = (cc) < 255 ? (cc) : 255; const int _so = (setoff); \
            _Pragma("unroll") for (int kt = 0; kt < 4; ++kt) SC_DMA16(gQ + (size_t)_c * 131072 + kt * 64, _so + SC_SQ + (wl * 4 + kt) * 1024); \
            _Pragma("unroll") for (int j = 0; j < 4; ++j) SC_DMA16(gK + (size_t)_c * 131072 + (j >> 1) * 2048 + (j & 1) * 64, _so + SC_SKT + ((2 * wl + (j >> 1)) * 2 + (j & 1)) * 1024); \
            SC_DMA16(gS + (size_t)_c * 32768, _so + SC_SS + wl * 1024); \
            _Pragma("unroll") for (int k2 = 0; k2 < 2; ++k2) SC_DMA16(gV + (ones ? (size_t)0 : (size_t)_c * 262144) + k2 * 64, _so + SC_SVT + (wl * 2 + k2) * 1024); \
            SC_DMA4(gC + _c * 4, _so + SC_SWI + 256); } while (0)
        SC_DMA(0, 0); SC_DMA(1, SC_SET);
        asm volatile("s_waitcnt vmcnt(12)" ::: "memory");
        int so2 = 2 * SC_SET;
        for (int c = 0; c < 256; ++c) {
            SC_BAR();
            SC_DMA(c + 2, so2);
            asm volatile("s_waitcnt vmcnt(12)" ::: "memory");
            so2 = (so2 == 2 * SC_SET) ? 0 : so2 + SC_SET;
        }
        asm volatile("s_waitcnt vmcnt(0)" ::: "memory");
        SC_BAR();
#undef SC_DMA16
#undef SC_DMA4
#undef SC_DMA
    } else if (wave < 2) {
        f32x4 C[2][8];
#pragma unroll
        for (int u = 0; u < 2; ++u)
#pragma unroll
            for (int i = 0; i < 8; ++i) C[u][i] = (f32x4){0.f, 0.f, 0.f, 0.f};
        const int lo = fr * 64 + ((fq ^ ((fr >> 3) << 1)) * 16);
        int sco = 0;
        bf16* NUMh = (bf16*)NUM + (size_t)half * ((size_t)M * 2048); float* DENRh = DENR + (size_t)half * ((size_t)M * 4);
        __builtin_amdgcn_s_setprio(2);
        for (int c = 0; c < 256; ++c) {
            if (c > 0 && (c & (SC_PUB - 1)) == 0) asm volatile("s_waitcnt vmcnt(0)" ::: "memory");
            SC_BAR();
            const LAS unsigned char* sb_ = lds + sco; sco = (sco == 2 * SC_SET) ? 0 : sco + SC_SET;
            const LAS unsigned char* qbase = sb_ + SC_SQ + lo; const LAS unsigned char* sbase = sb_ + SC_SS + lo; const LAS unsigned char* kbase = sb_ + SC_SKT + lo;
            const LAS float* sWI = (const LAS float*)(sb_ + SC_SWI);
#define SC_LD4(F, base, s1) do { _Pragma("unroll") for (int _j = 0; _j < 4; ++_j) F[_j] = *(const LAS bf16x8*)((base) + _j * (s1)); } while (0)
#define SC_SB __builtin_amdgcn_sched_barrier(0)
#define SC_USE4(F) asm volatile("" :: "v"(F[0]), "v"(F[1]), "v"(F[2]), "v"(F[3]))
#define SC_CVT(dst, t) do { _Pragma("unroll") for (int _u = 0; _u < 2; ++_u) { \
                const u32x4 _w = (u32x4){pk2n(C[_u][t][0], C[_u][t][1]), pk2n(C[_u][t][2], C[_u][t][3]), pk2n(C[_u][(t) + 1][0], C[_u][(t) + 1][1]), pk2n(C[_u][(t) + 1][2], C[_u][(t) + 1][3])}; dst[_u] = __builtin_bit_cast(bf16x8, _w); } } while (0)
#define SC_INTER(cbv, F) do { _Pragma("unroll") for (int _u = 0; _u < 2; ++_u) _Pragma("unroll") for (int _a = 0; _a < 4; ++_a) o[_u][_a] = __builtin_amdgcn_mfma_f32_16x16x32_bf16(cbv[_u], F[_a], o[_u][_a], 0, 0, 0); } while (0)
#define SC_SCALE(t) do { _Pragma("unroll") for (int _u = 0; _u < 2; ++_u) { C[_u][t] = C[_u][t] * cdec; C[_u][(t) + 1] = C[_u][(t) + 1] * cdec; asm volatile("" : "+v"(C[_u][t]), "+v"(C[_u][(t) + 1])); } } while (0)
#define SC_MIX(nv) do { _Pragma("unroll") for (int _g = 0; _g < 8; ++_g) { __builtin_amdgcn_sched_group_barrier(0x008, 1, 0); __builtin_amdgcn_sched_group_barrier(0x002, nv, 0); } } while (0)
#define SC_UPD(F, b, k) do { _Pragma("unroll") for (int _i = 0; _i < 4; ++_i) _Pragma("unroll") for (int _u = 0; _u < 2; ++_u) \
                C[_u][4 * (b) + _i] = __builtin_amdgcn_mfma_f32_16x16x32_bf16(F[_i], v[_u][k], C[_u][4 * (b) + _i], 0, 0, 0); } while (0)
            {
                bf16x8 v[2][2], F0[4], F1[4], cba[2], cbb[2]; f32x4 o[2][4];
                const float cdec = sWI[64];
#pragma unroll
                for (int u = 0; u < 2; ++u)
#pragma unroll
                    for (int a = 0; a < 4; ++a) o[u][a] = (f32x4){0.f, 0.f, 0.f, 0.f};
                SC_LD4(F0, qbase, 4096);
                SC_CVT(cba, 0);
                SC_SB;
                SC_USE4(F0); SC_SB; SC_LD4(F1, qbase + 1024, 4096);
#pragma unroll
                for (int u = 0; u < 2; ++u)
#pragma unroll
                    for (int k2 = 0; k2 < 2; ++k2) v[u][k2] = *(const LAS bf16x8*)(sb_ + SC_SVT + (2 * (2 * wave + u) + k2) * 1024 + lo);
                SC_SB; SC_INTER(cba, F0); SC_CVT(cbb, 2); SC_SCALE(0); SC_MIX(2); SC_SB;
                SC_USE4(F1); SC_SB; SC_LD4(F0, qbase + 2048, 4096); SC_SB; SC_INTER(cbb, F1); SC_CVT(cba, 4); SC_SCALE(2); SC_MIX(2); SC_SB;
                SC_USE4(F0); SC_SB; SC_LD4(F1, qbase + 3072, 4096); SC_SB; SC_INTER(cba, F0); SC_CVT(cbb, 6); SC_SCALE(4); SC_MIX(2); SC_SB;
                SC_USE4(F1); SC_SB; SC_LD4(F0, sbase, 1024); SC_SB; SC_INTER(cbb, F1); SC_SCALE(6); SC_MIX(1); SC_SB;
                SC_USE4(F0); SC_SB; SC_LD4(F1, kbase, 2048); SC_SB;
                if (half == 0) {
#pragma unroll
                    for (int k2 = 0; k2 < 2; ++k2)
#pragma unroll
                        for (int a = 0; a < 2; ++a)
#pragma unroll
                            for (int u = 0; u < 2; ++u) o[u][a] = __builtin_amdgcn_mfma_f32_16x16x32_bf16(v[u][k2], F0[a * 2 + k2], o[u][a], 0, 0, 0);
                } else {
#pragma unroll
                    for (int k2 = 0; k2 < 2; ++k2)
#pragma unroll
                        for (int a = 0; a < 2; ++a)
#pragma unroll
                            for (int u = 0; u < 2; ++u) o[u][2 + a] = __builtin_amdgcn_mfma_f32_16x16x32_bf16(v[u][k2], F0[a * 2 + k2], o[u][2 + a], 0, 0, 0);
                }
                SC_SB;
                SC_USE4(F1); SC_SB; SC_LD4(F0, kbase + 1024, 2048); SC_SB;
                if (!ones) {
                    SC_UPD(F1, 0, 0);
#pragma unroll
                    for (int a = 0; a < 4; ++a) { const size_t mrow = (size_t)(64 * c + 16 * a + fr);
                        *(u32x4*)(NUMh + mrow * 2048 + h * 512 + 64 * sl + 32 * wave + 8 * fq) = (u32x4){pk2n(o[0][a][0], o[0][a][1]), pk2n(o[0][a][2], o[0][a][3]), pk2n(o[1][a][0], o[1][a][1]), pk2n(o[1][a][2], o[1][a][3])}; }
                    SC_MIX(2);
                } else {
                    SC_UPD(F1, 0, 0);
#pragma unroll
                    for (int a = 0; a < 4; ++a) { const size_t mrow = (size_t)(64 * c + 16 * a + fr); if (wave == 0 && fq == 0) DENRh[mrow * 4 + h] = o[0][a][0]; }
                }
                SC_SB;
                SC_USE4(F0); SC_SB; SC_LD4(F1, kbase + 8192, 2048); SC_SB; SC_UPD(F0, 0, 1); SC_SB;
                SC_USE4(F1); SC_SB; SC_LD4(F0, kbase + 8192 + 1024, 2048); SC_SB; SC_UPD(F1, 1, 0); SC_SB;
                SC_UPD(F0, 1, 1); SC_SB;
            }
#undef SC_LD4
#undef SC_SB
#undef SC_USE4
#undef SC_INTER
#undef SC_CVT
#undef SC_SCALE
#undef SC_MIX
#undef SC_UPD
        }
        __builtin_amdgcn_s_setprio(0);
        asm volatile("s_waitcnt vmcnt(0)" ::: "memory");
        SC_BAR();
    } else {
        for (int c = 0; c <= 256; ++c) {
            SC_BAR();
            if (wave == 4 && c > 0 && (c & (SC_PUB - 1)) == 0) {
                __builtin_amdgcn_fence(__ATOMIC_RELEASE, "agent");
                asm volatile("s_waitcnt vmcnt(0)" ::: "memory");
                if (lane == 0) __hip_atomic_store(prog, (unsigned)c, __ATOMIC_RELAXED, __HIP_MEMORY_SCOPE_AGENT);
            }
        }
    }
}

__device__ __forceinline__ void e4_step(int it0, int stride, const float* NUM, const float* DENR, const float* EMT, const bf16* P, const f32x4 w0, const f32x4 w1, bf16* MIX, int lane) {
    u32x4 ra[2], rb[2], ro[2], rz[2]; float dn[2], em[2];
#pragma unroll
    for (int q = 0; q < 2; ++q) { const int it = it0 + q * stride < M * 4 ? it0 + q * stride : it0; const int m = it >> 2, h = it & 3;
        const bf16* NB0 = (const bf16*)NUM + (size_t)m * 2048 + h * 512 + lane * 8;
        ra[q] = *(const u32x4*)NB0; rb[q] = *(const u32x4*)(NB0 + (size_t)M * 2048);
        ro[q] = *(const u32x4*)(P + (size_t)m * EVEN_N + 4096 + h * 512 + lane * 8); rz[q] = *(const u32x4*)(P + (size_t)m * EVEN_N + 6144 + h * 512 + lane * 8);
        dn[q] = DENR[(size_t)m * 4 + h] + DENR[(size_t)M * 4 + (size_t)m * 4 + h]; em[q] = EMT[(size_t)m * 4 + h]; }
#pragma unroll
    for (int q = 0; q < 2; ++q) { const int it = it0 + q * stride; if (it >= M * 4) break; const int m = it >> 2, h = it & 3;
        float na[8], nb[8], og[8], zg[8]; unpack8(ra[q], na); unpack8(rb[q], nb); unpack8(ro[q], og); unpack8(rz[q], zg);
        const float rd = 1.0f / fmaxf(fabsf(dn[q]), em[q]);
        float v[8]; float s = 0.f;
#pragma unroll
        for (int e = 0; e < 8; ++e) { v[e] = (na[e] + nb[e]) * rd * og[e]; s += v[e]; }
        const float mean = wave_sum(s) * (1.f / 512.f); float s2 = 0.f;
#pragma unroll
        for (int e = 0; e < 8; ++e) { v[e] -= mean; s2 += v[e] * v[e]; }
        const float rstd = 1.f / sqrtf(wave_sum(s2) * (1.f / 512.f) + LN_EPS);
        const float wv[8] = {w0.x, w0.y, w0.z, w0.w, w1.x, w1.y, w1.z, w1.w};
#pragma unroll
        for (int e = 0; e < 8; ++e) v[e] = v[e] * rstd * wv[e] * zg[e];
        u32x4 o; o.x = pk2(v[0], v[1]); o.y = pk2(v[2], v[3]); o.z = pk2(v[4], v[5]); o.w = pk2(v[6], v[7]);
        *(u32x4*)(MIX + (size_t)m * EVEN_MIX + h * 512 + lane * 8) = o; }
}
__device__ __forceinline__ void phase_e4(const float* NUM, const float* DENR, const float* EMT, const bf16* P, const float* hnw, bf16* MIX, int G) {
    int tid = threadIdx.x; asm volatile("" : "+v"(tid));
    const int lane = tid & 63, wave = tid >> 6;
    const int gw = blockIdx.x * NWAVES + wave, NGW = G * NWAVES;
    const int hh = gw & 3;
    const f32x4 w0 = *(const f32x4*)(hnw + hh * 512 + lane * 8), w1 = *(const f32x4*)(hnw + hh * 512 + lane * 8 + 4);
    for (int it0 = gw; it0 < M * 4; it0 += 2 * NGW) e4_step(it0, NGW, NUM, DENR, EMT, P, w0, w1, MIX, lane);
}
__device__ __forceinline__ void e4_fused(int bq, int nb, const unsigned* prog, const float* NUM, const float* DENR, const float* EMT, const bf16* P, const float* hnw, bf16* MIX, LAS unsigned char* lds) {
    int tid = threadIdx.x; asm volatile("" : "+v"(tid));
    const int lane = tid & 63, wave = __builtin_amdgcn_readfirstlane(tid >> 6);
    const int NGW = nb * NWAVES;
    volatile LAS unsigned* sHave = (volatile LAS unsigned*)(lds + MISC_OFF) + 16;
    unsigned have = 0u;
    const int hh = wave & 3;
    const f32x4 w0 = *(const f32x4*)(hnw + hh * 512 + lane * 8), w1 = *(const f32x4*)(hnw + hh * 512 + lane * 8 + 4);
    for (int base = bq * NWAVES; base < M * 4; base += 2 * NGW) {
        int last = base + NWAVES - 1 + NGW; last = last < M * 4 ? last : M * 4 - 1;
        const unsigned need = (unsigned)((last >> 2) >> 6) + 1u;
        if (have < need) {
            __syncthreads();
            if (wave == 0) {
                unsigned mn, sp = 0u;
                for (;;) {
                    unsigned a0 = __hip_atomic_load(prog + lane, __ATOMIC_RELAXED, __HIP_MEMORY_SCOPE_AGENT);
                    unsigned a1 = (lane < SC_ITEMS - 64) ? __hip_atomic_load(prog + 64 + lane, __ATOMIC_RELAXED, __HIP_MEMORY_SCOPE_AGENT) : 256u;
                    a0 = a0 < a1 ? a0 : a1;
#pragma unroll
                    for (int o = 32; o >= 1; o >>= 1) { const unsigned u = (unsigned)__shfl_xor((int)a0, o); a0 = a0 < u ? a0 : u; }
                    mn = a0;
                    if (mn >= need || ++sp > (1u << 16)) break;
                    __builtin_amdgcn_s_sleep(64);
                }
                __builtin_amdgcn_fence(__ATOMIC_ACQUIRE, "agent");
                asm volatile("s_waitcnt vmcnt(0)" ::: "memory");
                if (lane == 0) sHave[0] = mn;
            }
            __syncthreads();
            have = sHave[0];
        }
        e4_step(base + wave, NGW, NUM, DENR, EMT, P, w0, w1, MIX, lane);
    }
}

__device__ __forceinline__ void phase_o2(const bf16* P2, const float* pool_b, const float* pool_s, bf16* H, int G) {
    int tid = threadIdx.x; asm volatile("" : "+v"(tid));
    const int gt = blockIdx.x * NTHR + tid, NT = G * NTHR;
    for (int idx = gt; idx < 256 * 512; idx += NT) {
        const int cg = idx & 511, run = idx >> 9, g = cg >> 7, w = 2 << g, t0 = run * 64;
        const bf16* src = P2 + cg * 8;
        const f32x4 b0 = *(const f32x4*)(pool_b + cg * 8), b1 = *(const f32x4*)(pool_b + cg * 8 + 4), s0 = *(const f32x4*)(pool_s + cg * 8), s1 = *(const f32x4*)(pool_s + cg * 8 + 4);
        const float pb[8] = {b0.x, b0.y, b0.z, b0.w, b1.x, b1.y, b1.z, b1.w}, ps[8] = {s0.x, s0.y, s0.z, s0.w, s1.x, s1.y, s1.z, s1.w};
        float sum[8];
#pragma unroll
        for (int e = 0; e < 8; ++e) sum[e] = 0.f;
        for (int t = t0 - w + 1; t < t0; ++t) if (t >= 0) { float f[8]; unpack8(*(const u32x4*)(src + (size_t)t * ODD_IN), f);
#pragma unroll
            for (int e = 0; e < 8; ++e) sum[e] += f[e]; }
        for (int t = t0; t < t0 + 64; t += 4) {
            u32x4 rc[4], rz[4], ro[4];
#pragma unroll
            for (int j = 0; j < 4; ++j) { rc[j] = *(const u32x4*)(src + (size_t)(t + j) * ODD_IN); rz[j] = *(const u32x4*)(src + (size_t)(t + j) * ODD_IN + 4096);
                const int to = t + j - w + 1; ro[j] = *(const u32x4*)(src + (size_t)(to >= 0 ? to : 0) * ODD_IN); }
#pragma unroll
            for (int j = 0; j < 4; ++j) {
                float cur[8], zf[8]; unpack8(rc[j], cur); unpack8(rz[j], zf);
#pragma unroll
                for (int e = 0; e < 8; ++e) sum[e] += cur[e];
                const int tt = t + j; const float inv = 1.0f / (float)((tt + 1) < w ? (tt + 1) : w);
                float o[8];
#pragma unroll
                for (int e = 0; e < 8; ++e) o[e] = ((sum[e] * inv - cur[e]) + pb[e]) * ps[e] * zf[e];
                *(u32x4*)(H + (size_t)tt * D + cg * 8) = (u32x4){pk2(o[0], o[1]), pk2(o[2], o[3]), pk2(o[4], o[5]), pk2(o[6], o[7])};
                if (tt - w + 1 >= 0) { float old[8]; unpack8(ro[j], old);
#pragma unroll
                    for (int e = 0; e < 8; ++e) sum[e] -= old[e]; }
            }
        }
    }
}

constexpr int N_PHASES = 24;
__global__ void __launch_bounds__(NTHR, 2) fwd_kernel(Args a) {
    extern __shared__ __attribute__((aligned(16))) unsigned char lds_raw[];
    LAS unsigned char* lds = (LAS unsigned char*)lds_raw;
    const int tid = threadIdx.x, G = gridDim.x;
    unsigned char* ws = a.ws;
    for (int u = tid; u < (LDS_BYTES - LDSCTL_OFF) / 4; u += NTHR) ((LAS unsigned*)(lds + LDSCTL_OFF))[u] = 0u;
    __syncthreads();
    unsigned* barw = (unsigned*)(ws + WS_CTL) + CW_BAR;
    XcdBarrier bar; bar.bar = barw; bar.x = 0; bar.st = nullptr;
    if (!MK_MULTI) bar = xcd_barrier_post(barw, (volatile LAS unsigned*)(lds + MISC_OFF) + 8);
    const int lo = a.ph_lo, hi = a.ph_hi;
#define IN(k) (lo <= (k) && (k) < hi)
#define SEAM(k) do { if (!MK_MULTI && IN(k) && IN((k) + 1)) xcd_barrier_next(bar); } while (0)
#define SEAM0(k) do { if (!MK_MULTI && IN(k) && IN((k) + 1)) xcd_barrier(bar); } while (0)

    float* MOD = (float*)(ws + WS_MOD); float* GATES = (float*)(ws + WS_GATES);
    bf16* U = (bf16*)(ws + WS_U); float* T = (float*)(ws + WS_T); bf16* YB = (bf16*)(ws + WS_T); bf16* XH = (bf16*)(ws + WS_T + 128 * MiB);     bf16* P = (bf16*)(ws + WS_P); bf16* MIX = (bf16*)(ws + WS_MIX);
    float* NUM = (float*)(ws + WS_NUM2); bf16* POOLED = (bf16*)(ws + WS_NUM);
    float* WINTER = (float*)(ws + WS_WINTER); float* EMT = (float*)(ws + WS_EMT); float* CDEC = (float*)(ws + WS_CDEC); float* DENR = (float*)(ws + WS_DENR); float* BLWM = (float*)(ws + WS_CDEC + 65536);
    bf16* SB = (bf16*)(ws + WS_S); bf16* QC = (bf16*)(ws + WS_QC); bf16* KC = (bf16*)(ws + WS_KC); bf16* VT = (bf16*)(ws + WS_VT); bf16* VBT = (bf16*)(ws + WS_VBT); bf16* QB2 = (bf16*)(ws + WS_T); bf16* KB2 = (bf16*)(ws + WS_T + 32 * MiB);

    float* BIAS = (float*)(ws + WS_BIAS);
    if (IN(0)) { phase_mods(a, lds, G); } SEAM0(0);
    if (IN(1)) { for (int rep = 0; rep < REP_P0; ++rep) phase_weights(a, lds, G); } SEAM(1);
    if (IN(2)) {
#pragma unroll 1
        for (int lp = 0; lp < 2; ++lp) {
            const bf16* wbp = (const bf16*)(ws + WS_W + (size_t)lp * W_PAIR);
            const bf16* Wt_pool_ = (const bf16*)((const unsigned char*)wbp + W_IN_E + W_OUT_E + W_IN_O); bf16* Wt_in_o_ = (bf16*)((unsigned char*)wbp + W_IN_E + W_OUT_E);
            pg8::Gemm g{Wt_pool_, (const bf16*)(ws + WS_P) + (size_t)lp * D * D, D, D, 1024, 1024, D, 0, 4}; pg8::StaticOrder S; S.init(D, D, G, (int)blockIdx.x);
            pg8::EpiColScale E{Wt_in_o_, D, MOD + (2 * lp + 1) * 12288 + D}; pg8::gemm_phase<pg8::EpiColScale, pg8::StaticOrder, true>(lds, g, S, E);
        }
    }
    if (IN(3)) { phase_rows<true, false, false>(a.in[I_X], nullptr, nullptr, nullptr, nullptr, U, nullptr, (const bf16*)(ws + WS_WG), (const float*)(ws + WS_WG + 262144), GATES, lds, G); } SEAM(3);

#pragma unroll 1
    for (int lp = 0; lp < 2; ++lp) {
        const int pb = 4 + 10 * lp;
        const bf16* wb = (const bf16*)(ws + WS_W + (size_t)lp * W_PAIR);
        const bf16* Wt_in_e = wb; const bf16* Wt_out_e = (const bf16*)((const unsigned char*)wb + W_IN_E); const bf16* Wt_in_o = (const bf16*)((const unsigned char*)wb + W_IN_E + W_OUT_E);
        const bf16* Wt_pool = (const bf16*)((const unsigned char*)wb + W_IN_E + W_OUT_E + W_IN_O); const bf16* Wt_out_o = (const bf16*)((const unsigned char*)wb + W_IN_E + W_OUT_E + W_IN_O + W_POOL);
        const float* conv_w = lp ? a.in[24] : a.in[5]; const float* igb = lp ? a.in[25] : a.in[6]; const float* fgb = lp ? a.in[26] : a.in[7]; const float* hnw = lp ? a.in[27] : a.in[8];
        const float* lng_e = lp ? a.in[29] : a.in[10]; const float* lnb_e = lp ? a.in[30] : a.in[11];
        const float* pool_b = lp ? a.in[35] : a.in[16]; const float* pool_s = lp ? a.in[36] : a.in[17];
        const float* lng_o = lp ? a.in[38] : a.in[19]; const float* lnb_o = lp ? a.in[39] : a.in[20];
        const float* xcur_e = lp ? (const float*)a.out : a.in[I_X];
        const float* mod_e = MOD + (2 * lp) * 12288; const float* mod_o = MOD + (2 * lp + 1) * 12288;

        if (IN(pb + 0)) { chunk_gate_sums(GATES, igb, fgb, BLWM, G);
            pg8::Gemm g{U, Wt_in_e, M, EVEN_N, D, D, D, 0, 0}; pg8::StaticOrder S; S.init(M, EVEN_N, G, (int)blockIdx.x);
            pg8::EpiAct E{P, EVEN_N, 0, BIAS + (2 * lp) * 12288}; pg8::gemm_phase<pg8::EpiAct, pg8::StaticOrder, true>(lds, g, S, E); }
        SEAM(pb + 0);
        if (IN(pb + 1)) for (int rep = 0; rep < REP_E2; ++rep) {
            e2_preamble(BLWM, lds);
            for (int it = blockIdx.x; it < 1024; it += G) e2_prep_item(it >> 2, it & 3, P, conv_w, GATES, igb, fgb, QC, KC, SB, VT, VBT, QB2, KB2, WINTER, EMT, CDEC, lds);
        }
        SEAM(pb + 1);
        const bool fusedE4 = G > 2 * SC_ITEMS;
        unsigned* PROG = (unsigned*)(ws + WS_CTL + 32768) + lp * 128;
        if (IN(pb + 2)) for (int rep = 0; rep < REP_E3; ++rep) {
            const int nscan = G > 2 * SC_ITEMS ? SC_ITEMS : 0;
#define SC_CALL(it) e3_scan_item(((it) >> 1) / (SC_SLICES + 1), ((it) >> 1) % (SC_SLICES + 1), (it) & 1, QC, KC, SB, VT, WINTER, CDEC, NUM, DENR, (const bf16*)(ws + WS_CDEC + 131072), PROG + (it), lds)
            if ((int)blockIdx.x < nscan) { const int g_ = (int)blockIdx.x & 7, s_ = (int)blockIdx.x >> 3; SC_CALL(((g_ >> 1) * (SC_SLICES + 1) + s_) * 2 + (g_ & 1)); }
            else {
                if (nscan == 0) for (int it = blockIdx.x; it < SC_ITEMS; it += G) SC_CALL(it);
                for (int it = blockIdx.x - nscan; it < 2048; it += G - nscan) { const int r = 2047 - it; e3_attn_item(r & 7, r >> 3, P, QB2, KB2, VBT, MIX, lds); }
                if (nscan) e4_fused((int)blockIdx.x - nscan, G - nscan, PROG, NUM, DENR, EMT, P, hnw, MIX, lds);
            }
#undef SC_CALL
        }
        if (!fusedE4 || MK_MULTI) SEAM(pb + 2);
        if (IN(pb + 3) && !fusedE4) { phase_e4(NUM, DENR, EMT, P, hnw, MIX, G); }
        SEAM(pb + 3);
        if (IN(pb + 4)) { pg8::Gemm g{MIX, Wt_out_e, M, D, EVEN_MIX, EVEN_MIX, EVEN_MIX, 0, 0}; pg8::StaticOrder S; S.init(M, D, G, (int)blockIdx.x);
            pg8::EpiAct E{YB, D, 2, nullptr}; pg8::gemm_phase<pg8::EpiAct, pg8::StaticOrder, true>(lds, g, S, E); }
        SEAM(pb + 4);
        if (IN(pb + 5)) for (int rep = 0; rep < REP_ROWS; ++rep) {
            if (lp == 0) phase_rows<false, false, false>(a.in[I_X], YB, mod_e + 2 * D, lng_e, lnb_e, U, XH, nullptr, nullptr, nullptr, lds, G);
            else phase_rows<false, true, false>(XH, YB, mod_e + 2 * D, lng_e, lnb_e, U, XH, nullptr, nullptr, nullptr, lds, G);
        }
        SEAM(pb + 5);
        if (IN(pb + 6)) { pg8::Gemm g{U, Wt_in_o, M, ODD_IN, D, D, D, 0, 0}; pg8::StaticOrder S; S.init(M, ODD_IN, G, (int)blockIdx.x);
            pg8::EpiAct E{P, ODD_IN, 1, BIAS + (2 * lp + 1) * 12288}; pg8::gemm_phase<pg8::EpiAct, pg8::StaticOrder, true>(lds, g, S, E); }
        SEAM(pb + 6);
        if (IN(pb + 7)) { phase_o2(P, pool_b, pool_s, MIX, G); }
        SEAM(pb + 7);
        if (IN(pb + 8)) for (int rep = 0; rep < REP_GEMM; ++rep) { pg8::Gemm g{MIX, Wt_out_o, M, D, D, D, D, 0, 0}; pg8::StaticOrder S; S.init(M, D, G, (int)blockIdx.x);
            pg8::EpiAct E{YB, D, 2, nullptr}; pg8::gemm_phase<pg8::EpiAct, pg8::StaticOrder, true>(lds, g, S, E); }
        SEAM(pb + 8);
        if (IN(pb + 9)) {
            if (lp == 0) phase_rows<false, true, false>(XH, YB, mod_o + 2 * D, lng_o, lnb_o, U, XH, (const bf16*)(ws + WS_WG) + 8 * D, (const float*)(ws + WS_WG + 262144) + 8, GATES, lds, G);
            else phase_rows<false, true, true>(XH, YB, mod_o + 2 * D, lng_o, lnb_o, a.out, nullptr, nullptr, nullptr, nullptr, lds, G);
        }
        SEAM(pb + 9);
    }
#undef IN
#undef SEAM
}

extern "C" void kernel_launch(void* const* d_in, const int* in_sizes, int n_in, void* d_out, int out_size, void* d_ws, size_t ws_size, hipStream_t stream) {
    static int grid = 0;
    if (grid == 0) {
        if (n_in != 40 || in_sizes[0] != M * D || out_size != M * D || ws_size < WS_END) { fprintf(stderr, "kernel_launch: unexpected shapes (n_in %d, in0 %d, out %d, ws %zu < %zu)\n", n_in, n_in > 0 ? in_sizes[0] : -1, out_size, ws_size, (size_t)WS_END); grid = -1; return; }
        int dev = 0, cus = 0, per_cu = 0;
        if (hipGetDevice(&dev) != hipSuccess || hipDeviceGetAttribute(&cus, hipDeviceAttributeMultiprocessorCount, dev) != hipSuccess) { grid = -1; return; }
        if (hipFuncSetAttribute((const void*)fwd_kernel, hipFuncAttributeMaxDynamicSharedMemorySize, LDS_BYTES) != hipSuccess) { fprintf(stderr, "kernel_launch: hipFuncSetAttribute failed\n"); grid = -1; return; }
        if (hipOccupancyMaxActiveBlocksPerMultiprocessor(&per_cu, (const void*)fwd_kernel, NTHR, LDS_BYTES) != hipSuccess || per_cu < 1)
            fprintf(stderr, "kernel_launch: note: occupancy query reports %d workgroups per CU\n", per_cu);
        (void)hipGetLastError();
        grid = cus;
    }
    if (grid < 0) return;
    if (hipMemsetAsync((char*)d_ws + WS_CTL, 0, CTL_ZERO_BYTES, stream) != hipSuccess) return;
    Args a{};
    for (int i = 0; i < 40; ++i) a.in[i] = (const float*)d_in[i];
    a.out = (float*)d_out; a.ws = (unsigned char*)d_ws;
#if MK_MULTI
    for (int p = 0; p < N_PHASES; ++p) { a.ph_lo = p; a.ph_hi = p + 1; hipLaunchKernelGGL(fwd_kernel, dim3(grid), dim3(NTHR), LDS_BYTES, stream, a); }
#else
    a.ph_lo = 0; a.ph_hi = N_PHASES; hipLaunchKernelGGL(fwd_kernel, dim3(grid), dim3(NTHR), LDS_BYTES, stream, a);
#endif
}
```

```cpp
#include <hip/hip_runtime.h>
#include <cstdio>
#include <cstdint>

#ifndef REP_P0
#define REP_P0 1
#endif
#ifndef REP_E2
#define REP_E2 1
#endif
#ifndef REP_E3
#define REP_E3 1
#endif
#ifndef REP_ROWS
#define REP_ROWS 1
#endif
#ifndef REP_GEMM
#define REP_GEMM 1
#endif
#ifndef MK_MULTI
#define MK_MULTI 0
#endif

namespace pg8 {
#define PG8_LAS __attribute__((address_space(3)))
typedef unsigned short bf16_t;
typedef short bf16x8 __attribute__((ext_vector_type(8)));
typedef float f32x4 __attribute__((ext_vector_type(4)));
typedef unsigned u32x4 __attribute__((ext_vector_type(4)));
constexpr int BM = 256, BK = 64, HALF = 128, HTB = HALF * BK * 2, STAGE_BYTES = 8 * HTB, NXCD = 8, WGM = 8;

__host__ __device__ __forceinline__ int lds_byte(int r, int c) { const int st = (r >> 4) * 2 + (c >> 5), rr = r & 15, cc = c & 31, ob = rr * 64 + cc * 2; return st * 1024 + (ob ^ (((ob >> 9) & 1) << 5)); }
__host__ __device__ __forceinline__ void stage_rc(int b, int& R, int& C) { const int st = b / 1024, sb = b % 1024, swz = sb ^ (((sb >> 9) & 1) << 5); R = (st >> 1) * 16 + swz / 64; C = (st & 1) * 32 + (swz % 64) / 2; }
__host__ __device__ __forceinline__ int perm32(int rho) { const int n = rho >> 4, i = rho & 15; return 8 * (i >> 2) + 4 * n + (i & 3); }

struct Unit { int pm, pn; };
struct Gemm { const bf16_t* A; const bf16_t* Bt; int M, N, K, lda, ldb, grp_tiles, grpb_tiles; };

struct StaticOrder {
    int nM, nN, nwg, G, c;
    __host__ __device__ void init(int M, int N, int G_, int c_) { nM = M / BM; nN = N / BM; nwg = nM * nN; G = G_; c = c_; }
    __host__ __device__ bool next(int i, Unit& u) const {
        const long L = (long)i * G + c; if (L >= nwg) return false;
        int wgid = (int)L; { const int q = nwg / NXCD, r = nwg % NXCD, xcd = wgid % NXCD, off = wgid / NXCD; wgid = (xcd < r ? xcd * (q + 1) : r * (q + 1) + (xcd - r) * q) + off; }
        const int nig = WGM * nN, gid = wgid / nig, fm = gid * WGM, gsz = (nM - fm) < WGM ? (nM - fm) : WGM;
        u.pm = fm + ((wgid % nig) % gsz); u.pn = (wgid % nig) / gsz; return true;
    }
    __device__ __forceinline__ void a_ready(const Unit&) const {}
    __device__ __forceinline__ void done(const Unit&) const {}
};

__device__ __forceinline__ unsigned cvt_pk_bf16(float lo, float hi) { unsigned r; asm volatile("v_cvt_pk_bf16_f32 %0, %1, %2" : "=v"(r) : "v"(lo), "v"(hi)); return r; }
__device__ __forceinline__ float sigmoidf_fast(float x) { return __builtin_amdgcn_rcpf(1.0f + __expf(-x)); }

struct EpiAct {
    static constexpr bool PERM = true, AFTER_DRAIN = false;
    bf16_t* O; int ldc; int mode; const float* bias;
    __device__ __forceinline__ void operator()(const f32x4 (&acc)[2][2][4][2], const Unit& u, int wr, int wc, int fr, int fq) const {
        const int row0 = u.pm * BM + wr * 64 + fr, colt = u.pn * BM;
        int act = 0; float sc = 1.f;
        if (mode == 0) { if (colt >= 4096 && colt < 6144) act = 1; else if ((colt >= 6144 && colt < 8192) || colt >= 11264) act = 2; else if (colt >= 8192 && colt < 9216) sc = 0.08838834764831845f; }
        else if (mode == 1) { if (colt >= 4096) act = 2; }
        const int col0 = colt + wc * 32 + 8 * fq;
        f32x4 bv[2][2];
#pragma unroll
        for (int bj = 0; bj < 2; ++bj)
#pragma unroll
            for (int n = 0; n < 2; ++n) bv[bj][n] = bias ? *(const f32x4*)(bias + col0 + bj * HALF + 4 * n) : (f32x4){0.f, 0.f, 0.f, 0.f};
#pragma unroll
        for (int ai = 0; ai < 2; ++ai)
#pragma unroll
            for (int m = 0; m < 4; ++m) { bf16_t* rowp = O + (size_t)(row0 + ai * HALF + m * 16) * ldc + col0;
#pragma unroll
                for (int bj = 0; bj < 2; ++bj) { f32x4 v0 = acc[ai][bj][m][0] + bv[bj][0], v1 = acc[ai][bj][m][1] + bv[bj][1];
                    if (act == 1) {
#pragma unroll
                        for (int j = 0; j < 4; ++j) { v0[j] = sigmoidf_fast(v0[j]); v1[j] = sigmoidf_fast(v1[j]); } }
                    else if (act == 2) {
#pragma unroll
                        for (int j = 0; j < 4; ++j) { v0[j] = v0[j] * sigmoidf_fast(v0[j]); v1[j] = v1[j] * sigmoidf_fast(v1[j]); } }
                    v0 = v0 * sc; v1 = v1 * sc;
                    u32x4 w; w.x = cvt_pk_bf16(v0[0], v0[1]); w.y = cvt_pk_bf16(v0[2], v0[3]); w.z = cvt_pk_bf16(v1[0], v1[1]); w.w = cvt_pk_bf16(v1[2], v1[3]);
                    *(u32x4*)(rowp + bj * HALF) = w; } }
    }
};
struct EpiRes {
    static constexpr bool PERM = false, AFTER_DRAIN = false;
    const float* X; float* T; const float* gate; float alpha;
    __device__ __forceinline__ void operator()(const f32x4 (&acc)[2][2][4][2], const Unit& u, int wr, int wc, int fr, int fq) const {
        const int row0 = u.pm * BM + wr * 64 + fr, col0 = u.pn * BM + wc * 32 + 4 * fq;
        f32x4 gv[2][2];
#pragma unroll
        for (int bj = 0; bj < 2; ++bj)
#pragma unroll
            for (int n = 0; n < 2; ++n) gv[bj][n] = *(const f32x4*)(gate + col0 + bj * HALF + n * 16) + 1.0f;
#pragma unroll
        for (int ai = 0; ai < 2; ++ai)
#pragma unroll
            for (int m = 0; m < 4; ++m) { const size_t off = (size_t)(row0 + ai * HALF + m * 16) * 4096 + col0;
#pragma unroll
                for (int bj = 0; bj < 2; ++bj)
#pragma unroll
                    for (int n = 0; n < 2; ++n) { const f32x4 xs = *(const f32x4*)(X + off + bj * HALF + n * 16);
                        *(f32x4*)(T + off + bj * HALF + n * 16) = xs * alpha + gv[bj][n] * acc[ai][bj][m][n]; }
                asm volatile("" ::: "memory"); }
    }
};
struct EpiColScale {
    static constexpr bool PERM = true, AFTER_DRAIN = false;
    bf16_t* O; int ldc; const float* scale;
    __device__ __forceinline__ void operator()(const f32x4 (&acc)[2][2][4][2], const Unit& u, int wr, int wc, int fr, int fq) const {
        const int row0 = u.pm * BM + wr * 64 + fr, col0 = u.pn * BM + wc * 32 + 8 * fq;
        f32x4 sv[2][2];
#pragma unroll
        for (int bj = 0; bj < 2; ++bj)
#pragma unroll
            for (int n = 0; n < 2; ++n) sv[bj][n] = *(const f32x4*)(scale + col0 + bj * HALF + 4 * n) + 1.0f;
#pragma unroll
        for (int ai = 0; ai < 2; ++ai)
#pragma unroll
            for (int m = 0; m < 4; ++m) { const size_t r = (size_t)(row0 + ai * HALF + m * 16);
#pragma unroll
                for (int bj = 0; bj < 2; ++bj) { const f32x4 v0 = acc[ai][bj][m][0] * sv[bj][0], v1 = acc[ai][bj][m][1] * sv[bj][1];
                    u32x4 w; w.x = cvt_pk_bf16(v0[0], v0[1]); w.y = cvt_pk_bf16(v0[2], v0[3]); w.z = cvt_pk_bf16(v1[0], v1[1]); w.w = cvt_pk_bf16(v1[2], v1[3]);
                    *(u32x4*)(O + r * ldc + col0 + bj * HALF) = w; } }
    }
};

template <class Epi, class Sched, bool ALIGN_EPI>
__device__ __forceinline__ void gemm_phase(PG8_LAS unsigned char* lds, const Gemm g, const Sched& S, const Epi& E) {
    int tid = threadIdx.x; asm volatile("" : "+v"(tid));
    const int wid = __builtin_amdgcn_readfirstlane(tid >> 6), lane = tid & 63, wr = wid >> 2, wc = wid & 3, fr = lane & 15, fq = lane >> 4;
    const int K = g.K, nt = K / BK;
    unsigned voffA[2], voffB[2];
#pragma unroll
    for (int i = 0; i < 2; ++i) { int R, C; stage_rc(tid * 16 + i * 8192, R, C); const int Rb = Epi::PERM ? ((R & ~31) + perm32(R & 31)) : R;
        voffA[i] = (unsigned)(R * g.lda + C) * 2u; voffB[i] = (unsigned)(Rb * g.ldb + C) * 2u; }
    const size_t kstep = (size_t)(BK * 2);
    const size_t hstepA = (size_t)HALF * g.lda * 2, hstepB = (size_t)HALF * g.ldb * 2;
    const size_t tstepA = 2 * hstepA, tstepB = 2 * hstepB;
    const unsigned ldsw = (unsigned)wid * 1024u;
    const int aoff = lds_byte(wr * 64 + fr, fq * 8), boff = lds_byte(wc * 32 + fr, fq * 8);
#define PG8_UA(u) ((const char*)g.A + (size_t)(u).pm * tstepA + (g.grp_tiles ? (size_t)((u).pn / g.grp_tiles) * (size_t)K * 2 : (size_t)0))
#define PG8_UB(u) ((const char*)g.Bt + (size_t)(u).pn * tstepB + (g.grpb_tiles ? (size_t)((u).pm / g.grpb_tiles) * (size_t)K * 2 : (size_t)0))
#define PG8_SA(b, h) (((b) * 2 + (h)) * HTB)
#define PG8_SB(b, h) ((4 + (b) * 2 + (h)) * HTB)
#define PG8_STAGE(bufoff, gbase, voff) do { _Pragma("unroll") for (int _i = 0; _i < 2; ++_i) \
        __builtin_amdgcn_global_load_lds((const unsigned*)((const char*)(gbase) + (voff)[_i]), (PG8_LAS unsigned*)(lds + (bufoff) + ldsw + _i * 8192), 16, 0, 0); } while (0)
#define PG8_LDA(dst, b, h) do { _Pragma("unroll") for (int m = 0; m < 4; ++m) _Pragma("unroll") for (int k = 0; k < 2; ++k) dst[m][k] = *(const PG8_LAS bf16x8*)(lds + PG8_SA(b, h) + aoff + m * 2048 + k * 1024); } while (0)
#define PG8_LDB(dst, b, h) do { _Pragma("unroll") for (int n = 0; n < 2; ++n) _Pragma("unroll") for (int k = 0; k < 2; ++k) dst[n][k] = *(const PG8_LAS bf16x8*)(lds + PG8_SB(b, h) + boff + n * 2048 + k * 1024); } while (0)
#define PG8_MMA(ai, bj, At, Bt) do { __builtin_amdgcn_s_setprio(1); _Pragma("unroll") for (int m = 0; m < 4; ++m) _Pragma("unroll") for (int n = 0; n < 2; ++n) _Pragma("unroll") for (int k = 0; k < 2; ++k) \
        acc[ai][bj][m][n] = __builtin_amdgcn_mfma_f32_16x16x32_bf16(Bt[n][k], At[m][k], acc[ai][bj][m][n], 0, 0, 0); __builtin_amdgcn_s_setprio(0); } while (0)
#define PG8_WAIT_V(n) asm volatile("s_waitcnt vmcnt(" #n ")" ::: "memory")
#define PG8_WAIT_L(n) asm volatile("s_waitcnt lgkmcnt(" #n ")" ::: "memory")
#define PG8_BAR __builtin_amdgcn_s_barrier()
#define PG8_SCHED __builtin_amdgcn_sched_barrier(0)
    Unit cur, nxt; int ui = 0;
    if (!S.next(0, cur)) return;
    f32x4 acc[2][2][4][2];
#pragma unroll
    for (int a = 0; a < 2; ++a)
#pragma unroll
        for (int b = 0; b < 2; ++b)
#pragma unroll
            for (int m = 0; m < 4; ++m)
#pragma unroll
                for (int n = 0; n < 2; ++n) acc[a][b][m][n] = (f32x4){0.f, 0.f, 0.f, 0.f};
    bf16x8 At[4][2], B0[2][2], B1[2][2];
    const char* cA = PG8_UA(cur); const char* cB = PG8_UB(cur);
    S.a_ready(cur);
    PG8_STAGE(PG8_SB(0, 0), cB, voffB); PG8_STAGE(PG8_SB(0, 1), cB + hstepB, voffB); PG8_STAGE(PG8_SA(0, 0), cA, voffA); PG8_STAGE(PG8_SA(0, 1), cA + hstepA, voffA);
    if (wr == 1) PG8_BAR;
    PG8_WAIT_V(2); PG8_BAR;
    PG8_STAGE(PG8_SB(1, 0), cB + kstep, voffB); PG8_STAGE(PG8_SA(1, 0), cA + kstep, voffA); PG8_STAGE(PG8_SB(1, 1), cB + hstepB + kstep, voffB);
    PG8_WAIT_V(6); PG8_BAR;
    for (;;) {
        const bool has_next = S.next(ui + 1, nxt);
        const char* nA = has_next ? PG8_UA(nxt) : cA; const char* nB = has_next ? PG8_UB(nxt) : cB;
        for (int t = 0; t < nt; t += 2) {
            const bool last = (t == nt - 2);
            const char* a1 = cA + (size_t)(t + 1) * kstep;
            const char* a2 = last ? nA : cA + (size_t)(t + 2) * kstep; const char* b2 = last ? nB : cB + (size_t)(t + 2) * kstep;
            const char* a3 = a2 + kstep; const char* b3 = b2 + kstep;
            if (last && has_next) S.a_ready(nxt);
            PG8_LDB(B0, 0, 0); PG8_LDB(B1, 0, 1); PG8_SCHED; PG8_LDA(At, 0, 0); PG8_STAGE(PG8_SA(1, 1), a1 + hstepA, voffA);
            PG8_WAIT_V(8); PG8_WAIT_L(0); PG8_BAR; PG8_MMA(0, 0, At, B0); PG8_MMA(0, 1, At, B1); PG8_BAR; PG8_SCHED;
            PG8_LDA(At, 0, 1); PG8_STAGE(PG8_SB(0, 0), b2, voffB); PG8_STAGE(PG8_SB(0, 1), b2 + hstepB, voffB); PG8_STAGE(PG8_SA(0, 0), a2, voffA);
            PG8_WAIT_V(8); PG8_WAIT_L(0); PG8_BAR; PG8_MMA(1, 0, At, B0); PG8_MMA(1, 1, At, B1); PG8_BAR; PG8_SCHED;
            PG8_LDB(B0, 1, 0); PG8_LDB(B1, 1, 1); PG8_SCHED; PG8_LDA(At, 1, 0); PG8_STAGE(PG8_SA(0, 1), a2 + hstepA, voffA);
            PG8_WAIT_V(8); PG8_WAIT_L(0); PG8_BAR; PG8_MMA(0, 0, At, B0); PG8_MMA(0, 1, At, B1); PG8_BAR; PG8_SCHED;
            PG8_LDA(At, 1, 1); PG8_STAGE(PG8_SB(1, 0), b3, voffB); PG8_STAGE(PG8_SB(1, 1), b3 + hstepB, voffB); PG8_STAGE(PG8_SA(1, 0), a3, voffA);
            PG8_WAIT_V(8); PG8_WAIT_L(0); PG8_BAR; PG8_MMA(1, 0, At, B0); PG8_MMA(1, 1, At, B1); PG8_BAR; PG8_SCHED;
        }
        if constexpr (ALIGN_EPI) { if (wr == 0) PG8_BAR; }
        E(acc, cur, wr, wc, fr, fq); S.done(cur);
        if (!has_next) break;
#pragma unroll
        for (int a = 0; a < 2; ++a)
#pragma unroll
            for (int b = 0; b < 2; ++b)
#pragma unroll
                for (int m = 0; m < 4; ++m)
#pragma unroll
                    for (int n = 0; n < 2; ++n) acc[a][b][m][n] = (f32x4){0.f, 0.f, 0.f, 0.f};
        cur = nxt; cA = nA; cB = nB; ++ui;
        if constexpr (ALIGN_EPI) { if (wr == 1) PG8_BAR; }
    }
    PG8_WAIT_V(0);
    if constexpr (!ALIGN_EPI) { if (wr == 0) PG8_BAR; }
    PG8_BAR;
#undef PG8_UA
#undef PG8_UB
#undef PG8_SA
#undef PG8_SB
#undef PG8_STAGE
#undef PG8_LDA
#undef PG8_LDB
#undef PG8_MMA
#undef PG8_WAIT_V
#undef PG8_WAIT_L
#undef PG8_BAR
#undef PG8_SCHED
}
}

constexpr int NWAVES = 8, NTHR = 512;
constexpr int M = 16384, D = 4096;
constexpr int EVEN_IN = 12296, EVEN_N = 12288, EVEN_MIX = 3072, ODD_IN = 8192;
constexpr float LN_EPS = 1e-5f;
constexpr float DN_ALPHA = 1.6817928305074290861f;
constexpr float SB_EXIT = 104.0f;

constexpr size_t MiB = 1u << 20;
constexpr size_t WS_CTL = 0, CTL_ZERO_BYTES = 1 * MiB;
constexpr size_t WS_MOD = 1 * MiB;
constexpr size_t WS_WG = 2 * MiB;
constexpr size_t WS_GATES = 3 * MiB;
constexpr size_t WS_WINTER = 4 * MiB;
constexpr size_t WS_EMT = 5 * MiB;
constexpr size_t WS_CDEC = 6 * MiB;
constexpr size_t WS_DENR = 7 * MiB;
constexpr size_t WS_S = 8 * MiB;
constexpr size_t WS_QC = 16 * MiB;
constexpr size_t WS_KC = 48 * MiB;
constexpr size_t WS_U = 80 * MiB;
constexpr size_t WS_T = 208 * MiB;
constexpr size_t WS_P = 464 * MiB;
constexpr size_t WS_MIX = 848 * MiB;
constexpr size_t WS_NUM = 976 * MiB;
constexpr size_t WS_W = 1104 * MiB;
constexpr size_t W_IN_E = 96 * MiB, W_OUT_E = 24 * MiB, W_IN_O = 64 * MiB, W_POOL = 8 * MiB, W_OUT_O = 32 * MiB, W_PAIR = W_IN_E + W_OUT_E + W_IN_O + W_POOL + W_OUT_O;
constexpr size_t WS_VT = WS_W + 2 * W_PAIR;
constexpr size_t WS_VBT = WS_VT + 64 * MiB;
constexpr size_t WS_NUM2 = WS_VBT + 32 * MiB;
constexpr size_t WS_END = WS_NUM2 + 256 * MiB;
constexpr int CW_BAR = 4096;
constexpr size_t WS_BIAS = WS_CTL + 65536;

constexpr int RING_BYTES = 149504, LDSCTL_OFF = RING_BYTES, MISC_OFF = LDSCTL_OFF + 320, LDS_BYTES = 155648;

#define LAS __attribute__((address_space(3)))
typedef unsigned short bf16;
typedef float f32x4 __attribute__((ext_vector_type(4)));
typedef float f32x2 __attribute__((ext_vector_type(2)));
typedef unsigned u32x4 __attribute__((ext_vector_type(4)));
typedef unsigned u32x2 __attribute__((ext_vector_type(2)));
typedef short bf16x8 __attribute__((ext_vector_type(8)));
typedef __bf16 bf16x2n __attribute__((ext_vector_type(2)));

__device__ __forceinline__ unsigned f2bf(float f) { unsigned u = __builtin_bit_cast(unsigned, f); return (u + 0x7fffu + ((u >> 16) & 1u)) >> 16; }
__device__ __forceinline__ unsigned pk2(float lo, float hi) { return pg8::cvt_pk_bf16(lo, hi); }
__device__ __forceinline__ unsigned pk2n(float lo, float hi) { return __builtin_bit_cast(unsigned, __builtin_convertvector((f32x2){lo, hi}, bf16x2n)); }
__device__ __forceinline__ unsigned pkh(float lo, float hi) { return (unsigned)__builtin_bit_cast(unsigned short, (_Float16)lo) | ((unsigned)__builtin_bit_cast(unsigned short, (_Float16)hi) << 16); }
__device__ __forceinline__ float hlo(unsigned w) { return (float)__builtin_bit_cast(_Float16, (unsigned short)(w & 0xffffu)); }
__device__ __forceinline__ float hhi(unsigned w) { return (float)__builtin_bit_cast(_Float16, (unsigned short)(w >> 16)); }
__device__ __forceinline__ float bflo(unsigned w) { return __uint_as_float(w << 16); }
__device__ __forceinline__ float bfhi(unsigned w) { return __uint_as_float(w & 0xffff0000u); }
__device__ __forceinline__ float wave_sum(float v) {
#pragma unroll
    for (int o = 1; o < 64; o <<= 1) v += __shfl_xor(v, o);
    return v;
}
__device__ __forceinline__ float wave_max(float v) {
#pragma unroll
    for (int o = 1; o < 64; o <<= 1) v = fmaxf(v, __shfl_xor(v, o));
    return v;
}
__device__ __forceinline__ float wave_min(float v) {
#pragma unroll
    for (int o = 1; o < 64; o <<= 1) v = fminf(v, __shfl_xor(v, o));
    return v;
}
__device__ __forceinline__ float wave_incl_sum(float v, int lane) {
#pragma unroll
    for (int o = 1; o < 64; o <<= 1) { const float t = __shfl_up(v, o); if (lane >= o) v += t; }
    return v;
}
__device__ __forceinline__ float wave_incl_max(float v, int lane) {
#pragma unroll
    for (int o = 1; o < 64; o <<= 1) { const float t = __shfl_up(v, o); if (lane >= o) v = fmaxf(v, t); }
    return v;
}
__device__ __forceinline__ float logsigmoidf_acc(float x) { return x >= 0.f ? -log1pf(expf(-x)) : x - log1pf(expf(x)); }
__device__ __forceinline__ float softplusf_acc(float z) { return fmaxf(z, 0.f) + log1pf(expf(-fabsf(z))); }
__device__ __forceinline__ float softplusf_fast(float z) { return fmaxf(z, 0.f) + __logf(1.0f + __expf(-fabsf(z))); }
__device__ __forceinline__ void unpack8(const u32x4 w, float (&f)[8]) { f[0] = bflo(w.x); f[1] = bfhi(w.x); f[2] = bflo(w.y); f[3] = bfhi(w.y); f[4] = bflo(w.z); f[5] = bfhi(w.z); f[6] = bflo(w.w); f[7] = bfhi(w.w); }

#define XB_TMO      128
#define XB_XCNT(j)  (256  + 64 * (j))
#define XB_XSUB(j)  (1280 + 64 * (j))
#define XB_XGEN(j)  (2304 + 64 * (j))
#define XB_TOP      3328
#define XB_TOPGEN   3392
#define XCD_BAR_WORDS 3456
#define XB_SPIN_CAP (1u << 18)
__device__ __forceinline__ unsigned xb_ld(unsigned* p)              { return __hip_atomic_load(p, __ATOMIC_RELAXED, __HIP_MEMORY_SCOPE_AGENT); }
__device__ __forceinline__ unsigned xb_add(unsigned* p, unsigned v) { return __hip_atomic_fetch_add(p, v, __ATOMIC_RELAXED, __HIP_MEMORY_SCOPE_AGENT); }
__device__ __forceinline__ unsigned xb_xcc_id() { return (unsigned)__builtin_amdgcn_s_getreg((3 << 11) | 20) & 0xFu; }
#define XB_SPIN(cond, bar) do { unsigned _sp = 0; while (cond) { __builtin_amdgcn_s_sleep(1); \
    if ((++_sp & 255u) == 0u) { if (xb_ld(&(bar)[XB_TMO])) break; if (_sp > XB_SPIN_CAP) { atomicAdd(&(bar)[XB_TMO], 1u); break; } } } } while (0)
struct XcdBarrier { unsigned* bar; unsigned x; volatile LAS unsigned* st; };
__device__ __forceinline__ XcdBarrier xcd_barrier_post(unsigned* bar, volatile LAS unsigned* st) {
    XcdBarrier b; b.bar = bar; b.x = xb_xcc_id(); b.st = st;
    if (threadIdx.x == 0) (void)xb_add(&bar[XB_XCNT(b.x)], 1u);
    return b;
}
__device__ __forceinline__ void xcd_barrier_complete(unsigned* bar, unsigned x, unsigned& nloc, unsigned& nx) {
    const unsigned G = gridDim.x * gridDim.y * gridDim.z;
    unsigned sum, cnt, mine, sp = 0u;
    for (;;) {
        sum = 0u; cnt = 0u; mine = 0u;
#pragma unroll
        for (unsigned j = 0; j < 16; ++j) { const unsigned c = xb_ld(&bar[XB_XCNT(j)]); sum += c; cnt += (c > 0u) ? 1u : 0u; mine = (j == x) ? c : mine; }
        if (sum == G) break;
        __builtin_amdgcn_s_sleep(1);
        if ((++sp & 255u) == 0u) { if (xb_ld(&bar[XB_TMO])) break; if (sp > XB_SPIN_CAP) { atomicAdd(&bar[XB_TMO], 1u); break; } }
    }
    nloc = mine > 0u ? mine : 1u; nx = cnt > 0u ? cnt : 1u;
}
__device__ __forceinline__ void xcd_barrier(const XcdBarrier& b) {
    asm volatile("s_waitcnt vmcnt(0)" ::: "memory");
    __syncthreads();
    if (threadIdx.x == 0) {
        unsigned* bar = b.bar;
        __builtin_amdgcn_s_waitcnt(0);
        unsigned nloc = b.st[0], nx = b.st[1];
        if (nloc == 0u) { xcd_barrier_complete(bar, b.x, nloc, nx); b.st[0] = nloc; b.st[1] = nx; }
        const unsigned old = xb_add(&bar[XB_XSUB(b.x)], 1u);
        const unsigned gen = old / nloc;
        if (old + 1u == (gen + 1u) * nloc) {
            __builtin_amdgcn_fence(__ATOMIC_RELEASE, "agent");
            asm volatile("s_waitcnt vmcnt(0)" ::: "memory");
            const unsigned og = xb_add(&bar[XB_TOP], 1u);
            const unsigned tg = og / nx;
            if (og + 1u == (tg + 1u) * nx) xb_add(&bar[XB_TOPGEN], 1u);
            else XB_SPIN(xb_ld(&bar[XB_TOPGEN]) == tg, bar);
            __builtin_amdgcn_fence(__ATOMIC_ACQUIRE, "agent");
            xb_add(&bar[XB_XGEN(b.x)], 1u);
            asm volatile("s_waitcnt vmcnt(0)" ::: "memory");
        } else {
            XB_SPIN(xb_ld(&bar[XB_XGEN(b.x)]) == gen, bar);
            __builtin_amdgcn_fence(__ATOMIC_ACQUIRE, "agent");
            asm volatile("s_waitcnt vmcnt(0)" ::: "memory");
        }
    }
    __syncthreads();
}

__device__ __forceinline__ void xcd_barrier_next(const XcdBarrier& b) {
    asm volatile("s_waitcnt vmcnt(0)" ::: "memory");
    __syncthreads();
    if (threadIdx.x == 0) {
        unsigned* bar = b.bar;
        __builtin_amdgcn_s_waitcnt(0);
        const unsigned nloc = b.st[0], nx = b.st[1];
        const unsigned old = xb_add(&bar[XB_XSUB(b.x)], 1u);
        const unsigned gen = old / nloc;
        if (old + 1u == (gen + 1u) * nloc) {
            __builtin_amdgcn_fence(__ATOMIC_RELEASE, "agent");
            asm volatile("s_waitcnt vmcnt(0)" ::: "memory");
            const unsigned og = xb_add(&bar[XB_TOP], 1u);
            const unsigned tg = og / nx;
            if (og + 1u == (tg + 1u) * nx) xb_add(&bar[XB_TOPGEN], 1u);
            else XB_SPIN(xb_ld(&bar[XB_TOPGEN]) == tg, bar);
            __builtin_amdgcn_fence(__ATOMIC_ACQUIRE, "agent");
            xb_add(&bar[XB_XGEN(b.x)], 1u);
            asm volatile("s_waitcnt vmcnt(0)" ::: "memory");
        } else {
            XB_SPIN(xb_ld(&bar[XB_XGEN(b.x)]) == gen, bar);
            __builtin_amdgcn_fence(__ATOMIC_ACQUIRE, "agent");
            asm volatile("s_waitcnt vmcnt(0)" ::: "memory");
        }
    }
    __syncthreads();
}

struct Args { const float* in[40]; float* out; unsigned char* ws; int ph_lo, ph_hi; };
constexpr int I_X = 0, I_C = 1;

__device__ __forceinline__ void p0_transpose_item(const float* W, int ldw, int src_col0, bf16* WT, int ldt, int dst_row0, int nblk, LAS float* scr, int item, int lane,
                                                  const float* scl, const float* shf, float* bias) {
    const int kb = item / nblk, nb = item % nblk, k0 = 64 * kb, n0 = 32 * nb;
    float bacc = 0.f;
    LAS float* sms = scr + 64 * 33;
    if (scl) { sms[lane] = 1.0f + scl[k0 + lane]; sms[64 + lane] = shf[k0 + lane]; asm volatile("s_waitcnt lgkmcnt(0)" ::: "memory"); }
#pragma unroll 8
    for (int i = 0; i < 32; ++i) { const int kk = 2 * i + (lane >> 5); const float wv = W[(size_t)(k0 + kk) * ldw + src_col0 + n0 + (lane & 31)];
        if (scl) { scr[kk * 33 + (lane & 31)] = wv * sms[kk]; bacc += sms[64 + kk] * wv; } else scr[kk * 33 + (lane & 31)] = wv; }
    if (scl) { bacc += __shfl_xor(bacc, 32); if (lane < 32) atomicAdd(bias + dst_row0 + n0 + lane, bacc); }
    asm volatile("s_waitcnt lgkmcnt(0)" ::: "memory");
    const int c = lane & 7;
#pragma unroll
    for (int j = 0; j < 4; ++j) { const int n = (lane >> 3) + 8 * j; const LAS float* s = scr + (8 * c) * 33 + n;
        u32x4 o; o.x = pk2(s[0 * 33], s[1 * 33]); o.y = pk2(s[2 * 33], s[3 * 33]); o.z = pk2(s[4 * 33], s[5 * 33]); o.w = pk2(s[6 * 33], s[7 * 33]);
        *(u32x4*)(WT + (size_t)(dst_row0 + n0 + n) * ldt + k0 + 8 * c) = o; }
    asm volatile("s_waitcnt lgkmcnt(0)" ::: "memory");
}
__device__ __forceinline__ void p0_convert(const float* W, int K, int ldw, int src_col0, int ncols, bf16* WT, int dst_row0, LAS float* scr, int gw, int NGW, int lane,
                                           const float* scl, const float* shf, float* bias) {
    const int nblk = ncols / 32, nitems = (K / 64) * nblk;
    for (int it = gw; it < nitems; it += NGW) p0_transpose_item(W, ldw, src_col0, WT, K, dst_row0, nblk, scr, it, lane, scl, shf, bias);
}
__device__ __forceinline__ void phase_mods(const Args& a, LAS unsigned char* lds, int G) {
    __syncthreads();
    int tid = threadIdx.x; asm volatile("" : "+v"(tid));
    const int lane = tid & 63, wave = tid >> 6;
    LAS float* cact = (LAS float*)lds; LAS float* red = (LAS float*)(lds + 16384);
    for (int i = tid; i < D; i += NTHR) { const float c = a.in[I_C][i]; cact[i] = c / (1.0f + expf(-c)); }
    __syncthreads();
    float* MOD = (float*)(a.ws + WS_MOD);
    if (blockIdx.x == 0) ((u32x4*)(a.ws + WS_CDEC + 131072))[tid] = (u32x4){0x3F803F80u, 0x3F803F80u, 0x3F803F80u, 0x3F803F80u};
    for (int item = blockIdx.x; item < 4 * 192; item += G) {
        const int l = item / 192, col = (item % 192) * 64 + lane;
        const float* Wl = l == 0 ? a.in[2] : l == 1 ? a.in[12] : l == 2 ? a.in[21] : a.in[31];
        const float* bl = l == 0 ? a.in[3] : l == 1 ? a.in[13] : l == 2 ? a.in[22] : a.in[32];
        const float* Wp = Wl + (size_t)(wave * 512) * 12288 + col; const LAS float* cp = cact + wave * 512;
        float acc = 0.f;
#pragma unroll 16
        for (int k = 0; k < 512; ++k) acc += cp[k] * Wp[(size_t)k * 12288];
        red[wave * 64 + lane] = acc;
        __syncthreads();
        if (wave == 0) { float s = 0.f;
#pragma unroll
            for (int w = 0; w < 8; ++w) s += red[w * 64 + lane];
            MOD[l * 12288 + col] = s + bl[col]; }
        __syncthreads();
    }
}
__device__ __forceinline__ void phase_weights(const Args& a, LAS unsigned char* lds, int G) {
    __syncthreads();
    int tid = threadIdx.x; asm volatile("" : "+v"(tid));
    const int lane = tid & 63, wave = tid >> 6;
    unsigned char* ws = a.ws;
    const float* MOD = (const float*)(ws + WS_MOD); float* BIAS = (float*)(ws + WS_BIAS);
    LAS float* scr = (LAS float*)(lds + wave * 16384);
    const int gw = blockIdx.x * NWAVES + wave, NGW = G * NWAVES;
#pragma unroll 1
    for (int lp = 0; lp < 2; ++lp) {
        bf16* wb = (bf16*)(ws + WS_W + (size_t)lp * W_PAIR);
        const float* w_in_e = lp ? a.in[23] : a.in[4]; const float* w_out_e = lp ? a.in[28] : a.in[9];
        const float* w_in_o = lp ? a.in[33] : a.in[14]; const float* pool_w = lp ? a.in[34] : a.in[15]; const float* w_out_o = lp ? a.in[37] : a.in[18];
        bf16* Wt_in_e = wb; bf16* Wt_out_e = (bf16*)((unsigned char*)wb + W_IN_E); bf16* Wt_in_o = (bf16*)((unsigned char*)wb + W_IN_E + W_OUT_E);
        bf16* Wt_pool = (bf16*)((unsigned char*)wb + W_IN_E + W_OUT_E + W_IN_O); bf16* Wt_out_o = (bf16*)((unsigned char*)wb + W_IN_E + W_OUT_E + W_IN_O + W_POOL);
        const float* mod_e = MOD + (2 * lp) * 12288; const float* mod_o = MOD + (2 * lp + 1) * 12288;
        p0_convert(w_in_e, D, EVEN_IN, 0, 8192, Wt_in_e, 0, scr, gw, NGW, lane, mod_e + D, mod_e, BIAS + (2 * lp) * 12288);
        p0_convert(w_in_e, D, EVEN_IN, 8200, 4096, Wt_in_e, 8192, scr, gw, NGW, lane, mod_e + D, mod_e, BIAS + (2 * lp) * 12288);
        p0_convert(w_out_e, EVEN_MIX, D, 0, D, Wt_out_e, 0, scr, gw, NGW, lane, nullptr, nullptr, nullptr);
        p0_convert(w_in_o, D, ODD_IN, 4096, 4096, Wt_in_o, 4096, scr, gw, NGW, lane, mod_o + D, mod_o, BIAS + (2 * lp + 1) * 12288);
        {
            bf16* WV = (bf16*)(ws + WS_P) + (size_t)lp * D * D;
            for (size_t i = (size_t)blockIdx.x * NTHR + tid; i < (size_t)D * D / 8; i += (size_t)G * NTHR) { const size_t k = i / 512, c8 = i % 512;
                const f32x4 a0 = *(const f32x4*)(w_in_o + k * ODD_IN + c8 * 8), a1 = *(const f32x4*)(w_in_o + k * ODD_IN + c8 * 8 + 4);
                *(u32x4*)(WV + k * D + c8 * 8) = (u32x4){pk2(a0.x, a0.y), pk2(a0.z, a0.w), pk2(a1.x, a1.y), pk2(a1.z, a1.w)}; }
        }
#pragma unroll 1
        for (int g = 0; g < 4; ++g) p0_convert(pool_w + (size_t)g * 1024 * 1024, 1024, 1024, 0, 1024, Wt_pool, g * 1024, scr, gw, NGW, lane, nullptr, nullptr, nullptr);
        p0_convert(w_out_o, D, D, 0, D, Wt_out_o, 0, scr, gw, NGW, lane, nullptr, nullptr, nullptr);
        bf16* WGB = (bf16*)(ws + WS_WG) + lp * 8 * D; float* GB = (float*)(ws + WS_WG + 262144) + lp * 8;
        for (int i = blockIdx.x * NTHR + tid; i < 8 * D; i += G * NTHR) { const int j = i / D, k = i % D; WGB[i] = (bf16)f2bf(w_in_e[(size_t)k * EVEN_IN + 8192 + j] * (1.0f + mod_e[D + k])); }
        if (gw < 8) { float acc = 0.f; for (int k = lane; k < D; k += 64) acc += mod_e[k] * w_in_e[(size_t)k * EVEN_IN + 8192 + gw]; acc = wave_sum(acc); if (lane == 0) GB[gw] = acc; }
    }
}

constexpr int RW_G1 = 0, RW_LG = 16384, RW_LB = 32768, RW_WG = 49152;
template <bool FIRST, bool SRCB, bool DSTF>
__device__ __forceinline__ void phase_rows(const void* src, const bf16* Y, const float* gate, const float* lng, const float* lnb, void* xout, bf16* xh, const bf16* wgb, const float* gb, float* GATES,
                                           LAS unsigned char* lds, int G) {
    int tid = threadIdx.x; asm volatile("" : "+v"(tid));
    const int lane = tid & 63, wave = tid >> 6;
    __syncthreads();
    if (!FIRST) { for (int i = tid; i < 1024; i += NTHR) { ((LAS f32x4*)(lds + RW_G1))[i] = ((const f32x4*)gate)[i] + 1.0f; ((LAS f32x4*)(lds + RW_LG))[i] = ((const f32x4*)lng)[i]; ((LAS f32x4*)(lds + RW_LB))[i] = ((const f32x4*)lnb)[i]; } }
    if (wgb) { for (int i = tid; i < 4096; i += NTHR) ((LAS u32x4*)(lds + RW_WG))[i] = ((const u32x4*)wgb)[i]; }
    __syncthreads();
    const int gw = blockIdx.x * NWAVES + wave, NGW = G * NWAVES;
#pragma unroll 1
    for (int m = gw; m < M; m += NGW) {
        int ln = lane; asm volatile("" : "+v"(ln));
        f32x4 v[16]; u32x2 yy[16];
        if (SRCB) { const u32x2* xr = (const u32x2*)((const bf16*)src + (size_t)m * D) + ln; u32x2 xx[16];
#pragma unroll
            for (int j = 0; j < 16; ++j) xx[j] = xr[64 * j];
            if (!FIRST) { const u32x2* yr = (const u32x2*)(Y + (size_t)m * D) + ln;
#pragma unroll
                for (int j = 0; j < 16; ++j) yy[j] = yr[64 * j]; }
#pragma unroll
            for (int j = 0; j < 16; ++j) v[j] = (f32x4){hlo(xx[j].x), hhi(xx[j].x), hlo(xx[j].y), hhi(xx[j].y)}; }
        else { const f32x4* xr = (const f32x4*)((const float*)src + (size_t)m * D) + ln;
#pragma unroll
            for (int j = 0; j < 16; ++j) v[j] = xr[64 * j];
            if (!FIRST) { const u32x2* yr = (const u32x2*)(Y + (size_t)m * D) + ln;
#pragma unroll
                for (int j = 0; j < 16; ++j) yy[j] = yr[64 * j]; } }
        if (!FIRST) {
            const LAS f32x4* g1 = (const LAS f32x4*)(lds + RW_G1) + ln; const LAS f32x4* lg = (const LAS f32x4*)(lds + RW_LG) + ln; const LAS f32x4* lb = (const LAS f32x4*)(lds + RW_LB) + ln;
            float s = 0.f;
#pragma unroll
            for (int j = 0; j < 16; ++j) { const f32x4 yv = (f32x4){bflo(yy[j].x), bfhi(yy[j].x), bflo(yy[j].y), bfhi(yy[j].y)}; v[j] = v[j] * DN_ALPHA + g1[64 * j] * yv; s += (v[j].x + v[j].y) + (v[j].z + v[j].w); }
            const float mean = wave_sum(s) * (1.f / D); float s2 = 0.f;
#pragma unroll
            for (int j = 0; j < 16; ++j) { v[j] = v[j] - mean; s2 += (v[j].x * v[j].x + v[j].y * v[j].y) + (v[j].z * v[j].z + v[j].w * v[j].w); }
            const float rstd = 1.f / sqrtf(wave_sum(s2) * (1.f / D) + LN_EPS);
#pragma unroll
            for (int j = 0; j < 16; ++j) { v[j] = v[j] * rstd * lg[64 * j] + lb[64 * j];
                if (DSTF) ((f32x4*)((float*)xout + (size_t)m * D) + ln)[64 * j] = v[j]; }
        }
        if (!DSTF) { u32x2* xo = (u32x2*)((bf16*)xout + (size_t)m * D) + ln;
#pragma unroll
            for (int j = 0; j < 16; ++j) { u32x2 o; o.x = pk2(v[j].x, v[j].y); o.y = pk2(v[j].z, v[j].w); xo[64 * j] = o; }
            if (xh) { u32x2* ho = (u32x2*)(xh + (size_t)m * D) + ln;
#pragma unroll
                for (int j = 0; j < 16; ++j) { u32x2 o; o.x = pkh(v[j].x, v[j].y); o.y = pkh(v[j].z, v[j].w); ho[64 * j] = o; } } }
        if (wgb) {
            float keep = 0.f;
#pragma unroll 1
            for (int jg = 0; jg < 8; ++jg) { float p = 0.f; const LAS u32x2* wr = (const LAS u32x2*)(lds + RW_WG) + jg * 1024 + ln;
#pragma unroll
                for (int j = 0; j < 16; ++j) { const u32x2 w = wr[64 * j]; p += (v[j].x * bflo(w.x) + v[j].y * bfhi(w.x)) + (v[j].z * bflo(w.y) + v[j].w * bfhi(w.y)); }
                p = wave_sum(p); if (lane == jg) keep = p + gb[jg]; }
            if (lane < 8) GATES[(size_t)m * 8 + lane] = keep;
        }
    }
}

constexpr int E2_BL = 0, E2_WM = 4096, E2_MP = 8192;
constexpr int E2_SQ = 16384, E2_SK = E2_SQ + 64 * 528;
constexpr int E2_VC = 16384, E2_VC_PITCH = 1544;
constexpr int E2_SS = 115712, E2_SC = 123904;
static_assert(E2_SK + 64 * 528 <= E2_SS && E2_VC + 64 * E2_VC_PITCH <= E2_SS && E2_SC + 1280 <= RING_BYTES, "E2 LDS map");

__device__ __forceinline__ void chunk_gate_sums(const float* GATES, const float* igb, const float* fgb, float* BLWM, int G) {
    int tid = threadIdx.x; asm volatile("" : "+v"(tid));
    const int lane = tid & 63, wave = tid >> 6;
    for (int pair = blockIdx.x * NWAVES + wave; pair < 1024; pair += G * NWAVES) {
        const int c = pair >> 2, h = pair & 3, m = 64 * c + lane;
        const float lf = logsigmoidf_acc(GATES[(size_t)m * 8 + 4 + h] + fgb[h]), li = GATES[(size_t)m * 8 + h] + igb[h];
        const float b = wave_incl_sum(lf, lane), gmax = wave_max(li - b), blast = __shfl(b, 63);
        if (lane == 0) { BLWM[(h * 256 + c) * 2] = blast; BLWM[(h * 256 + c) * 2 + 1] = blast + gmax; }
    }
}
__device__ __forceinline__ void e2_preamble(const float* BLWM, LAS unsigned char* lds) {
    int tid = threadIdx.x; asm volatile("" : "+v"(tid));
    LAS float* sBL = (LAS float*)(lds + E2_BL); LAS float* sWM = (LAS float*)(lds + E2_WM); LAS float* sMP = (LAS float*)(lds + E2_MP);
    __syncthreads();
    for (int i = tid; i < 1024; i += NTHR) { const f32x2 v = *(const f32x2*)(BLWM + 2 * i); sBL[i] = v.x; sWM[i] = v.y; }
    __syncthreads();
    if (tid < 256) { const int hh = tid >> 6, ln = tid & 63;
        float av[4], bv[4];
#pragma unroll
        for (int i = 0; i < 4; ++i) { av[i] = sBL[hh * 256 + 4 * ln + i]; bv[i] = sWM[hh * 256 + 4 * ln + i]; }
        float A = av[0], B = bv[0];
#pragma unroll
        for (int i = 1; i < 4; ++i) { B = fmaxf(B + av[i], bv[i]); A += av[i]; }
#pragma unroll
        for (int o = 1; o < 64; o <<= 1) { const float Ap = __shfl_up(A, o), Bp = __shfl_up(B, o); if (ln >= o) { B = fmaxf(Bp + A, B); A = Ap + A; } }
        const float Ae = __shfl_up(A, 1), Be = __shfl_up(B, 1);
        float mm = ln ? fmaxf(0.f + Ae, Be) : 0.f;
#pragma unroll
        for (int i = 0; i < 4; ++i) { sMP[hh * 256 + 4 * ln + i] = mm; mm = fmaxf(av[i] + mm, bv[i]); } }
    __syncthreads();
}
__device__ __forceinline__ void e2_prep_item(int c, int h, const bf16* P, const float* conv_w, const float* GATES, const float* igb, const float* fgb,
                                             bf16* QC, bf16* KCT, bf16* SB, bf16* VT, bf16* VBT, bf16* QB2, bf16* KB2, float* WINTER, float* EMT, float* CDEC, LAS unsigned char* lds) {
    int tid = threadIdx.x; asm volatile("" : "+v"(tid));
    const int lane = tid & 63, wave = tid >> 6;
    LAS float* sMP = (LAS float*)(lds + E2_MP);
    LAS float* sb = (LAS float*)(lds + E2_SC); LAS float* sli = sb + 64; LAS float* smt = sb + 128; LAS float* sws = sb + 192;
    LAS unsigned char* sq = lds + E2_SQ; LAS unsigned char* sk = lds + E2_SK; LAS unsigned char* sS = lds + E2_SS; LAS unsigned char* sVc = lds + E2_VC;
    const int item = c * 4 + h;
    u32x4 vreg[12];
#pragma unroll
    for (int i = 0; i < 12; ++i) { const int idx = tid + NTHR * i, s = idx / 96, p = idx % 96;
        vreg[i] = *(const u32x4*)(P + (size_t)(64 * c + s) * EVEN_N + (p < 64 ? 2048 + h * 512 + p * 8 : 10240 + h * 256 + (p - 64) * 8)); }
    __syncthreads();
    if (wave == 0) {
        const int m = 64 * c + lane;
        const float lf = logsigmoidf_acc(GATES[(size_t)m * 8 + 4 + h] + fgb[h]), li = GATES[(size_t)m * 8 + h] + igb[h];
        const float b = wave_incl_sum(lf, lane), g = li - b, pm = wave_incl_max(g, lane), gmax = __shfl(pm, 63), blast = __shfl(b, 63);
        const float mprev = sMP[h * 256 + c];
        const float mt = fmaxf(b + mprev, b + pm);
        const float mnew = fmaxf(blast + mprev, blast + gmax);
        sb[lane] = b; sli[lane] = li; smt[lane] = mt; sws[lane] = expf(blast + g - mnew);
        sb[256 + lane] = expf(b + mprev - mt);
        EMT[(size_t)m * 4 + h] = expf(-mt);
        if (lane == 0) CDEC[c * 4 + h] = expf(blast + mprev - mnew);
    }
    __syncthreads();
    {
        const int d2 = tid & 127, tq = tid >> 7;
        const int dk = 2 * d2, r5 = dk & 31, pos = (dk & ~31) + 8 * ((r5 >> 2) & 3) + 4 * (r5 >> 4) + (r5 & 3);
        unsigned xw[2][19]; float cw0[2][4], cw1[2][4];
#pragma unroll
        for (int part = 0; part < 2; ++part) { const int col = part * 1024 + h * 256 + 2 * d2;
#pragma unroll
            for (int j = 0; j < 19; ++j) { const int mr = 64 * c + 16 * tq - 3 + j; xw[part][j] = (mr >= 0) ? *(const unsigned*)(P + (size_t)(mr >= 0 ? mr : 0) * EVEN_N + col) : 0u; }
#pragma unroll
            for (int j = 0; j < 4; ++j) { cw0[part][j] = conv_w[j * 2048 + col]; cw1[part][j] = conv_w[j * 2048 + col + 1]; } }
#pragma unroll
        for (int part = 0; part < 2; ++part) {
            unsigned kw0[8], kw1[8]; float p0 = 0.f, p1 = 0.f;
#pragma unroll
            for (int tt = 0; tt < 16; ++tt) {
                const int t = 16 * tq + tt, mr = 64 * c + t;
                float y0 = 0.f, y1 = 0.f;
#pragma unroll
                for (int j = 0; j < 4; ++j) { const unsigned w = xw[part][tt + j]; y0 += cw0[part][j] * bflo(w); y1 += cw1[part][j] * bfhi(w); }
                y0 = y0 * pg8::sigmoidf_fast(y0); y1 = y1 * pg8::sigmoidf_fast(y1);
                if (part == 0) { const float wq = sb[256 + t] * 0.0625f; *(LAS unsigned*)(sq + t * 528 + d2 * 4) = pk2(y0 * 0.0625f, y1 * 0.0625f); *(unsigned*)(QC + (size_t)mr * 1024 + h * 256 + pos) = pk2(y0 * wq, y1 * wq); }
                else { const float wsv = sws[t]; *(LAS unsigned*)(sk + t * 528 + d2 * 4) = pk2(y0, y1);
                    const float s0 = y0 * wsv, s1 = y1 * wsv;
                    if (tt & 1) { kw0[tt >> 1] = pk2(p0, s0); kw1[tt >> 1] = pk2(p1, s1); } else { p0 = s0; p1 = s1; } }
            }
            if (part == 1) { bf16* kr = KCT + (size_t)item * 16384 + (size_t)dk * 64 + 16 * tq;
                *(u32x4*)(kr) = (u32x4){kw0[0], kw0[1], kw0[2], kw0[3]}; *(u32x4*)(kr + 8) = (u32x4){kw0[4], kw0[5], kw0[6], kw0[7]};
                *(u32x4*)(kr + 64) = (u32x4){kw1[0], kw1[1], kw1[2], kw1[3]}; *(u32x4*)(kr + 72) = (u32x4){kw1[4], kw1[5], kw1[6], kw1[7]}; }
        }
    }
    __syncthreads();
    {
        const int wv = __builtin_amdgcn_readfirstlane(tid >> 6), ta = wv & 3, wh = wv >> 2, fr = lane & 15, fq = lane >> 4;
        f32x4 z0 = (f32x4){0.f, 0.f, 0.f, 0.f}, z1 = z0;
#pragma unroll
        for (int kk = 0; kk < 8; ++kk) { const bf16x8 af = *(const LAS bf16x8*)(sq + (16 * ta + fr) * 528 + (32 * kk + 8 * fq) * 2);
            const bf16x8 b0 = *(const LAS bf16x8*)(sk + (32 * wh + fr) * 528 + (32 * kk + 8 * fq) * 2), b1 = *(const LAS bf16x8*)(sk + (32 * wh + 16 + fr) * 528 + (32 * kk + 8 * fq) * 2);
            z0 = __builtin_amdgcn_mfma_f32_16x16x32_bf16(af, b0, z0, 0, 0, 0); z1 = __builtin_amdgcn_mfma_f32_16x16x32_bf16(af, b1, z1, 0, 0, 0); }
        const int s0 = 32 * wh + fr, s1 = s0 + 16; const float e0 = sli[s0] - sb[s0], e1 = sli[s1] - sb[s1];
#pragma unroll
        for (int r = 0; r < 4; ++r) { const int t = 16 * ta + 4 * fq + r; const float bm = sb[t] - smt[t];
            const float w0 = (s0 <= t) ? expf(bm + e0) : 0.f, w1 = (s1 <= t) ? expf(bm + e1) : 0.f;
            *(LAS unsigned short*)(sS + (t * 64 + s0) * 2) = (unsigned short)f2bf(z0[r] * w0); *(LAS unsigned short*)(sS + (t * 64 + s1) * 2) = (unsigned short)f2bf(z1[r] * w1); }
    }
    __syncthreads();
    *(u32x4*)(SB + (size_t)item * 4096 + tid * 8) = *(const LAS u32x4*)(sS + tid * 16);
#pragma unroll
    for (int i = 0; i < 12; ++i) { const int idx = tid + NTHR * i, s = idx / 96, p = idx % 96; LAS unsigned char* d = sVc + s * E2_VC_PITCH + p * 16;
        *(LAS u32x2*)d = (u32x2){vreg[i].x, vreg[i].y}; *(LAS u32x2*)(d + 8) = (u32x2){vreg[i].z, vreg[i].w}; }
    __syncthreads();
    {
        const int cp = lane >> 3, pc = lane & 7;
#pragma unroll
        for (int rd = 0; rd < 6; ++rd) {
            const int R = wave * 6 + rd, v0 = 16 * R + 2 * cp;
            unsigned x[8];
#pragma unroll
            for (int j = 0; j < 8; ++j) x[j] = *(const LAS unsigned*)(sVc + (8 * pc + j) * E2_VC_PITCH + v0 * 2);
            const u32x4 lo = (u32x4){__builtin_amdgcn_perm(x[1], x[0], 0x05040100u), __builtin_amdgcn_perm(x[3], x[2], 0x05040100u), __builtin_amdgcn_perm(x[5], x[4], 0x05040100u), __builtin_amdgcn_perm(x[7], x[6], 0x05040100u)};
            const u32x4 hi = (u32x4){__builtin_amdgcn_perm(x[1], x[0], 0x07060302u), __builtin_amdgcn_perm(x[3], x[2], 0x07060302u), __builtin_amdgcn_perm(x[5], x[4], 0x07060302u), __builtin_amdgcn_perm(x[7], x[6], 0x07060302u)};
            bf16* dst;
            if (R < 32) dst = VT + (size_t)item * 32768 + (size_t)v0 * 64 + 8 * pc;
            else { const int vb = v0 - 512; dst = VBT + ((size_t)(c * 8 + 2 * h + (vb >> 7)) * 128 + (vb & 127)) * 64 + 8 * pc; }
            *(u32x4*)dst = lo; *(u32x4*)(dst + 64) = hi;
        }
    }
}

constexpr int AT_Q = 0, AT_K = AT_Q + 128 * 272, AT_VT = AT_K + 64 * 272, AT_Z = AT_VT + 128 * 144, AT_W = AT_Z + 128 * 272, AT_MIN = AT_W + 128 * 144, AT_O = 0;
static_assert(AT_MIN + 64 <= RING_BYTES && 128 * 528 <= AT_Z, "attention LDS map");
#define AT_BAR() do { asm volatile("s_waitcnt lgkmcnt(0)" ::: "memory"); __builtin_amdgcn_s_barrier(); asm volatile("" ::: "memory"); } while (0)
__device__ __forceinline__ void e3_attn_item(int hb, int qp, const bf16* P, const bf16* QB2, const bf16* KB2, const bf16* VBT, bf16* MIX, LAS unsigned char* lds) {
    int tid = threadIdx.x; asm volatile("" : "+v"(tid));
    const int lane = tid & 63, wave = __builtin_amdgcn_readfirstlane(tid >> 6), fr = lane & 15, fq = lane >> 4;
    LAS unsigned char* sQ = lds + AT_Q; LAS unsigned char* sK = lds + AT_K; LAS unsigned char* sVT = lds + AT_VT; LAS unsigned char* sW = lds + AT_W;
    LAS float* sZ = (LAS float*)(lds + AT_Z); LAS float* sMin = (LAS float*)(lds + AT_MIN); LAS float* sO = (LAS float*)(lds + AT_O);
    const int q0 = qp * 128, t = tid >> 3, sg = tid & 7, kb0 = 2 * qp + 1;
    const int ta = wave;
    u32x4 rk[2], rv[2];
#pragma unroll
    for (int i = 0; i < 2; ++i) { const int idx = tid + NTHR * i; rk[i] = *(const u32x4*)(P + (size_t)(64 * kb0 + (idx >> 4)) * EVEN_N + 9216 + hb * 128 + (idx & 15) * 8); rv[i] = *(const u32x4*)(VBT + (size_t)(kb0 * 8 + hb) * 8192 + idx * 8); }
    __syncthreads();
#pragma unroll
    for (int i = 0; i < 4; ++i) { const int idx = tid + NTHR * i, row = idx >> 4, p = idx & 15;
        *(LAS u32x4*)(sQ + row * 272 + p * 16) = *(const u32x4*)(P + (size_t)(q0 + row) * EVEN_N + 8192 + hb * 128 + p * 8); }
    float R[2] = {0.f, 0.f}; f32x4 acc[8];
#pragma unroll
    for (int e = 0; e < 8; ++e) acc[e] = (f32x4){0.f, 0.f, 0.f, 0.f};
    for (int kb = kb0; kb >= 0; --kb) {
        const int k0 = kb * 64;
        AT_BAR();
#pragma unroll
        for (int i = 0; i < 2; ++i) { const int idx = tid + NTHR * i;
            *(LAS u32x4*)(sK + (idx >> 4) * 272 + (idx & 15) * 16) = rk[i];
            *(LAS u32x4*)(sVT + (idx >> 3) * 144 + (idx & 7) * 16) = rv[i]; }
        { const int kn = kb > 0 ? kb - 1 : 0;
#pragma unroll
            for (int i = 0; i < 2; ++i) { const int idx = tid + NTHR * i; rk[i] = *(const u32x4*)(P + (size_t)(64 * kn + (idx >> 4)) * EVEN_N + 9216 + hb * 128 + (idx & 15) * 8); rv[i] = *(const u32x4*)(VBT + (size_t)(kn * 8 + hb) * 8192 + idx * 8); } }
        AT_BAR();
        {
            f32x4 z[4];
#pragma unroll
            for (int kt = 0; kt < 4; ++kt) z[kt] = (f32x4){0.f, 0.f, 0.f, 0.f};
#pragma unroll
            for (int kk = 0; kk < 4; ++kk) { const bf16x8 af = *(const LAS bf16x8*)(sQ + (16 * ta + fr) * 272 + (32 * kk + 8 * fq) * 2);
#pragma unroll
                for (int kt = 0; kt < 4; ++kt) { const bf16x8 bq = *(const LAS bf16x8*)(sK + (16 * kt + fr) * 272 + (32 * kk + 8 * fq) * 2);
                    z[kt] = __builtin_amdgcn_mfma_f32_16x16x32_bf16(af, bq, z[kt], 0, 0, 0); } }
#pragma unroll
            for (int kt = 0; kt < 4; ++kt)
#pragma unroll
                for (int r = 0; r < 4; ++r) sZ[(16 * ta + 4 * fq + r) * 68 + 16 * kt + fr] = z[kt][r];
        }
        AT_BAR();
        {
            float rmin = 3.0e38f;
#pragma unroll
            for (int hr = 0; hr < 2; ++hr) { const int row = t + 64 * hr;
                const f32x4 za = *(const LAS f32x4*)(sZ + row * 68 + 8 * sg), zb = *(const LAS f32x4*)(sZ + row * 68 + 8 * sg + 4);
                const float z[8] = {za.x, za.y, za.z, za.w, zb.x, zb.y, zb.z, zb.w};
                float sp[8], tot = 0.f;
#pragma unroll
                for (int i = 0; i < 8; ++i) { const bool ok = (k0 + 8 * sg + i) < (q0 + row); sp[i] = ok ? softplusf_fast(z[i]) : 0.f; tot += sp[i]; }
                float v = tot;
#pragma unroll
                for (int o = 1; o < 8; o <<= 1) { const float u = __shfl_down(v, o, 8); if (sg + o < 8) v += u; }
                const float rowtot = __shfl(v, 0, 8);
                float suf = R[hr] + (v - tot);
                float w[8];
#pragma unroll
                for (int i = 7; i >= 0; --i) { const bool ok = (k0 + 8 * sg + i) < (q0 + row); w[i] = ok ? __expf(z[i] - sp[i] - suf) : 0.f; suf += sp[i]; }
                *(LAS u32x4*)(sW + row * 144 + sg * 16) = (u32x4){pk2(w[0], w[1]), pk2(w[2], w[3]), pk2(w[4], w[5]), pk2(w[6], w[7])};
                R[hr] += rowtot; rmin = fminf(rmin, R[hr]); }
            const float mn = wave_min(rmin);
            if (lane == 0) sMin[wave] = mn;
        }
        AT_BAR();
        {
#pragma unroll
            for (int kk = 0; kk < 2; ++kk) { const bf16x8 af = *(const LAS bf16x8*)(sW + (16 * ta + fr) * 144 + (32 * kk + 8 * fq) * 2);
#pragma unroll
                for (int e = 0; e < 8; ++e) { const bf16x8 bfr = *(const LAS bf16x8*)(sVT + (16 * e + fr) * 144 + (32 * kk + 8 * fq) * 2);
                    acc[e] = __builtin_amdgcn_mfma_f32_16x16x32_bf16(af, bfr, acc[e], 0, 0, 0); } }
        }
        float mn = sMin[0];
#pragma unroll
        for (int w = 1; w < 8; ++w) mn = fminf(mn, sMin[w]);
        if (mn > SB_EXIT) break;
    }
    __syncthreads();
#pragma unroll
    for (int e = 0; e < 8; ++e)
#pragma unroll
        for (int r = 0; r < 4; ++r) sO[(16 * ta + 4 * fq + r) * 132 + 16 * e + fr] = acc[e][r];
    __syncthreads();
    {
#pragma unroll
        for (int hr = 0; hr < 2; ++hr) { const int row = t + 64 * hr; const size_t m = (size_t)(q0 + row);
#pragma unroll
            for (int half = 0; half < 2; ++half) { const int d0 = 64 * half + 8 * sg;
                const f32x4 oa = *(const LAS f32x4*)(sO + row * 132 + d0), ob = *(const LAS f32x4*)(sO + row * 132 + d0 + 4);
                float zf[8]; unpack8(*(const u32x4*)(P + m * EVEN_N + 11264 + hb * 128 + d0), zf);
                u32x4 o; o.x = pk2(oa.x * zf[0], oa.y * zf[1]); o.y = pk2(oa.z * zf[2], oa.w * zf[3]); o.z = pk2(ob.x * zf[4], ob.y * zf[5]); o.w = pk2(ob.z * zf[6], ob.w * zf[7]);
                *(u32x4*)(MIX + m * EVEN_MIX + 2048 + hb * 128 + d0) = o; } }
    }
}

#define SC_BAR() do { asm volatile("s_waitcnt lgkmcnt(0)" ::: "memory"); __builtin_amdgcn_s_barrier(); asm volatile("" ::: "memory"); } while (0)
constexpr int SC_SLICES = 8, SC_ITEMS = 4 * (SC_SLICES + 1) * 2;
constexpr int SC_SQ = 0, SC_SS = 16384, SC_SWI = 24576, SC_SVT = 25088, SC_SKT = 33280, SC_SET = 49664;
constexpr int SC_NSET = 3, SC_PUB = 32;
static_assert(SC_NSET * SC_SET <= RING_BYTES, "scan LDS map");
__device__ __forceinline__ void e3_scan_item(int h, int sl, int half, const bf16* QC, const bf16* KCT, const bf16* SB, const bf16* VT, const float* WINTER, const float* CDEC,
                                             float* NUM, float* DENR, const bf16* ONES, unsigned* prog, LAS unsigned char* lds) {
    int tid = threadIdx.x; asm volatile("" : "+v"(tid));
    const int lane = tid & 63, wave = __builtin_amdgcn_readfirstlane(tid >> 6), fr = lane & 15, fq = lane >> 4;
    const bool ones = (sl == SC_SLICES);
    __syncthreads();
    if (wave & 2) {
        const int wl = (wave & 1) | ((wave >> 2) << 1), rr = lane >> 2, q = (lane & 3) ^ ((rr & 8) ? 2 : 0);
        const unsigned offQ = (unsigned)(rr * 1024 + q * 8) * 2u, off64 = (unsigned)(rr * 64 + q * 8) * 2u;
        const char* gQ = (const char*)(QC + (size_t)(16 * wl) * 1024 + h * 256 + 128 * half) + offQ;
        const char* gK = (const char*)(KCT + (size_t)h * 16384 + (size_t)(128 * half + 32 * wl) * 64) + off64;
        const char* gS = (const char*)(SB + (size_t)h * 4096 + (size_t)(16 * (2 * half + (wl >> 1))) * 64) + off64 + (wl & 1) * 64;
        const int vrow = 32 * (wl >> 1) + 8 * (rr >> 2) + 4 * (wl & 1) + (rr & 3);
        const char* gV = (ones ? (const char*)ONES + (size_t)(16 * wl) * 128 + off64 : (const char*)(VT + (size_t)h * 32768 + (size_t)(64 * sl) * 64) + (size_t)vrow * 128 + (size_t)(q * 16));
        const float* gC = CDEC + h;
#define SC_DMA16(src, dstoff) __builtin_amdgcn_global_load_lds((const unsigned*)(src), (LAS unsigned*)(lds + (dstoff)), 16, 0, 0)
#define SC_DMA4(src, dstoff) __builtin_amdgcn_global_load_lds((const unsigned*)(src), (LAS unsigned*)(lds + (dstoff)), 4, 0, 0)
#define SC_DMA(cc, setoff) do { const int _c = (cc) < 255 ? (cc) : 255; const int _so = (setoff); \
            _Pragma("unroll") for (int kt = 0; kt < 4; ++kt) SC_DMA16(gQ + (size_t)_c * 131072 + kt * 64, _so + SC_SQ + (wl * 4 + kt) * 1024); \
            _Pragma("unroll") for (int j = 0; j < 4; ++j) SC_DMA16(gK + (size_t)_c * 131072 + (j >> 1) * 2048 + (j & 1) * 64, _so + SC_SKT + ((2 * wl + (j >> 1)) * 2 + (j & 1)) * 1024); \
            SC_DMA16(gS + (size_t)_c * 32768, _so + SC_SS + wl * 1024); \
            _Pragma("unroll") for (int k2 = 0; k2 < 2; ++k2) SC_DMA16(gV + (ones ? (size_t)0 : (size_t)_c * 262144) + k2 * 64, _so + SC_SVT + (wl * 2 + k2) * 1024); \
            SC_DMA4(gC + _c * 4, _so + SC_SWI + 256); } while (0)
        SC_DMA(0, 0); SC_DMA(1, SC_SET);
        asm volatile("s_waitcnt vmcnt(12)" ::: "memory");
        int so2 = 2 * SC_SET;
        for (int c = 0; c < 256; ++c) {
            SC_BAR();
            SC_DMA(c + 2, so2);
            asm volatile("s_waitcnt vmcnt(12)" ::: "memory");
            so2 = (so2 == 2 * SC_SET) ? 0 : so2 + SC_SET;
        }
        asm volatile("s_waitcnt vmcnt(0)" ::: "memory");
        SC_BAR();
#undef SC_DMA16
#undef SC_DMA4
#undef SC_DMA
    } else if (wave < 2) {
        f32x4 C[2][8];
#pragma unroll
        for (int u = 0; u < 2; ++u)
#pragma unroll
            for (int i = 0; i < 8; ++i) C[u][i] = (f32x4){0.f, 0.f, 0.f, 0.f};
        const int lo = fr * 64 + ((fq ^ ((fr >> 3) << 1)) * 16);
        int sco = 0;
        bf16* NUMh = (bf16*)NUM + (size_t)half * ((size_t)M * 2048); float* DENRh = DENR + (size_t)half * ((size_t)M * 4);
        __builtin_amdgcn_s_setprio(2);
        for (int c = 0; c < 256; ++c) {
            if (c > 0 && (c & (SC_PUB - 1)) == 0) asm volatile("s_waitcnt vmcnt(0)" ::: "memory");
            SC_BAR();
            const LAS unsigned char* sb_ = lds + sco; sco = (sco == 2 * SC_SET) ? 0 : sco + SC_SET;
            const LAS unsigned char* qbase = sb_ + SC_SQ + lo; const LAS unsigned char* sbase = sb_ + SC_SS + lo; const LAS unsigned char* kbase = sb_ + SC_SKT + lo;
            const LAS float* sWI = (const LAS float*)(sb_ + SC_SWI);
#define SC_LD4(F, base, s1) do { _Pragma("unroll") for (int _j = 0; _j < 4; ++_j) F[_j] = *(const LAS bf16x8*)((base) + _j * (s1)); } while (0)
#define SC_SB __builtin_amdgcn_sched_barrier(0)
#define SC_USE4(F) asm volatile("" :: "v"(F[0]), "v"(F[1]), "v"(F[2]), "v"(F[3]))
#define SC_CVT(dst, t) do { _Pragma("unroll") for (int _u = 0; _u < 2; ++_u) { \
                const u32x4 _w = (u32x4){pk2n(C[_u][t][0], C[_u][t][1]), pk2n(C[_u][t][2], C[_u][t][3]), pk2n(C[_u][(t) + 1][0], C[_u][(t) + 1][1]), pk2n(C[_u][(t) + 1][2], C[_u][(t) + 1][3])}; dst[_u] = __builtin_bit_cast(bf16x8, _w); } } while (0)
#define SC_INTER(cbv, F) do { _Pragma("unroll") for (int _u = 0; _u < 2; ++_u) _Pragma("unroll") for (int _a = 0; _a < 4; ++_a) o[_u][_a] = __builtin_amdgcn_mfma_f32_16x16x32_bf16(cbv[_u], F[_a], o[_u][_a], 0, 0, 0); } while (0)
#define SC_SCALE(t) do { _Pragma("unroll") for (int _u = 0; _u < 2; ++_u) { C[_u][t] = C[_u][t] * cdec; C[_u][(t) + 1] = C[_u][(t) + 1] * cdec; asm volatile("" : "+v"(C[_u][t]), "+v"(C[_u][(t) + 1])); } } while (0)
#define SC_MIX(nv) do { _Pragma("unroll") for (int _g = 0; _g < 8; ++_g) { __builtin_amdgcn_sched_group_barrier(0x008, 1, 0); __builtin_amdgcn_sched_group_barrier(0x002, nv, 0); } } while (0)
#define SC_UPD(F, b, k) do { _Pragma("unroll") for (int _i = 0; _i < 4; ++_i) _Pragma("unroll") for (int _u = 0; _u < 2; ++_u) \
                C[_u][4 * (b) + _i] = __builtin_amdgcn_mfma_f32_16x16x32_bf16(F[_i], v[_u][k], C[_u][4 * (b) + _i], 0, 0, 0); } while (0)
            {
                bf16x8 v[2][2], F0[4], F1[4], cba[2], cbb[2]; f32x4 o[2][4];
                const float cdec = sWI[64];
#pragma unroll
                for (int u = 0; u < 2; ++u)
#pragma unroll
                    for (int a = 0; a < 4; ++a) o[u][a] = (f32x4){0.f, 0.f, 0.f, 0.f};
                SC_LD4(F0, qbase, 4096);
                SC_CVT(cba, 0);
                SC_SB;
                SC_USE4(F0); SC_SB; SC_LD4(F1, qbase + 1024, 4096);
#pragma unroll
                for (int u = 0; u < 2; ++u)
#pragma unroll
                    for (int k2 = 0; k2 < 2; ++k2) v[u][k2] = *(const LAS bf16x8*)(sb_ + SC_SVT + (2 * (2 * wave + u) + k2) * 1024 + lo);
                SC_SB; SC_INTER(cba, F0); SC_CVT(cbb, 2); SC_SCALE(0); SC_MIX(2); SC_SB;
                SC_USE4(F1); SC_SB; SC_LD4(F0, qbase + 2048, 4096); SC_SB; SC_INTER(cbb, F1); SC_CVT(cba, 4); SC_SCALE(2); SC_MIX(2); SC_SB;
                SC_USE4(F0); SC_SB; SC_LD4(F1, qbase + 3072, 4096); SC_SB; SC_INTER(cba, F0); SC_CVT(cbb, 6); SC_SCALE(4); SC_MIX(2); SC_SB;
                SC_USE4(F1); SC_SB; SC_LD4(F0, sbase, 1024); SC_SB; SC_INTER(cbb, F1); SC_SCALE(6); SC_MIX(1); SC_SB;
                SC_USE4(F0); SC_SB; SC_LD4(F1, kbase, 2048); SC_SB;
                if (half == 0) {
#pragma unroll
                    for (int k2 = 0; k2 < 2; ++k2)
#pragma unroll
                        for (int a = 0; a < 2; ++a)
#pragma unroll
                            for (int u = 0; u < 2; ++u) o[u][a] = __builtin_amdgcn_mfma_f32_16x16x32_bf16(v[u][k2], F0[a * 2 + k2], o[u][a], 0, 0, 0);
                } else {
#pragma unroll
                    for (int k2 = 0; k2 < 2; ++k2)
#pragma unroll
                        for (int a = 0; a < 2; ++a)
#pragma unroll
                            for (int u = 0; u < 2; ++u) o[u][2 + a] = __builtin_amdgcn_mfma_f32_16x16x32_bf16(v[u][k2], F0[a * 2 + k2], o[u][2 + a], 0, 0, 0);
                }
                SC_SB;
                SC_USE4(F1); SC_SB; SC_LD4(F0, kbase + 1024, 2048); SC_SB;
                if (!ones) {
                    SC_UPD(F1, 0, 0);
#pragma unroll
                    for (int a = 0; a < 4; ++a) { const size_t mrow = (size_t)(64 * c + 16 * a + fr);
                        *(u32x4*)(NUMh + mrow * 2048 + h * 512 + 64 * sl + 32 * wave + 8 * fq) = (u32x4){pk2n(o[0][a][0], o[0][a][1]), pk2n(o[0][a][2], o[0][a][3]), pk2n(o[1][a][0], o[1][a][1]), pk2n(o[1][a][2], o[1][a][3])}; }
                    SC_MIX(2);
                } else {
                    SC_UPD(F1, 0, 0);
#pragma unroll
                    for (int a = 0; a < 4; ++a) { const size_t mrow = (size_t)(64 * c + 16 * a + fr); if (wave == 0 && fq == 0) DENRh[mrow * 4 + h] = o[0][a][0]; }
                }
                SC_SB;
                SC_USE4(F0); SC_SB; SC_LD4(F1, kbase + 8192, 2048); SC_SB; SC_UPD(F0, 0, 1); SC_SB;
                SC_USE4(F1); SC_SB; SC_LD4(F0, kbase + 8192 + 1024, 2048); SC_SB; SC_UPD(F1, 1, 0); SC_SB;
                SC_UPD(F0, 1, 1); SC_SB;
            }
#undef SC_LD4
#undef SC_SB
#undef SC_USE4
#undef SC_INTER
#undef SC_CVT
#undef SC_SCALE
#undef SC_MIX
#undef SC_UPD
        }
        __builtin_amdgcn_s_setprio(0);
        asm volatile("s_waitcnt vmcnt(0)" ::: "memory");
        SC_BAR();
    } else {
        for (int c = 0; c <= 256; ++c) {
            SC_BAR();
            if (wave == 4 && c > 0 && (c & (SC_PUB - 1)) == 0) {
                __builtin_amdgcn_fence(__ATOMIC_RELEASE, "agent");
                asm volatile("s_waitcnt vmcnt(0)" ::: "memory");
                if (lane == 0) __hip_atomic_store(prog, (unsigned)c, __ATOMIC_RELAXED, __HIP_MEMORY_SCOPE_AGENT);
            }
        }
    }
}

__device__ __forceinline__ void e4_step(int it0, int stride, const float* NUM, const float* DENR, const float* EMT, const bf16* P, const f32x4 w0, const f32x4 w1, bf16* MIX, int lane) {
    u32x4 ra[2], rb[2], ro[2], rz[2]; float dn[2], em[2];
#pragma unroll
    for (int q = 0; q < 2; ++q) { const int it = it0 + q * stride < M * 4 ? it0 + q * stride : it0; const int m = it >> 2, h = it & 3;
        const bf16* NB0 = (const bf16*)NUM + (size_t)m * 2048 + h * 512 + lane * 8;
        ra[q] = *(const u32x4*)NB0; rb[q] = *(const u32x4*)(NB0 + (size_t)M * 2048);
        ro[q] = *(const u32x4*)(P + (size_t)m * EVEN_N + 4096 + h * 512 + lane * 8); rz[q] = *(const u32x4*)(P + (size_t)m * EVEN_N + 6144 + h * 512 + lane * 8);
        dn[q] = DENR[(size_t)m * 4 + h] + DENR[(size_t)M * 4 + (size_t)m * 4 + h]; em[q] = EMT[(size_t)m * 4 + h]; }
#pragma unroll
    for (int q = 0; q < 2; ++q) { const int it = it0 + q * stride; if (it >= M * 4) break; const int m = it >> 2, h = it & 3;
        float na[8], nb[8], og[8], zg[8]; unpack8(ra[q], na); unpack8(rb[q], nb); unpack8(ro[q], og); unpack8(rz[q], zg);
        const float rd = 1.0f / fmaxf(fabsf(dn[q]), em[q]);
        float v[8]; float s = 0.f;
#pragma unroll
        for (int e = 0; e < 8; ++e) { v[e] = (na[e] + nb[e]) * rd * og[e]; s += v[e]; }
        const float mean = wave_sum(s) * (1.f / 512.f); float s2 = 0.f;
#pragma unroll
        for (int e = 0; e < 8; ++e) { v[e] -= mean; s2 += v[e] * v[e]; }
        const float rstd = 1.f / sqrtf(wave_sum(s2) * (1.f / 512.f) + LN_EPS);
        const float wv[8] = {w0.x, w0.y, w0.z, w0.w, w1.x, w1.y, w1.z, w1.w};
#pragma unroll
        for (int e = 0; e < 8; ++e) v[e] = v[e] * rstd * wv[e] * zg[e];
        u32x4 o; o.x = pk2(v[0], v[1]); o.y = pk2(v[2], v[3]); o.z = pk2(v[4], v[5]); o.w = pk2(v[6], v[7]);
        *(u32x4*)(MIX + (size_t)m * EVEN_MIX + h * 512 + lane * 8) = o; }
}
__device__ __forceinline__ void phase_e4(const float* NUM, const float* DENR, const float* EMT, const bf16* P, const float* hnw, bf16* MIX, int G) {
    int tid = threadIdx.x; asm volatile("" : "+v"(tid));
    const int lane = tid & 63, wave = tid >> 6;
    const int gw = blockIdx.x * NWAVES + wave, NGW = G * NWAVES;
    const int hh = gw & 3;
    const f32x4 w0 = *(const f32x4*)(hnw + hh * 512 + lane * 8), w1 = *(const f32x4*)(hnw + hh * 512 + lane * 8 + 4);
    for (int it0 = gw; it0 < M * 4; it0 += 2 * NGW) e4_step(it0, NGW, NUM, DENR, EMT, P, w0, w1, MIX, lane);
}
__device__ __forceinline__ void e4_fused(int bq, int nb, const unsigned* prog, const float* NUM, const float* DENR, const float* EMT, const bf16* P, const float* hnw, bf16* MIX, LAS unsigned char* lds) {
    int tid = threadIdx.x; asm volatile("" : "+v"(tid));
    const int lane = tid & 63, wave = __builtin_amdgcn_readfirstlane(tid >> 6);
    const int NGW = nb * NWAVES;
    volatile LAS unsigned* sHave = (volatile LAS unsigned*)(lds + MISC_OFF) + 16;
    unsigned have = 0u;
    const int hh = wave & 3;
    const f32x4 w0 = *(const f32x4*)(hnw + hh * 512 + lane * 8), w1 = *(const f32x4*)(hnw + hh * 512 + lane * 8 + 4);
    for (int base = bq * NWAVES; base < M * 4; base += 2 * NGW) {
        int last = base + NWAVES - 1 + NGW; last = last < M * 4 ? last : M * 4 - 1;
        const unsigned need = (unsigned)((last >> 2) >> 6) + 1u;
        if (have < need) {
            __syncthreads();
            if (wave == 0) {
                unsigned mn, sp = 0u;
                for (;;) {
                    unsigned a0 = __hip_atomic_load(prog + lane, __ATOMIC_RELAXED, __HIP_MEMORY_SCOPE_AGENT);
                    unsigned a1 = (lane < SC_ITEMS - 64) ? __hip_atomic_load(prog + 64 + lane, __ATOMIC_RELAXED, __HIP_MEMORY_SCOPE_AGENT) : 256u;
                    a0 = a0 < a1 ? a0 : a1;
#pragma unroll
                    for (int o = 32; o >= 1; o >>= 1) { const unsigned u = (unsigned)__shfl_xor((int)a0, o); a0 = a0 < u ? a0 : u; }
                    mn = a0;
                    if (mn >= need || ++sp > (1u << 16)) break;
                    __builtin_amdgcn_s_sleep(64);
                }
                __builtin_amdgcn_fence(__ATOMIC_ACQUIRE, "agent");
                asm volatile("s_waitcnt vmcnt(0)" ::: "memory");
                if (lane == 0) sHave[0] = mn;
            }
            __syncthreads();
            have = sHave[0];
        }
        e4_step(base + wave, NGW, NUM, DENR, EMT, P, w0, w1, MIX, lane);
    }
}

__device__ __forceinline__ void phase_o2(const bf16* P2, const float* pool_b, const float* pool_s, bf16* H, int G) {
    int tid = threadIdx.x; asm volatile("" : "+v"(tid));
    const int gt = blockIdx.x * NTHR + tid, NT = G * NTHR;
    for (int idx = gt; idx < 256 * 512; idx += NT) {
        const int cg = idx & 511, run = idx >> 9, g = cg >> 7, w = 2 << g, t0 = run * 64;
        const bf16* src = P2 + cg * 8;
        const f32x4 b0 = *(const f32x4*)(pool_b + cg * 8), b1 = *(const f32x4*)(pool_b + cg * 8 + 4), s0 = *(const f32x4*)(pool_s + cg * 8), s1 = *(const f32x4*)(pool_s + cg * 8 + 4);
        const float pb[8] = {b0.x, b0.y, b0.z, b0.w, b1.x, b1.y, b1.z, b1.w}, ps[8] = {s0.x, s0.y, s0.z, s0.w, s1.x, s1.y, s1.z, s1.w};
        float sum[8];
#pragma unroll
        for (int e = 0; e < 8; ++e) sum[e] = 0.f;
        for (int t = t0 - w + 1; t < t0; ++t) if (t >= 0) { float f[8]; unpack8(*(const u32x4*)(src + (size_t)t * ODD_IN), f);
#pragma unroll
            for (int e = 0; e < 8; ++e) sum[e] += f[e]; }
        for (int t = t0; t < t0 + 64; t += 4) {
            u32x4 rc[4], rz[4], ro[4];
#pragma unroll
            for (int j = 0; j < 4; ++j) { rc[j] = *(const u32x4*)(src + (size_t)(t + j) * ODD_IN); rz[j] = *(const u32x4*)(src + (size_t)(t + j) * ODD_IN + 4096);
                const int to = t + j - w + 1; ro[j] = *(const u32x4*)(src + (size_t)(to >= 0 ? to : 0) * ODD_IN); }
#pragma unroll
            for (int j = 0; j < 4; ++j) {
                float cur[8], zf[8]; unpack8(rc[j], cur); unpack8(rz[j], zf);
#pragma unroll
                for (int e = 0; e < 8; ++e) sum[e] += cur[e];
                const int tt = t + j; const float inv = 1.0f / (float)((tt + 1) < w ? (tt + 1) : w);
                float o[8];
#pragma unroll
                for (int e = 0; e < 8; ++e) o[e] = ((sum[e] * inv - cur[e]) + pb[e]) * ps[e] * zf[e];
                *(u32x4*)(H + (size_t)tt * D + cg * 8) = (u32x4){pk2(o[0], o[1]), pk2(o[2], o[3]), pk2(o[4], o[5]), pk2(o[6], o[7])};
                if (tt - w + 1 >= 0) { float old[8]; unpack8(ro[j], old);
#pragma unroll
                    for (int e = 0; e < 8; ++e) sum[e] -= old[e]; }
            }
        }
    }
}

constexpr int N_PHASES = 24;
__global__ void __launch_bounds__(NTHR, 2) fwd_kernel(Args a) {
    extern __shared__ __attribute__((aligned(16))) unsigned char lds_raw[];
    LAS unsigned char* lds = (LAS unsigned char*)lds_raw;
    const int tid = threadIdx.x, G = gridDim.x;
    unsigned char* ws = a.ws;
    for (int u = tid; u < (LDS_BYTES - LDSCTL_OFF) / 4; u += NTHR) ((LAS unsigned*)(lds + LDSCTL_OFF))[u] = 0u;
    __syncthreads();
    unsigned* barw = (unsigned*)(ws + WS_CTL) + CW_BAR;
    XcdBarrier bar; bar.bar = barw; bar.x = 0; bar.st = nullptr;
    if (!MK_MULTI) bar = xcd_barrier_post(barw, (volatile LAS unsigned*)(lds + MISC_OFF) + 8);
    const int lo = a.ph_lo, hi = a.ph_hi;
#define IN(k) (lo <= (k) && (k) < hi)
#define SEAM(k) do { if (!MK_MULTI && IN(k) && IN((k) + 1)) xcd_barrier_next(bar); } while (0)
#define SEAM0(k) do { if (!MK_MULTI && IN(k) && IN((k) + 1)) xcd_barrier(bar); } while (0)

    float* MOD = (float*)(ws + WS_MOD); float* GATES = (float*)(ws + WS_GATES);
    bf16* U = (bf16*)(ws + WS_U); float* T = (float*)(ws + WS_T); bf16* YB = (bf16*)(ws + WS_T); bf16* XH = (bf16*)(ws + WS_T + 128 * MiB);     bf16* P = (bf16*)(ws + WS_P); bf16* MIX = (bf16*)(ws + WS_MIX);
    float* NUM = (float*)(ws + WS_NUM2); bf16* POOLED = (bf16*)(ws + WS_NUM);
    float* WINTER = (float*)(ws + WS_WINTER); float* EMT = (float*)(ws + WS_EMT); float* CDEC = (float*)(ws + WS_CDEC); float* DENR = (float*)(ws + WS_DENR); float* BLWM = (float*)(ws + WS_CDEC + 65536);
    bf16* SB = (bf16*)(ws + WS_S); bf16* QC = (bf16*)(ws + WS_QC); bf16* KC = (bf16*)(ws + WS_KC); bf16* VT = (bf16*)(ws + WS_VT); bf16* VBT = (bf16*)(ws + WS_VBT); bf16* QB2 = (bf16*)(ws + WS_T); bf16* KB2 = (bf16*)(ws + WS_T + 32 * MiB);

    float* BIAS = (float*)(ws + WS_BIAS);
    if (IN(0)) { phase_mods(a, lds, G); } SEAM0(0);
    if (IN(1)) { for (int rep = 0; rep < REP_P0; ++rep) phase_weights(a, lds, G); } SEAM(1);
    if (IN(2)) {
#pragma unroll 1
        for (int lp = 0; lp < 2; ++lp) {
            const bf16* wbp = (const bf16*)(ws + WS_W + (size_t)lp * W_PAIR);
            const bf16* Wt_pool_ = (const bf16*)((const unsigned char*)wbp + W_IN_E + W_OUT_E + W_IN_O); bf16* Wt_in_o_ = (bf16*)((unsigned char*)wbp + W_IN_E + W_OUT_E);
            pg8::Gemm g{Wt_pool_, (const bf16*)(ws + WS_P) + (size_t)lp * D * D, D, D, 1024, 1024, D, 0, 4}; pg8::StaticOrder S; S.init(D, D, G, (int)blockIdx.x);
            pg8::EpiColScale E{Wt_in_o_, D, MOD + (2 * lp + 1) * 12288 + D}; pg8::gemm_phase<pg8::EpiColScale, pg8::StaticOrder, true>(lds, g, S, E);
        }
    }
    if (IN(3)) { phase_rows<true, false, false>(a.in[I_X], nullptr, nullptr, nullptr, nullptr, U, nullptr, (const bf16*)(ws + WS_WG), (const float*)(ws + WS_WG + 262144), GATES, lds, G); } SEAM(3);

#pragma unroll 1
    for (int lp = 0; lp < 2; ++lp) {
        const int pb = 4 + 10 * lp;
        const bf16* wb = (const bf16*)(ws + WS_W + (size_t)lp * W_PAIR);
        const bf16* Wt_in_e = wb; const bf16* Wt_out_e = (const bf16*)((const unsigned char*)wb + W_IN_E); const bf16* Wt_in_o = (const bf16*)((const unsigned char*)wb + W_IN_E + W_OUT_E);
        const bf16* Wt_pool = (const bf16*)((const unsigned char*)wb + W_IN_E + W_OUT_E + W_IN_O); const bf16* Wt_out_o = (const bf16*)((const unsigned char*)wb + W_IN_E + W_OUT_E + W_IN_O + W_POOL);
        const float* conv_w = lp ? a.in[24] : a.in[5]; const float* igb = lp ? a.in[25] : a.in[6]; const float* fgb = lp ? a.in[26] : a.in[7]; const float* hnw = lp ? a.in[27] : a.in[8];
        const float* lng_e = lp ? a.in[29] : a.in[10]; const float* lnb_e = lp ? a.in[30] : a.in[11];
        const float* pool_b = lp ? a.in[35] : a.in[16]; const float* pool_s = lp ? a.in[36] : a.in[17];
        const float* lng_o = lp ? a.in[38] : a.in[19]; const float* lnb_o = lp ? a.in[39] : a.in[20];
        const float* xcur_e = lp ? (const float*)a.out : a.in[I_X];
        const float* mod_e = MOD + (2 * lp) * 12288; const float* mod_o = MOD + (2 * lp + 1) * 12288;

        if (IN(pb + 0)) { chunk_gate_sums(GATES, igb, fgb, BLWM, G);
            pg8::Gemm g{U, Wt_in_e, M, EVEN_N, D, D, D, 0, 0}; pg8::StaticOrder S; S.init(M, EVEN_N, G, (int)blockIdx.x);
            pg8::EpiAct E{P, EVEN_N, 0, BIAS + (2 * lp) * 12288}; pg8::gemm_phase<pg8::EpiAct, pg8::StaticOrder, true>(lds, g, S, E); }
        SEAM(pb + 0);
        if (IN(pb + 1)) for (int rep = 0; rep < REP_E2; ++rep) {
            e2_preamble(BLWM, lds);
            for (int it = blockIdx.x; it < 1024; it += G) e2_prep_item(it >> 2, it & 3, P, conv_w, GATES, igb, fgb, QC, KC, SB, VT, VBT, QB2, KB2, WINTER, EMT, CDEC, lds);
        }
        SEAM(pb + 1);
        const bool fusedE4 = G > 2 * SC_ITEMS;
        unsigned* PROG = (unsigned*)(ws + WS_CTL + 32768) + lp * 128;
        if (IN(pb + 2)) for (int rep = 0; rep < REP_E3; ++rep) {
            const int nscan = G > 2 * SC_ITEMS ? SC_ITEMS : 0;
#define SC_CALL(it) e3_scan_item(((it) >> 1) / (SC_SLICES + 1), ((it) >> 1) % (SC_SLICES + 1), (it) & 1, QC, KC, SB, VT, WINTER, CDEC, NUM, DENR, (const bf16*)(ws + WS_CDEC + 131072), PROG + (it), lds)
            if ((int)blockIdx.x < nscan) { const int g_ = (int)blockIdx.x & 7, s_ = (int)blockIdx.x >> 3; SC_CALL(((g_ >> 1) * (SC_SLICES + 1) + s_) * 2 + (g_ & 1)); }
            else {
                if (nscan == 0) for (int it = blockIdx.x; it < SC_ITEMS; it += G) SC_CALL(it);
                for (int it = blockIdx.x - nscan; it < 1024; it += G - nscan) { const int r = 1023 - it; e3_attn_item(r & 7, r >> 3, P, QB2, KB2, VBT, MIX, lds); }
                if (nscan) e4_fused((int)blockIdx.x - nscan, G - nscan, PROG, NUM, DENR, EMT, P, hnw, MIX, lds);
            }
#undef SC_CALL
        }
        if (!fusedE4 || MK_MULTI) SEAM(pb + 2);
        if (IN(pb + 3) && !fusedE4) { phase_e4(NUM, DENR, EMT, P, hnw, MIX, G); }
        SEAM(pb + 3);
        if (IN(pb + 4)) { pg8::Gemm g{MIX, Wt_out_e, M, D, EVEN_MIX, EVEN_MIX, EVEN_MIX, 0, 0}; pg8::StaticOrder S; S.init(M, D, G, (int)blockIdx.x);
            pg8::EpiAct E{YB, D, 2, nullptr}; pg8::gemm_phase<pg8::EpiAct, pg8::StaticOrder, true>(lds, g, S, E); }
        SEAM(pb + 4);
        if (IN(pb + 5)) for (int rep = 0; rep < REP_ROWS; ++rep) {
            if (lp == 0) phase_rows<false, false, false>(a.in[I_X], YB, mod_e + 2 * D, lng_e, lnb_e, U, XH, nullptr, nullptr, nullptr, lds, G);
            else phase_rows<false, true, false>(XH, YB, mod_e + 2 * D, lng_e, lnb_e, U, XH, nullptr, nullptr, nullptr, lds, G);
        }
        SEAM(pb + 5);
        if (IN(pb + 6)) { pg8::Gemm g{U, Wt_in_o, M, ODD_IN, D, D, D, 0, 0}; pg8::StaticOrder S; S.init(M, ODD_IN, G, (int)blockIdx.x);
            pg8::EpiAct E{P, ODD_IN, 1, BIAS + (2 * lp + 1) * 12288}; pg8::gemm_phase<pg8::EpiAct, pg8::StaticOrder, true>(lds, g, S, E); }
        SEAM(pb + 6);
        if (IN(pb + 7)) { phase_o2(P, pool_b, pool_s, MIX, G); }
        SEAM(pb + 7);
        if (IN(pb + 8)) for (int rep = 0; rep < REP_GEMM; ++rep) { pg8::Gemm g{MIX, Wt_out_o, M, D, D, D, D, 0, 0}; pg8::StaticOrder S; S.init(M, D, G, (int)blockIdx.x);
            pg8::EpiAct E{YB, D, 2, nullptr}; pg8::gemm_phase<pg8::EpiAct, pg8::StaticOrder, true>(lds, g, S, E); }
        SEAM(pb + 8);
        if (IN(pb + 9)) {
            if (lp == 0) phase_rows<false, true, false>(XH, YB, mod_o + 2 * D, lng_o, lnb_o, U, XH, (const bf16*)(ws + WS_WG) + 8 * D, (const float*)(ws + WS_WG + 262144) + 8, GATES, lds, G);
            else phase_rows<false, true, true>(XH, YB, mod_o + 2 * D, lng_o, lnb_o, a.out, nullptr, nullptr, nullptr, nullptr, lds, G);
        }
        SEAM(pb + 9);
    }
#undef IN
#undef SEAM
}

extern "C" void kernel_launch(void* const* d_in, const int* in_sizes, int n_in, void* d_out, int out_size, void* d_ws, size_t ws_size, hipStream_t stream) {
    static int grid = 0;
    if (grid == 0) {
        if (n_in != 40 || in_sizes[0] != M * D || out_size != M * D || ws_size < WS_END) { fprintf(stderr, "kernel_launch: unexpected shapes (n_in %d, in0 %d, out %d, ws %zu < %zu)\n", n_in, n_in > 0 ? in_sizes[0] : -1, out_size, ws_size, (size_t)WS_END); grid = -1; return; }
        int dev = 0, cus = 0, per_cu = 0;
        if (hipGetDevice(&dev) != hipSuccess || hipDeviceGetAttribute(&cus, hipDeviceAttributeMultiprocessorCount, dev) != hipSuccess) { grid = -1; return; }
        if (hipFuncSetAttribute((const void*)fwd_kernel, hipFuncAttributeMaxDynamicSharedMemorySize, LDS_BYTES) != hipSuccess) { fprintf(stderr, "kernel_launch: hipFuncSetAttribute failed\n"); grid = -1; return; }
        if (hipOccupancyMaxActiveBlocksPerMultiprocessor(&per_cu, (const void*)fwd_kernel, NTHR, LDS_BYTES) != hipSuccess || per_cu < 1)
            fprintf(stderr, "kernel_launch: note: occupancy query reports %d workgroups per CU\n", per_cu);
        (void)hipGetLastError();
        grid = cus;
    }
    if (grid < 0) return;
    if (hipMemsetAsync((char*)d_ws + WS_CTL, 0, CTL_ZERO_BYTES, stream) != hipSuccess) return;
    Args a{};
    for (int i = 0; i < 40; ++i) a.in[i] = (const float*)d_in[i];
    a.out = (float*)d_out; a.ws = (unsigned char*)d_ws;
#if MK_MULTI
    for (int p = 0; p < N_PHASES; ++p) { a.ph_lo = p; a.ph_hi = p + 1; hipLaunchKernelGGL(fwd_kernel, dim3(grid), dim3(NTHR), LDS_BYTES, stream, a); }
#else
    a.ph_lo = 0; a.ph_hi = N_PHASES; hipLaunchKernelGGL(fwd_kernel, dim3(grid), dim3(NTHR), LDS_BYTES, stream, a);
#endif
}
```

```cpp
#include <hip/hip_runtime.h>
#include <cstdio>
#include <cstdint>

#ifndef REP_P0
#define REP_P0 1
#endif
#ifndef REP_E2
#define REP_E2 1
#endif
#ifndef REP_E3
#define REP_E3 1
#endif
#ifndef REP_ROWS
#define REP_ROWS 1
#endif
#ifndef REP_GEMM
#define REP_GEMM 1
#endif
#ifndef MK_MULTI
#define MK_MULTI 0
#endif

namespace pg8 {
#define PG8_LAS __attribute__((address_space(3)))
typedef unsigned short bf16_t;
typedef short bf16x8 __attribute__((ext_vector_type(8)));
typedef float f32x4 __attribute__((ext_vector_type(4)));
typedef unsigned u32x4 __attribute__((ext_vector_type(4)));
constexpr int BM = 256, BK = 64, HALF = 128, HTB = HALF * BK * 2, STAGE_BYTES = 8 * HTB, NXCD = 8, WGM = 8;

__host__ __device__ __forceinline__ int lds_byte(int r, int c) { const int st = (r >> 4) * 2 + (c >> 5), rr = r & 15, cc = c & 31, ob = rr * 64 + cc * 2; return st * 1024 + (ob ^ (((ob >> 9) & 1) << 5)); }
__host__ __device__ __forceinline__ void stage_rc(int b, int& R, int& C) { const int st = b / 1024, sb = b % 1024, swz = sb ^ (((sb >> 9) & 1) << 5); R = (st >> 1) * 16 + swz / 64; C = (st & 1) * 32 + (swz % 64) / 2; }
__host__ __device__ __forceinline__ int perm32(int rho) { const int n = rho >> 4, i = rho & 15; return 8 * (i >> 2) + 4 * n + (i & 3); }

struct Unit { int pm, pn; };
struct Gemm { const bf16_t* A; const bf16_t* Bt; int M, N, K, lda, ldb, grp_tiles, grpb_tiles; };

struct StaticOrder {
    int nM, nN, nwg, G, c;
    __host__ __device__ void init(int M, int N, int G_, int c_) { nM = M / BM; nN = N / BM; nwg = nM * nN; G = G_; c = c_; }
    __host__ __device__ bool next(int i, Unit& u) const {
        const long L = (long)i * G + c; if (L >= nwg) return false;
        int wgid = (int)L; { const int q = nwg / NXCD, r = nwg % NXCD, xcd = wgid % NXCD, off = wgid / NXCD; wgid = (xcd < r ? xcd * (q + 1) : r * (q + 1) + (xcd - r) * q) + off; }
        const int nig = WGM * nN, gid = wgid / nig, fm = gid * WGM, gsz = (nM - fm) < WGM ? (nM - fm) : WGM;
        u.pm = fm + ((wgid % nig) % gsz); u.pn = (wgid % nig) / gsz; return true;
    }
    __device__ __forceinline__ void a_ready(const Unit&) const {}
    __device__ __forceinline__ void done(const Unit&) const {}
};

__device__ __forceinline__ unsigned cvt_pk_bf16(float lo, float hi) { unsigned r; asm volatile("v_cvt_pk_bf16_f32 %0, %1, %2" : "=v"(r) : "v"(lo), "v"(hi)); return r; }
__device__ __forceinline__ float sigmoidf_fast(float x) { return __builtin_amdgcn_rcpf(1.0f + __expf(-x)); }

struct EpiAct {
    static constexpr bool PERM = true, AFTER_DRAIN = false;
    bf16_t* O; int ldc; int mode; const float* bias;
    __device__ __forceinline__ void operator()(const f32x4 (&acc)[2][2][4][2], const Unit& u, int wr, int wc, int fr, int fq) const {
        const int row0 = u.pm * BM + wr * 64 + fr, colt = u.pn * BM;
        int act = 0; float sc = 1.f;
        if (mode == 0) { if (colt >= 4096 && colt < 6144) act = 1; else if ((colt >= 6144 && colt < 8192) || colt >= 11264) act = 2; else if (colt >= 8192 && colt < 9216) sc = 0.08838834764831845f; }
        else if (mode == 1) { if (colt >= 4096) act = 2; }
        const int col0 = colt + wc * 32 + 8 * fq;
        f32x4 bv[2][2];
#pragma unroll
        for (int bj = 0; bj < 2; ++bj)
#pragma unroll
            for (int n = 0; n < 2; ++n) bv[bj][n] = bias ? *(const f32x4*)(bias + col0 + bj * HALF + 4 * n) : (f32x4){0.f, 0.f, 0.f, 0.f};
#pragma unroll
        for (int ai = 0; ai < 2; ++ai)
#pragma unroll
            for (int m = 0; m < 4; ++m) { bf16_t* rowp = O + (size_t)(row0 + ai * HALF + m * 16) * ldc + col0;
#pragma unroll
                for (int bj = 0; bj < 2; ++bj) { f32x4 v0 = acc[ai][bj][m][0] + bv[bj][0], v1 = acc[ai][bj][m][1] + bv[bj][1];
                    if (act == 1) {
#pragma unroll
                        for (int j = 0; j < 4; ++j) { v0[j] = sigmoidf_fast(v0[j]); v1[j] = sigmoidf_fast(v1[j]); } }
                    else if (act == 2) {
#pragma unroll
                        for (int j = 0; j < 4; ++j) { v0[j] = v0[j] * sigmoidf_fast(v0[j]); v1[j] = v1[j] * sigmoidf_fast(v1[j]); } }
                    v0 = v0 * sc; v1 = v1 * sc;
                    u32x4 w; w.x = cvt_pk_bf16(v0[0], v0[1]); w.y = cvt_pk_bf16(v0[2], v0[3]); w.z = cvt_pk_bf16(v1[0], v1[1]); w.w = cvt_pk_bf16(v1[2], v1[3]);
                    *(u32x4*)(rowp + bj * HALF) = w; } }
    }
};
struct EpiRes {
    static constexpr bool PERM = false, AFTER_DRAIN = false;
    const float* X; float* T; const float* gate; float alpha;
    __device__ __forceinline__ void operator()(const f32x4 (&acc)[2][2][4][2], const Unit& u, int wr, int wc, int fr, int fq) const {
        const int row0 = u.pm * BM + wr * 64 + fr, col0 = u.pn * BM + wc * 32 + 4 * fq;
        f32x4 gv[2][2];
#pragma unroll
        for (int bj = 0; bj < 2; ++bj)
#pragma unroll
            for (int n = 0; n < 2; ++n) gv[bj][n] = *(const f32x4*)(gate + col0 + bj * HALF + n * 16) + 1.0f;
#pragma unroll
        for (int ai = 0; ai < 2; ++ai)
#pragma unroll
            for (int m = 0; m < 4; ++m) { const size_t off = (size_t)(row0 + ai * HALF + m * 16) * 4096 + col0;
#pragma unroll
                for (int bj = 0; bj < 2; ++bj)
#pragma unroll
                    for (int n = 0; n < 2; ++n) { const f32x4 xs = *(const f32x4*)(X + off + bj * HALF + n * 16);
                        *(f32x4*)(T + off + bj * HALF + n * 16) = xs * alpha + gv[bj][n] * acc[ai][bj][m][n]; }
                asm volatile("" ::: "memory"); }
    }
};
struct EpiColScale {
    static constexpr bool PERM = true, AFTER_DRAIN = false;
    bf16_t* O; int ldc; const float* scale;
    __device__ __forceinline__ void operator()(const f32x4 (&acc)[2][2][4][2], const Unit& u, int wr, int wc, int fr, int fq) const {
        const int row0 = u.pm * BM + wr * 64 + fr, col0 = u.pn * BM + wc * 32 + 8 * fq;
        f32x4 sv[2][2];
#pragma unroll
        for (int bj = 0; bj < 2; ++bj)
#pragma unroll
            for (int n = 0; n < 2; ++n) sv[bj][n] = *(const f32x4*)(scale + col0 + bj * HALF + 4 * n) + 1.0f;
#pragma unroll
        for (int ai = 0; ai < 2; ++ai)
#pragma unroll
            for (int m = 0; m < 4; ++m) { const size_t r = (size_t)(row0 + ai * HALF + m * 16);
#pragma unroll
                for (int bj = 0; bj < 2; ++bj) { const f32x4 v0 = acc[ai][bj][m][0] * sv[bj][0], v1 = acc[ai][bj][m][1] * sv[bj][1];
                    u32x4 w; w.x = cvt_pk_bf16(v0[0], v0[1]); w.y = cvt_pk_bf16(v0[2], v0[3]); w.z = cvt_pk_bf16(v1[0], v1[1]); w.w = cvt_pk_bf16(v1[2], v1[3]);
                    *(u32x4*)(O + r * ldc + col0 + bj * HALF) = w; } }
    }
};

template <class Epi, class Sched, bool ALIGN_EPI>
__device__ __forceinline__ void gemm_phase(PG8_LAS unsigned char* lds, const Gemm g, const Sched& S, const Epi& E) {
    int tid = threadIdx.x; asm volatile("" : "+v"(tid));
    const int wid = __builtin_amdgcn_readfirstlane(tid >> 6), lane = tid & 63, wr = wid >> 2, wc = wid & 3, fr = lane & 15, fq = lane >> 4;
    const int K = g.K, nt = K / BK;
    unsigned voffA[2], voffB[2];
#pragma unroll
    for (int i = 0; i < 2; ++i) { int R, C; stage_rc(tid * 16 + i * 8192, R, C); const int Rb = Epi::PERM ? ((R & ~31) + perm32(R & 31)) : R;
        voffA[i] = (unsigned)(R * g.lda + C) * 2u; voffB[i] = (unsigned)(Rb * g.ldb + C) * 2u; }
    const size_t kstep = (size_t)(BK * 2);
    const size_t hstepA = (size_t)HALF * g.lda * 2, hstepB = (size_t)HALF * g.ldb * 2;
    const size_t tstepA = 2 * hstepA, tstepB = 2 * hstepB;
    const unsigned ldsw = (unsigned)wid * 1024u;
    const int aoff = lds_byte(wr * 64 + fr, fq * 8), boff = lds_byte(wc * 32 + fr, fq * 8);
#define PG8_UA(u) ((const char*)g.A + (size_t)(u).pm * tstepA + (g.grp_tiles ? (size_t)((u).pn / g.grp_tiles) * (size_t)K * 2 : (size_t)0))
#define PG8_UB(u) ((const char*)g.Bt + (size_t)(u).pn * tstepB + (g.grpb_tiles ? (size_t)((u).pm / g.grpb_tiles) * (size_t)K * 2 : (size_t)0))
#define PG8_SA(b, h) (((b) * 2 + (h)) * HTB)
#define PG8_SB(b, h) ((4 + (b) * 2 + (h)) * HTB)
#define PG8_STAGE(bufoff, gbase, voff) do { _Pragma("unroll") for (int _i = 0; _i < 2; ++_i) \
        __builtin_amdgcn_global_load_lds((const unsigned*)((const char*)(gbase) + (voff)[_i]), (PG8_LAS unsigned*)(lds + (bufoff) + ldsw + _i * 8192), 16, 0, 0); } while (0)
#define PG8_LDA(dst, b, h) do { _Pragma("unroll") for (int m = 0; m < 4; ++m) _Pragma("unroll") for (int k = 0; k < 2; ++k) dst[m][k] = *(const PG8_LAS bf16x8*)(lds + PG8_SA(b, h) + aoff + m * 2048 + k * 1024); } while (0)
#define PG8_LDB(dst, b, h) do { _Pragma("unroll") for (int n = 0; n < 2; ++n) _Pragma("unroll") for (int k = 0; k < 2; ++k) dst[n][k] = *(const PG8_LAS bf16x8*)(lds + PG8_SB(b, h) + boff + n * 2048 + k * 1024); } while (0)
#define PG8_MMA(ai, bj, At, Bt) do { __builtin_amdgcn_s_setprio(1); _Pragma("unroll") for (int m = 0; m < 4; ++m) _Pragma("unroll") for (int n = 0; n < 2; ++n) _Pragma("unroll") for (int k = 0; k < 2; ++k) \
        acc[ai][bj][m][n] = __builtin_amdgcn_mfma_f32_16x16x32_bf16(Bt[n][k], At[m][k], acc[ai][bj][m][n], 0, 0, 0); __builtin_amdgcn_s_setprio(0); } while (0)
#define PG8_WAIT_V(n) asm volatile("s_waitcnt vmcnt(" #n ")" ::: "memory")
#define PG8_WAIT_L(n) asm volatile("s_waitcnt lgkmcnt(" #n ")" ::: "memory")
#define PG8_BAR __builtin_amdgcn_s_barrier()
#define PG8_SCHED __builtin_amdgcn_sched_barrier(0)
    Unit cur, nxt; int ui = 0;
    if (!S.next(0, cur)) return;
    f32x4 acc[2][2][4][2];
#pragma unroll
    for (int a = 0; a < 2; ++a)
#pragma unroll
        for (int b = 0; b < 2; ++b)
#pragma unroll
            for (int m = 0; m < 4; ++m)
#pragma unroll
                for (int n = 0; n < 2; ++n) acc[a][b][m][n] = (f32x4){0.f, 0.f, 0.f, 0.f};
    bf16x8 At[4][2], B0[2][2], B1[2][2];
    const char* cA = PG8_UA(cur); const char* cB = PG8_UB(cur);
    S.a_ready(cur);
    PG8_STAGE(PG8_SB(0, 0), cB, voffB); PG8_STAGE(PG8_SB(0, 1), cB + hstepB, voffB); PG8_STAGE(PG8_SA(0, 0), cA, voffA); PG8_STAGE(PG8_SA(0, 1), cA + hstepA, voffA);
    if (wr == 1) PG8_BAR;
    PG8_WAIT_V(2); PG8_BAR;
    PG8_STAGE(PG8_SB(1, 0), cB + kstep, voffB); PG8_STAGE(PG8_SA(1, 0), cA + kstep, voffA); PG8_STAGE(PG8_SB(1, 1), cB + hstepB + kstep, voffB);
    PG8_WAIT_V(6); PG8_BAR;
    for (;;) {
        const bool has_next = S.next(ui + 1, nxt);
        const char* nA = has_next ? PG8_UA(nxt) : cA; const char* nB = has_next ? PG8_UB(nxt) : cB;
        for (int t = 0; t < nt; t += 2) {
            const bool last = (t == nt - 2);
            const char* a1 = cA + (size_t)(t + 1) * kstep;
            const char* a2 = last ? nA : cA + (size_t)(t + 2) * kstep; const char* b2 = last ? nB : cB + (size_t)(t + 2) * kstep;
            const char* a3 = a2 + kstep; const char* b3 = b2 + kstep;
            if (last && has_next) S.a_ready(nxt);
            PG8_LDB(B0, 0, 0); PG8_LDB(B1, 0, 1); PG8_SCHED; PG8_LDA(At, 0, 0); PG8_STAGE(PG8_SA(1, 1), a1 + hstepA, voffA);
            PG8_WAIT_V(8); PG8_WAIT_L(0); PG8_BAR; PG8_MMA(0, 0, At, B0); PG8_MMA(0, 1, At, B1); PG8_BAR; PG8_SCHED;
            PG8_LDA(At, 0, 1); PG8_STAGE(PG8_SB(0, 0), b2, voffB); PG8_STAGE(PG8_SB(0, 1), b2 + hstepB, voffB); PG8_STAGE(PG8_SA(0, 0), a2, voffA);
            PG8_WAIT_V(8); PG8_WAIT_L(0); PG8_BAR; PG8_MMA(1, 0, At, B0); PG8_MMA(1, 1, At, B1); PG8_BAR; PG8_SCHED;
            PG8_LDB(B0, 1, 0); PG8_LDB(B1, 1, 1); PG8_SCHED; PG8_LDA(At, 1, 0); PG8_STAGE(PG8_SA(0, 1), a2 + hstepA, voffA);
            PG8_WAIT_V(8); PG8_WAIT_L(0); PG8_BAR; PG8_MMA(0, 0, At, B0); PG8_MMA(0, 1, At, B1); PG8_BAR; PG8_SCHED;
            PG8_LDA(At, 1, 1); PG8_STAGE(PG8_SB(1, 0), b3, voffB); PG8_STAGE(PG8_SB(1, 1), b3 + hstepB, voffB); PG8_STAGE(PG8_SA(1, 0), a3, voffA);
            PG8_WAIT_V(8); PG8_WAIT_L(0); PG8_BAR; PG8_MMA(1, 0, At, B0); PG8_MMA(1, 1, At, B1); PG8_BAR; PG8_SCHED;
        }
        if constexpr (ALIGN_EPI) { if (wr == 0) PG8_BAR; }
        E(acc, cur, wr, wc, fr, fq); S.done(cur);
        if (!has_next) break;
#pragma unroll
        for (int a = 0; a < 2; ++a)
#pragma unroll
            for (int b = 0; b < 2; ++b)
#pragma unroll
                for (int m = 0; m < 4; ++m)
#pragma unroll
                    for (int n = 0; n < 2; ++n) acc[a][b][m][n] = (f32x4){0.f, 0.f, 0.f, 0.f};
        cur = nxt; cA = nA; cB = nB; ++ui;
        if constexpr (ALIGN_EPI) { if (wr == 1) PG8_BAR; }
    }
    PG8_WAIT_V(0);
    if constexpr (!ALIGN_EPI) { if (wr == 0) PG8_BAR; }
    PG8_BAR;
#undef PG8_UA
#undef PG8_UB
#undef PG8_SA
#undef PG8_SB
#undef PG8_STAGE
#undef PG8_LDA
#undef PG8_LDB
#undef PG8_MMA
#undef PG8_WAIT_V
#undef PG8_WAIT_L
#undef PG8_BAR
#undef PG8_SCHED
}
}

constexpr int NWAVES = 8, NTHR = 512;
constexpr int M = 16384, D = 4096;
constexpr int EVEN_IN = 12296, EVEN_N = 12288, EVEN_MIX = 3072, ODD_IN = 8192;
constexpr float LN_EPS = 1e-5f;
constexpr float DN_ALPHA = 1.6817928305074290861f;
constexpr float SB_EXIT = 104.0f;

constexpr size_t MiB = 1u << 20;
constexpr size_t WS_CTL = 0, CTL_ZERO_BYTES = 1 * MiB;
constexpr size_t WS_MOD = 1 * MiB;
constexpr size_t WS_WG = 2 * MiB;
constexpr size_t WS_GATES = 3 * MiB;
constexpr size_t WS_WINTER = 4 * MiB;
constexpr size_t WS_EMT = 5 * MiB;
constexpr size_t WS_CDEC = 6 * MiB;
constexpr size_t WS_DENR = 7 * MiB;
constexpr size_t WS_S = 8 * MiB;
constexpr size_t WS_QC = 16 * MiB;
constexpr size_t WS_KC = 48 * MiB;
constexpr size_t WS_U = 80 * MiB;
constexpr size_t WS_T = 208 * MiB;
constexpr size_t WS_P = 464 * MiB;
constexpr size_t WS_MIX = 848 * MiB;
constexpr size_t WS_NUM = 976 * MiB;
constexpr size_t WS_W = 1104 * MiB;
constexpr size_t W_IN_E = 96 * MiB, W_OUT_E = 24 * MiB, W_IN_O = 64 * MiB, W_POOL = 8 * MiB, W_OUT_O = 32 * MiB, W_PAIR = W_IN_E + W_OUT_E + W_IN_O + W_POOL + W_OUT_O;
constexpr size_t WS_VT = WS_W + 2 * W_PAIR;
constexpr size_t WS_VBT = WS_VT + 64 * MiB;
constexpr size_t WS_NUM2 = WS_VBT + 32 * MiB;
constexpr size_t WS_END = WS_NUM2 + 256 * MiB;
constexpr int CW_BAR = 4096;
constexpr size_t WS_BIAS = WS_CTL + 65536;

constexpr int RING_BYTES = 149504, LDSCTL_OFF = RING_BYTES, MISC_OFF = LDSCTL_OFF + 320, LDS_BYTES = 155648;

#define LAS __attribute__((address_space(3)))
typedef unsigned short bf16;
typedef float f32x4 __attribute__((ext_vector_type(4)));
typedef float f32x2 __attribute__((ext_vector_type(2)));
typedef unsigned u32x4 __attribute__((ext_vector_type(4)));
typedef unsigned u32x2 __attribute__((ext_vector_type(2)));
typedef short bf16x8 __attribute__((ext_vector_type(8)));
typedef __bf16 bf16x2n __attribute__((ext_vector_type(2)));

__device__ __forceinline__ unsigned f2bf(float f) { unsigned u = __builtin_bit_cast(unsigned, f); return (u + 0x7fffu + ((u >> 16) & 1u)) >> 16; }
__device__ __forceinline__ unsigned pk2(float lo, float hi) { return pg8::cvt_pk_bf16(lo, hi); }
__device__ __forceinline__ unsigned pk2n(float lo, float hi) { return __builtin_bit_cast(unsigned, __builtin_convertvector((f32x2){lo, hi}, bf16x2n)); }
__device__ __forceinline__ unsigned pkh(float lo, float hi) { return (unsigned)__builtin_bit_cast(unsigned short, (_Float16)lo) | ((unsigned)__builtin_bit_cast(unsigned short, (_Float16)hi) << 16); }
__device__ __forceinline__ float hlo(unsigned w) { return (float)__builtin_bit_cast(_Float16, (unsigned short)(w & 0xffffu)); }
__device__ __forceinline__ float hhi(unsigned w) { return (float)__builtin_bit_cast(_Float16, (unsigned short)(w >> 16)); }
__device__ __forceinline__ float bflo(unsigned w) { return __uint_as_float(w << 16); }
__device__ __forceinline__ float bfhi(unsigned w) { return __uint_as_float(w & 0xffff0000u); }
__device__ __forceinline__ float wave_sum(float v) {
#pragma unroll
    for (int o = 1; o < 64; o <<= 1) v += __shfl_xor(v, o);
    return v;
}
__device__ __forceinline__ float wave_max(float v) {
#pragma unroll
    for (int o = 1; o < 64; o <<= 1) v = fmaxf(v, __shfl_xor(v, o));
    return v;
}
__device__ __forceinline__ float wave_min(float v) {
#pragma unroll
    for (int o = 1; o < 64; o <<= 1) v = fminf(v, __shfl_xor(v, o));
    return v;
}
__device__ __forceinline__ float wave_incl_sum(float v, int lane) {
#pragma unroll
    for (int o = 1; o < 64; o <<= 1) { const float t = __shfl_up(v, o); if (lane >= o) v += t; }
    return v;
}
__device__ __forceinline__ float wave_incl_max(float v, int lane) {
#pragma unroll
    for (int o = 1; o < 64; o <<= 1) { const float t = __shfl_up(v, o); if (lane >= o) v = fmaxf(v, t); }
    return v;
}
__device__ __forceinline__ float logsigmoidf_acc(float x) { return x >= 0.f ? -log1pf(expf(-x)) : x - log1pf(expf(x)); }
__device__ __forceinline__ float softplusf_acc(float z) { return fmaxf(z, 0.f) + log1pf(expf(-fabsf(z))); }
__device__ __forceinline__ float softplusf_fast(float z) { return fmaxf(z, 0.f) + __logf(1.0f + __expf(-fabsf(z))); }
__device__ __forceinline__ void unpack8(const u32x4 w, float (&f)[8]) { f[0] = bflo(w.x); f[1] = bfhi(w.x); f[2] = bflo(w.y); f[3] = bfhi(w.y); f[4] = bflo(w.z); f[5] = bfhi(w.z); f[6] = bflo(w.w); f[7] = bfhi(w.w); }

#define XB_TMO      128
#define XB_XCNT(j)  (256  + 64 * (j))
#define XB_XSUB(j)  (1280 + 64 * (j))
#define XB_XGEN(j)  (2304 + 64 * (j))
#define XB_TOP      3328
#define XB_TOPGEN   3392
#define XCD_BAR_WORDS 3456
#define XB_SPIN_CAP (1u << 18)
__device__ __forceinline__ unsigned xb_ld(unsigned* p)              { return __hip_atomic_load(p, __ATOMIC_RELAXED, __HIP_MEMORY_SCOPE_AGENT); }
__device__ __forceinline__ unsigned xb_add(unsigned* p, unsigned v) { return __hip_atomic_fetch_add(p, v, __ATOMIC_RELAXED, __HIP_MEMORY_SCOPE_AGENT); }
__device__ __forceinline__ unsigned xb_xcc_id() { return (unsigned)__builtin_amdgcn_s_getreg((3 << 11) | 20) & 0xFu; }
#define XB_SPIN(cond, bar) do { unsigned _sp = 0; while (cond) { __builtin_amdgcn_s_sleep(1); \
    if ((++_sp & 255u) == 0u) { if (xb_ld(&(bar)[XB_TMO])) break; if (_sp > XB_SPIN_CAP) { atomicAdd(&(bar)[XB_TMO], 1u); break; } } } } while (0)
struct XcdBarrier { unsigned* bar; unsigned x; volatile LAS unsigned* st; };
__device__ __forceinline__ XcdBarrier xcd_barrier_post(unsigned* bar, volatile LAS unsigned* st) {
    XcdBarrier b; b.bar = bar; b.x = xb_xcc_id(); b.st = st;
    if (threadIdx.x == 0) (void)xb_add(&bar[XB_XCNT(b.x)], 1u);
    return b;
}
__device__ __forceinline__ void xcd_barrier_complete(unsigned* bar, unsigned x, unsigned& nloc, unsigned& nx) {
    const unsigned G = gridDim.x * gridDim.y * gridDim.z;
    unsigned sum, cnt, mine, sp = 0u;
    for (;;) {
        sum = 0u; cnt = 0u; mine = 0u;
#pragma unroll
        for (unsigned j = 0; j < 16; ++j) { const unsigned c = xb_ld(&bar[XB_XCNT(j)]); sum += c; cnt += (c > 0u) ? 1u : 0u; mine = (j == x) ? c : mine; }
        if (sum == G) break;
        __builtin_amdgcn_s_sleep(1);
        if ((++sp & 255u) == 0u) { if (xb_ld(&bar[XB_TMO])) break; if (sp > XB_SPIN_CAP) { atomicAdd(&bar[XB_TMO], 1u); break; } }
    }
    nloc = mine > 0u ? mine : 1u; nx = cnt > 0u ? cnt : 1u;
}
__device__ __forceinline__ void xcd_barrier(const XcdBarrier& b) {
    asm volatile("s_waitcnt vmcnt(0)" ::: "memory");
    __syncthreads();
    if (threadIdx.x == 0) {
        unsigned* bar = b.bar;
        __builtin_amdgcn_s_waitcnt(0);
        unsigned nloc = b.st[0], nx = b.st[1];
        if (nloc == 0u) { xcd_barrier_complete(bar, b.x, nloc, nx); b.st[0] = nloc; b.st[1] = nx; }
        const unsigned old = xb_add(&bar[XB_XSUB(b.x)], 1u);
        const unsigned gen = old / nloc;
        if (old + 1u == (gen + 1u) * nloc) {
            __builtin_amdgcn_fence(__ATOMIC_RELEASE, "agent");
            asm volatile("s_waitcnt vmcnt(0)" ::: "memory");
            const unsigned og = xb_add(&bar[XB_TOP], 1u);
            const unsigned tg = og / nx;
            if (og + 1u == (tg + 1u) * nx) xb_add(&bar[XB_TOPGEN], 1u);
            else XB_SPIN(xb_ld(&bar[XB_TOPGEN]) == tg, bar);
            __builtin_amdgcn_fence(__ATOMIC_ACQUIRE, "agent");
            xb_add(&bar[XB_XGEN(b.x)], 1u);
            asm volatile("s_waitcnt vmcnt(0)" ::: "memory");
        } else {
            XB_SPIN(xb_ld(&bar[XB_XGEN(b.x)]) == gen, bar);
            __builtin_amdgcn_fence(__ATOMIC_ACQUIRE, "agent");
            asm volatile("s_waitcnt vmcnt(0)" ::: "memory");
        }
    }
    __syncthreads();
}

__device__ __forceinline__ void xcd_barrier_next(const XcdBarrier& b) {
    asm volatile("s_waitcnt vmcnt(0)" ::: "memory");
    __syncthreads();
    if (threadIdx.x == 0) {
        unsigned* bar = b.bar;
        __builtin_amdgcn_s_waitcnt(0);
        const unsigned nloc = b.st[0], nx = b.st[1];
        const unsigned old = xb_add(&bar[XB_XSUB(b.x)], 1u);
        const unsigned gen = old / nloc;
        if (old + 1u == (gen + 1u) * nloc) {
            __builtin_amdgcn_fence(__ATOMIC_RELEASE, "agent");
            asm volatile("s_waitcnt vmcnt(0)" ::: "memory");
            const unsigned og = xb_add(&bar[XB_TOP], 1u);
            const unsigned tg = og / nx;
            if (og + 1u == (tg + 1u) * nx) xb_add(&bar[XB_TOPGEN], 1u);
            else XB_SPIN(xb_ld(&bar[XB_TOPGEN]) == tg, bar);
            __builtin_amdgcn_fence(__ATOMIC_ACQUIRE, "agent");
            xb_add(&bar[XB_XGEN(b.x)], 1u);
            asm volatile("s_waitcnt vmcnt(0)" ::: "memory");
        } else {
            XB_SPIN(xb_ld(&bar[XB_XGEN(b.x)]) == gen, bar);
            __builtin_amdgcn_fence(__ATOMIC_ACQUIRE, "agent");
            asm volatile("s_waitcnt vmcnt(0)" ::: "memory");
        }
    }
    __syncthreads();
}

struct Args { const float* in[40]; float* out; unsigned char* ws; int ph_lo, ph_hi; };
constexpr int I_X = 0, I_C = 1;

__device__ __forceinline__ void p0_transpose_item(const float* W, int ldw, int src_col0, bf16* WT, int ldt, int dst_row0, int nblk, LAS float* scr, int item, int lane,
                                                  const float* scl, const float* shf, float* bias) {
    const int kb = item / nblk, nb = item % nblk, k0 = 64 * kb, n0 = 32 * nb;
    float bacc = 0.f;
    LAS float* sms = scr + 64 * 33;
    if (scl) { sms[lane] = 1.0f + scl[k0 + lane]; sms[64 + lane] = shf[k0 + lane]; asm volatile("s_waitcnt lgkmcnt(0)" ::: "memory"); }
#pragma unroll 8
    for (int i = 0; i < 32; ++i) { const int kk = 2 * i + (lane >> 5); const float wv = __builtin_nontemporal_load(W + (size_t)(k0 + kk) * ldw + src_col0 + n0 + (lane & 31));
        if (scl) { scr[kk * 33 + (lane & 31)] = wv * sms[kk]; bacc += sms[64 + kk] * wv; } else scr[kk * 33 + (lane & 31)] = wv; }
    if (scl) { bacc += __shfl_xor(bacc, 32); if (lane < 32) atomicAdd(bias + dst_row0 + n0 + lane, bacc); }
    asm volatile("s_waitcnt lgkmcnt(0)" ::: "memory");
    const int c = lane & 7;
#pragma unroll
    for (int j = 0; j < 4; ++j) { const int n = (lane >> 3) + 8 * j; const LAS float* s = scr + (8 * c) * 33 + n;
        u32x4 o; o.x = pk2(s[0 * 33], s[1 * 33]); o.y = pk2(s[2 * 33], s[3 * 33]); o.z = pk2(s[4 * 33], s[5 * 33]); o.w = pk2(s[6 * 33], s[7 * 33]);
        __builtin_nontemporal_store(o, (u32x4*)(WT + (size_t)(dst_row0 + n0 + n) * ldt + k0 + 8 * c)); }
    asm volatile("s_waitcnt lgkmcnt(0)" ::: "memory");
}
__device__ __forceinline__ void p0_convert(const float* W, int K, int ldw, int src_col0, int ncols, bf16* WT, int dst_row0, LAS float* scr, int gw, int NGW, int lane,
                                           const float* scl, const float* shf, float* bias) {
    const int nblk = ncols / 32, nitems = (K / 64) * nblk;
    for (int it = gw; it < nitems; it += NGW) p0_transpose_item(W, ldw, src_col0, WT, K, dst_row0, nblk, scr, it, lane, scl, shf, bias);
}
__device__ __forceinline__ void phase_mods(const Args& a, LAS unsigned char* lds, int G) {
    __syncthreads();
    int tid = threadIdx.x; asm volatile("" : "+v"(tid));
    const int lane = tid & 63, wave = tid >> 6;
    LAS float* cact = (LAS float*)lds; LAS float* red = (LAS float*)(lds + 16384);
    for (int i = tid; i < D; i += NTHR) { const float c = a.in[I_C][i]; cact[i] = c / (1.0f + expf(-c)); }
    __syncthreads();
    float* MOD = (float*)(a.ws + WS_MOD);
    if (blockIdx.x == 0) ((u32x4*)(a.ws + WS_CDEC + 131072))[tid] = (u32x4){0x3F803F80u, 0x3F803F80u, 0x3F803F80u, 0x3F803F80u};
    for (int item = blockIdx.x; item < 4 * 192; item += G) {
        const int l = item / 192, col = (item % 192) * 64 + lane;
        const float* Wl = l == 0 ? a.in[2] : l == 1 ? a.in[12] : l == 2 ? a.in[21] : a.in[31];
        const float* bl = l == 0 ? a.in[3] : l == 1 ? a.in[13] : l == 2 ? a.in[22] : a.in[32];
        const float* Wp = Wl + (size_t)(wave * 512) * 12288 + col; const LAS float* cp = cact + wave * 512;
        float acc = 0.f;
#pragma unroll 16
        for (int k = 0; k < 512; ++k) acc += cp[k] * __builtin_nontemporal_load(Wp + (size_t)k * 12288);
        red[wave * 64 + lane] = acc;
        __syncthreads();
        if (wave == 0) { float s = 0.f;
#pragma unroll
            for (int w = 0; w < 8; ++w) s += red[w * 64 + lane];
            MOD[l * 12288 + col] = s + bl[col]; }
        __syncthreads();
    }
}
__device__ __forceinline__ void phase_weights(const Args& a, LAS unsigned char* lds, int G) {
    __syncthreads();
    int tid = threadIdx.x; asm volatile("" : "+v"(tid));
    const int lane = tid & 63, wave = tid >> 6;
    unsigned char* ws = a.ws;
    const float* MOD = (const float*)(ws + WS_MOD); float* BIAS = (float*)(ws + WS_BIAS);
    LAS float* scr = (LAS float*)(lds + wave * 16384);
    const int gw = blockIdx.x * NWAVES + wave, NGW = G * NWAVES;
#pragma unroll 1
    for (int lp = 0; lp < 2; ++lp) {
        bf16* wb = (bf16*)(ws + WS_W + (size_t)lp * W_PAIR);
        const float* w_in_e = lp ? a.in[23] : a.in[4]; const float* w_out_e = lp ? a.in[28] : a.in[9];
        const float* w_in_o = lp ? a.in[33] : a.in[14]; const float* pool_w = lp ? a.in[34] : a.in[15]; const float* w_out_o = lp ? a.in[37] : a.in[18];
        bf16* Wt_in_e = wb; bf16* Wt_out_e = (bf16*)((unsigned char*)wb + W_IN_E); bf16* Wt_in_o = (bf16*)((unsigned char*)wb + W_IN_E + W_OUT_E);
        bf16* Wt_pool = (bf16*)((unsigned char*)wb + W_IN_E + W_OUT_E + W_IN_O); bf16* Wt_out_o = (bf16*)((unsigned char*)wb + W_IN_E + W_OUT_E + W_IN_O + W_POOL);
        const float* mod_e = MOD + (2 * lp) * 12288; const float* mod_o = MOD + (2 * lp + 1) * 12288;
        p0_convert(w_in_e, D, EVEN_IN, 0, 8192, Wt_in_e, 0, scr, gw, NGW, lane, mod_e + D, mod_e, BIAS + (2 * lp) * 12288);
        p0_convert(w_in_e, D, EVEN_IN, 8200, 4096, Wt_in_e, 8192, scr, gw, NGW, lane, mod_e + D, mod_e, BIAS + (2 * lp) * 12288);
        p0_convert(w_out_e, EVEN_MIX, D, 0, D, Wt_out_e, 0, scr, gw, NGW, lane, nullptr, nullptr, nullptr);
        p0_convert(w_in_o, D, ODD_IN, 4096, 4096, Wt_in_o, 4096, scr, gw, NGW, lane, mod_o + D, mod_o, BIAS + (2 * lp + 1) * 12288);
        {
            bf16* WV = (bf16*)(ws + WS_P) + (size_t)lp * D * D;
            for (size_t i = (size_t)blockIdx.x * NTHR + tid; i < (size_t)D * D / 8; i += (size_t)G * NTHR) { const size_t k = i / 512, c8 = i % 512;
                const f32x4 a0 = __builtin_nontemporal_load((const f32x4*)(w_in_o + k * ODD_IN + c8 * 8)), a1 = __builtin_nontemporal_load((const f32x4*)(w_in_o + k * ODD_IN + c8 * 8 + 4));
                *(u32x4*)(WV + k * D + c8 * 8) = (u32x4){pk2(a0.x, a0.y), pk2(a0.z, a0.w), pk2(a1.x, a1.y), pk2(a1.z, a1.w)}; }
        }
#pragma unroll 1
        for (int g = 0; g < 4; ++g) p0_convert(pool_w + (size_t)g * 1024 * 1024, 1024, 1024, 0, 1024, Wt_pool, g * 1024, scr, gw, NGW, lane, nullptr, nullptr, nullptr);
        p0_convert(w_out_o, D, D, 0, D, Wt_out_o, 0, scr, gw, NGW, lane, nullptr, nullptr, nullptr);
        bf16* WGB = (bf16*)(ws + WS_WG) + lp * 8 * D; float* GB = (float*)(ws + WS_WG + 262144) + lp * 8;
        for (int i = blockIdx.x * NTHR + tid; i < 8 * D; i += G * NTHR) { const int j = i / D, k = i % D; WGB[i] = (bf16)f2bf(w_in_e[(size_t)k * EVEN_IN + 8192 + j] * (1.0f + mod_e[D + k])); }
        if (gw < 8) { float acc = 0.f; for (int k = lane; k < D; k += 64) acc += mod_e[k] * w_in_e[(size_t)k * EVEN_IN + 8192 + gw]; acc = wave_sum(acc); if (lane == 0) GB[gw] = acc; }
    }
}

constexpr int RW_G1 = 0, RW_LG = 16384, RW_LB = 32768, RW_WG = 49152;
template <bool FIRST, bool SRCB, bool DSTF, bool SRCBF = false>
__device__ __forceinline__ void phase_rows(const void* src, const bf16* Y, const float* gate, const float* lng, const float* lnb, void* xout, bf16* xh, const bf16* wgb, const float* gb, float* GATES,
                                           LAS unsigned char* lds, int G) {
    int tid = threadIdx.x; asm volatile("" : "+v"(tid));
    const int lane = tid & 63, wave = tid >> 6;
    __syncthreads();
    if (!FIRST) { for (int i = tid; i < 1024; i += NTHR) { ((LAS f32x4*)(lds + RW_G1))[i] = ((const f32x4*)gate)[i] + 1.0f; ((LAS f32x4*)(lds + RW_LG))[i] = ((const f32x4*)lng)[i]; ((LAS f32x4*)(lds + RW_LB))[i] = ((const f32x4*)lnb)[i]; } }
    if (wgb) { for (int i = tid; i < 4096; i += NTHR) ((LAS u32x4*)(lds + RW_WG))[i] = ((const u32x4*)wgb)[i]; }
    __syncthreads();
    const int gw = blockIdx.x * NWAVES + wave, NGW = G * NWAVES;
#pragma unroll 1
    for (int m = gw; m < M; m += NGW) {
        int ln = lane; asm volatile("" : "+v"(ln));
        f32x4 v[16]; u32x2 yy[16];
        if (SRCB) { const u32x2* xr = (const u32x2*)((const bf16*)src + (size_t)m * D) + ln; u32x2 xx[16];
#pragma unroll
            for (int j = 0; j < 16; ++j) xx[j] = __builtin_nontemporal_load(xr + 64 * j);
            if (!FIRST) { const u32x2* yr = (const u32x2*)(Y + (size_t)m * D) + ln;
#pragma unroll
                for (int j = 0; j < 16; ++j) yy[j] = __builtin_nontemporal_load(yr + 64 * j); }
#pragma unroll
            for (int j = 0; j < 16; ++j) v[j] = SRCBF ? (f32x4){bflo(xx[j].x), bfhi(xx[j].x), bflo(xx[j].y), bfhi(xx[j].y)} : (f32x4){hlo(xx[j].x), hhi(xx[j].x), hlo(xx[j].y), hhi(xx[j].y)}; }
        else { const f32x4* xr = (const f32x4*)((const float*)src + (size_t)m * D) + ln;
#pragma unroll
            for (int j = 0; j < 16; ++j) v[j] = __builtin_nontemporal_load(xr + 64 * j);
            if (!FIRST) { const u32x2* yr = (const u32x2*)(Y + (size_t)m * D) + ln;
#pragma unroll
                for (int j = 0; j < 16; ++j) yy[j] = __builtin_nontemporal_load(yr + 64 * j); } }
        if (!FIRST) {
            const LAS f32x4* g1 = (const LAS f32x4*)(lds + RW_G1) + ln; const LAS f32x4* lg = (const LAS f32x4*)(lds + RW_LG) + ln; const LAS f32x4* lb = (const LAS f32x4*)(lds + RW_LB) + ln;
            float s = 0.f;
#pragma unroll
            for (int j = 0; j < 16; ++j) { const f32x4 yv = (f32x4){bflo(yy[j].x), bfhi(yy[j].x), bflo(yy[j].y), bfhi(yy[j].y)}; v[j] = v[j] * DN_ALPHA + g1[64 * j] * yv; s += (v[j].x + v[j].y) + (v[j].z + v[j].w); }
            const float mean = wave_sum(s) * (1.f / D); float s2 = 0.f;
#pragma unroll
            for (int j = 0; j < 16; ++j) { v[j] = v[j] - mean; s2 += (v[j].x * v[j].x + v[j].y * v[j].y) + (v[j].z * v[j].z + v[j].w * v[j].w); }
            const float rstd = 1.f / sqrtf(wave_sum(s2) * (1.f / D) + LN_EPS);
#pragma unroll
            for (int j = 0; j < 16; ++j) { v[j] = v[j] * rstd * lg[64 * j] + lb[64 * j];
                if (DSTF) __builtin_nontemporal_store(v[j], (f32x4*)((float*)xout + (size_t)m * D) + ln + 64 * j); }
        }
        if (!DSTF) { u32x2* xo = (u32x2*)((bf16*)xout + (size_t)m * D) + ln;
#pragma unroll
            for (int j = 0; j < 16; ++j) { u32x2 o; o.x = pk2(v[j].x, v[j].y); o.y = pk2(v[j].z, v[j].w); xo[64 * j] = o; }
            if (xh) { u32x2* ho = (u32x2*)(xh + (size_t)m * D) + ln;
#pragma unroll
                for (int j = 0; j < 16; ++j) { u32x2 o; o.x = pkh(v[j].x, v[j].y); o.y = pkh(v[j].z, v[j].w); __builtin_nontemporal_store(o, ho + 64 * j); } } }
        if (wgb) {
            float keep = 0.f;
#pragma unroll 1
            for (int jg = 0; jg < 8; ++jg) { float p = 0.f; const LAS u32x2* wr = (const LAS u32x2*)(lds + RW_WG) + jg * 1024 + ln;
#pragma unroll
                for (int j = 0; j < 16; ++j) { const u32x2 w = wr[64 * j]; p += (v[j].x * bflo(w.x) + v[j].y * bfhi(w.x)) + (v[j].z * bflo(w.y) + v[j].w * bfhi(w.y)); }
                p = wave_sum(p); if (lane == jg) keep = p + gb[jg]; }
            if (lane < 8) GATES[(size_t)m * 8 + lane] = keep;
        }
    }
}

constexpr int E2_BL = 0, E2_WM = 4096, E2_MP = 8192;
constexpr int E2_SQ = 16384, E2_SK = E2_SQ + 64 * 528;
constexpr int E2_VC = 16384, E2_VC_PITCH = 1544;
constexpr int E2_SS = 115712, E2_SC = 123904;
static_assert(E2_SK + 64 * 528 <= E2_SS && E2_VC + 64 * E2_VC_PITCH <= E2_SS && E2_SC + 1280 <= RING_BYTES, "E2 LDS map");

__device__ __forceinline__ void chunk_gate_sums(const float* GATES, const float* igb, const float* fgb, float* BLWM, int G) {
    int tid = threadIdx.x; asm volatile("" : "+v"(tid));
    const int lane = tid & 63, wave = tid >> 6;
    for (int pair = blockIdx.x * NWAVES + wave; pair < 1024; pair += G * NWAVES) {
        const int c = pair >> 2, h = pair & 3, m = 64 * c + lane;
        const float lf = logsigmoidf_acc(GATES[(size_t)m * 8 + 4 + h] + fgb[h]), li = GATES[(size_t)m * 8 + h] + igb[h];
        const float b = wave_incl_sum(lf, lane), gmax = wave_max(li - b), blast = __shfl(b, 63);
        if (lane == 0) { BLWM[(h * 256 + c) * 2] = blast; BLWM[(h * 256 + c) * 2 + 1] = blast + gmax; }
    }
}
__device__ __forceinline__ void e2_preamble(const float* BLWM, LAS unsigned char* lds) {
    int tid = threadIdx.x; asm volatile("" : "+v"(tid));
    LAS float* sBL = (LAS float*)(lds + E2_BL); LAS float* sWM = (LAS float*)(lds + E2_WM); LAS float* sMP = (LAS float*)(lds + E2_MP);
    __syncthreads();
    for (int i = tid; i < 1024; i += NTHR) { const f32x2 v = *(const f32x2*)(BLWM + 2 * i); sBL[i] = v.x; sWM[i] = v.y; }
    __syncthreads();
    if (tid < 256) { const int hh = tid >> 6, ln = tid & 63;
        float av[4], bv[4];
#pragma unroll
        for (int i = 0; i < 4; ++i) { av[i] = sBL[hh * 256 + 4 * ln + i]; bv[i] = sWM[hh * 256 + 4 * ln + i]; }
        float A = av[0], B = bv[0];
#pragma unroll
        for (int i = 1; i < 4; ++i) { B = fmaxf(B + av[i], bv[i]); A += av[i]; }
#pragma unroll
        for (int o = 1; o < 64; o <<= 1) { const float Ap = __shfl_up(A, o), Bp = __shfl_up(B, o); if (ln >= o) { B = fmaxf(Bp + A, B); A = Ap + A; } }
        const float Ae = __shfl_up(A, 1), Be = __shfl_up(B, 1);
        float mm = ln ? fmaxf(0.f + Ae, Be) : 0.f;
#pragma unroll
        for (int i = 0; i < 4; ++i) { sMP[hh * 256 + 4 * ln + i] = mm; mm = fmaxf(av[i] + mm, bv[i]); } }
    __syncthreads();
}
__device__ __forceinline__ void e2_prep_item(int c, int h, const bf16* P, const float* conv_w, const float* GATES, const float* igb, const float* fgb,
                                             bf16* QC, bf16* KCT, bf16* SB, bf16* VT, bf16* VBT, bf16* QB2, bf16* KB2, float* WINTER, float* EMT, float* CDEC, LAS unsigned char* lds) {
    int tid = threadIdx.x; asm volatile("" : "+v"(tid));
    const int lane = tid & 63, wave = tid >> 6;
    LAS float* sMP = (LAS float*)(lds + E2_MP);
    LAS float* sb = (LAS float*)(lds + E2_SC); LAS float* sli = sb + 64; LAS float* smt = sb + 128; LAS float* sws = sb + 192;
    LAS unsigned char* sq = lds + E2_SQ; LAS unsigned char* sk = lds + E2_SK; LAS unsigned char* sS = lds + E2_SS; LAS unsigned char* sVc = lds + E2_VC;
    const int item = c * 4 + h;
    u32x4 vreg[12];
#pragma unroll
    for (int i = 0; i < 12; ++i) { const int idx = tid + NTHR * i, s = idx / 96, p = idx % 96;
        vreg[i] = __builtin_nontemporal_load((const u32x4*)(P + (size_t)(64 * c + s) * EVEN_N + (p < 64 ? 2048 + h * 512 + p * 8 : 10240 + h * 256 + (p - 64) * 8))); }
    __syncthreads();
    if (wave == 0) {
        const int m = 64 * c + lane;
        const float lf = logsigmoidf_acc(GATES[(size_t)m * 8 + 4 + h] + fgb[h]), li = GATES[(size_t)m * 8 + h] + igb[h];
        const float b = wave_incl_sum(lf, lane), g = li - b, pm = wave_incl_max(g, lane), gmax = __shfl(pm, 63), blast = __shfl(b, 63);
        const float mprev = sMP[h * 256 + c];
        const float mt = fmaxf(b + mprev, b + pm);
        const float mnew = fmaxf(blast + mprev, blast + gmax);
        sb[lane] = b; sli[lane] = li; smt[lane] = mt; sws[lane] = expf(blast + g - mnew);
        sb[256 + lane] = expf(b + mprev - mt);
        EMT[(size_t)m * 4 + h] = expf(-mt);
        if (lane == 0) CDEC[c * 4 + h] = expf(blast + mprev - mnew);
    }
    __syncthreads();
    {
        const int d2 = tid & 127, tq = tid >> 7;
        const int dk = 2 * d2, r5 = dk & 31, pos = (dk & ~31) + 8 * ((r5 >> 2) & 3) + 4 * (r5 >> 4) + (r5 & 3);
        unsigned xw[2][19]; float cw0[2][4], cw1[2][4];
#pragma unroll
        for (int part = 0; part < 2; ++part) { const int col = part * 1024 + h * 256 + 2 * d2;
#pragma unroll
            for (int j = 0; j < 19; ++j) { const int mr = 64 * c + 16 * tq - 3 + j; xw[part][j] = (mr >= 0) ? *(const unsigned*)(P + (size_t)(mr >= 0 ? mr : 0) * EVEN_N + col) : 0u; }
#pragma unroll
            for (int j = 0; j < 4; ++j) { cw0[part][j] = conv_w[j * 2048 + col]; cw1[part][j] = conv_w[j * 2048 + col + 1]; } }
#pragma unroll
        for (int part = 0; part < 2; ++part) {
            unsigned kw0[8], kw1[8]; float p0 = 0.f, p1 = 0.f;
#pragma unroll
            for (int tt = 0; tt < 16; ++tt) {
                const int t = 16 * tq + tt, mr = 64 * c + t;
                float y0 = 0.f, y1 = 0.f;
#pragma unroll
                for (int j = 0; j < 4; ++j) { const unsigned w = xw[part][tt + j]; y0 += cw0[part][j] * bflo(w); y1 += cw1[part][j] * bfhi(w); }
                y0 = y0 * pg8::sigmoidf_fast(y0); y1 = y1 * pg8::sigmoidf_fast(y1);
                if (part == 0) { const float wq = sb[256 + t] * 0.0625f; *(LAS unsigned*)(sq + t * 528 + d2 * 4) = pk2(y0 * 0.0625f, y1 * 0.0625f); *(unsigned*)(QC + (size_t)mr * 1024 + h * 256 + pos) = pk2(y0 * wq, y1 * wq); }
                else { const float wsv = sws[t]; *(LAS unsigned*)(sk + t * 528 + d2 * 4) = pk2(y0, y1);
                    const float s0 = y0 * wsv, s1 = y1 * wsv;
                    if (tt & 1) { kw0[tt >> 1] = pk2(p0, s0); kw1[tt >> 1] = pk2(p1, s1); } else { p0 = s0; p1 = s1; } }
            }
            if (part == 1) { bf16* kr = KCT + (size_t)item * 16384 + (size_t)dk * 64 + 16 * tq;
                *(u32x4*)(kr) = (u32x4){kw0[0], kw0[1], kw0[2], kw0[3]}; *(u32x4*)(kr + 8) = (u32x4){kw0[4], kw0[5], kw0[6], kw0[7]};
                *(u32x4*)(kr + 64) = (u32x4){kw1[0], kw1[1], kw1[2], kw1[3]}; *(u32x4*)(kr + 72) = (u32x4){kw1[4], kw1[5], kw1[6], kw1[7]}; }
        }
    }
    __syncthreads();
    {
        const int wv = __builtin_amdgcn_readfirstlane(tid >> 6), ta = wv & 3, wh = wv >> 2, fr = lane & 15, fq = lane >> 4;
        f32x4 z0 = (f32x4){0.f, 0.f, 0.f, 0.f}, z1 = z0;
#pragma unroll
        for (int kk = 0; kk < 8; ++kk) { const bf16x8 af = *(const LAS bf16x8*)(sq + (16 * ta + fr) * 528 + (32 * kk + 8 * fq) * 2);
            const bf16x8 b0 = *(const LAS bf16x8*)(sk + (32 * wh + fr) * 528 + (32 * kk + 8 * fq) * 2), b1 = *(const LAS bf16x8*)(sk + (32 * wh + 16 + fr) * 528 + (32 * kk + 8 * fq) * 2);
            z0 = __builtin_amdgcn_mfma_f32_16x16x32_bf16(af, b0, z0, 0, 0, 0); z1 = __builtin_amdgcn_mfma_f32_16x16x32_bf16(af, b1, z1, 0, 0, 0); }
        const int s0 = 32 * wh + fr, s1 = s0 + 16; const float e0 = sli[s0] - sb[s0], e1 = sli[s1] - sb[s1];
#pragma unroll
        for (int r = 0; r < 4; ++r) { const int t = 16 * ta + 4 * fq + r; const float bm = sb[t] - smt[t];
            const float w0 = (s0 <= t) ? expf(bm + e0) : 0.f, w1 = (s1 <= t) ? expf(bm + e1) : 0.f;
            *(LAS unsigned short*)(sS + (t * 64 + s0) * 2) = (unsigned short)f2bf(z0[r] * w0); *(LAS unsigned short*)(sS + (t * 64 + s1) * 2) = (unsigned short)f2bf(z1[r] * w1); }
    }
    __syncthreads();
    *(u32x4*)(SB + (size_t)item * 4096 + tid * 8) = *(const LAS u32x4*)(sS + tid * 16);
#pragma unroll
    for (int i = 0; i < 12; ++i) { const int idx = tid + NTHR * i, s = idx / 96, p = idx % 96; LAS unsigned char* d = sVc + s * E2_VC_PITCH + p * 16;
        *(LAS u32x2*)d = (u32x2){vreg[i].x, vreg[i].y}; *(LAS u32x2*)(d + 8) = (u32x2){vreg[i].z, vreg[i].w}; }
    __syncthreads();
    {
        const int cp = lane >> 3, pc = lane & 7;
#pragma unroll
        for (int rd = 0; rd < 6; ++rd) {
            const int R = wave * 6 + rd, v0 = 16 * R + 2 * cp;
            unsigned x[8];
#pragma unroll
            for (int j = 0; j < 8; ++j) x[j] = *(const LAS unsigned*)(sVc + (8 * pc + j) * E2_VC_PITCH + v0 * 2);
            const u32x4 lo = (u32x4){__builtin_amdgcn_perm(x[1], x[0], 0x05040100u), __builtin_amdgcn_perm(x[3], x[2], 0x05040100u), __builtin_amdgcn_perm(x[5], x[4], 0x05040100u), __builtin_amdgcn_perm(x[7], x[6], 0x05040100u)};
            const u32x4 hi = (u32x4){__builtin_amdgcn_perm(x[1], x[0], 0x07060302u), __builtin_amdgcn_perm(x[3], x[2], 0x07060302u), __builtin_amdgcn_perm(x[5], x[4], 0x07060302u), __builtin_amdgcn_perm(x[7], x[6], 0x07060302u)};
            bf16* dst;
            if (R < 32) dst = VT + (size_t)item * 32768 + (size_t)v0 * 64 + 8 * pc;
            else { const int vb = v0 - 512; dst = VBT + ((size_t)(c * 8 + 2 * h + (vb >> 7)) * 128 + (vb & 127)) * 64 + 8 * pc; }
            *(u32x4*)dst = lo; *(u32x4*)(dst + 64) = hi;
        }
    }
}

constexpr int AT_Q = 0, AT_K = AT_Q + 128 * 272, AT_VT = AT_K + 64 * 272, AT_Z = AT_VT + 128 * 144, AT_W = AT_Z + 128 * 272, AT_MIN = AT_W + 128 * 144, AT_O = 0;
static_assert(AT_MIN + 64 <= RING_BYTES && 128 * 528 <= AT_Z, "attention LDS map");
#define AT_BAR() do { asm volatile("s_waitcnt lgkmcnt(0)" ::: "memory"); __builtin_amdgcn_s_barrier(); asm volatile("" ::: "memory"); } while (0)
__device__ __forceinline__ void e3_attn_item(int hb, int qp, const bf16* P, const bf16* QB2, const bf16* KB2, const bf16* VBT, bf16* MIX, LAS unsigned char* lds) {
    int tid = threadIdx.x; asm volatile("" : "+v"(tid));
    const int lane = tid & 63, wave = __builtin_amdgcn_readfirstlane(tid >> 6), fr = lane & 15, fq = lane >> 4;
    LAS unsigned char* sQ = lds + AT_Q; LAS unsigned char* sK = lds + AT_K; LAS unsigned char* sVT = lds + AT_VT; LAS unsigned char* sW = lds + AT_W;
    LAS float* sZ = (LAS float*)(lds + AT_Z); LAS float* sMin = (LAS float*)(lds + AT_MIN); LAS float* sO = (LAS float*)(lds + AT_O);
    const int q0 = qp * 128, t = tid >> 3, sg = tid & 7, kb0 = 2 * qp + 1;
    const int ta = wave;
    u32x4 rk[2], rv[2];
#pragma unroll
    for (int i = 0; i < 2; ++i) { const int idx = tid + NTHR * i; rk[i] = *(const u32x4*)(P + (size_t)(64 * kb0 + (idx >> 4)) * EVEN_N + 9216 + hb * 128 + (idx & 15) * 8); rv[i] = *(const u32x4*)(VBT + (size_t)(kb0 * 8 + hb) * 8192 + idx * 8); }
    __syncthreads();
#pragma unroll
    for (int i = 0; i < 4; ++i) { const int idx = tid + NTHR * i, row = idx >> 4, p = idx & 15;
        *(LAS u32x4*)(sQ + row * 272 + p * 16) = __builtin_nontemporal_load((const u32x4*)(P + (size_t)(q0 + row) * EVEN_N + 8192 + hb * 128 + p * 8)); }
    float R[2] = {0.f, 0.f}; f32x4 acc[8];
#pragma unroll
    for (int e = 0; e < 8; ++e) acc[e] = (f32x4){0.f, 0.f, 0.f, 0.f};
    for (int kb = kb0; kb >= 0; --kb) {
        const int k0 = kb * 64;
        AT_BAR();
#pragma unroll
        for (int i = 0; i < 2; ++i) { const int idx = tid + NTHR * i;
            *(LAS u32x4*)(sK + (idx >> 4) * 272 + (idx & 15) * 16) = rk[i];
            *(LAS u32x4*)(sVT + (idx >> 3) * 144 + (idx & 7) * 16) = rv[i]; }
        { const int kn = kb > 0 ? kb - 1 : 0;
#pragma unroll
            for (int i = 0; i < 2; ++i) { const int idx = tid + NTHR * i; rk[i] = *(const u32x4*)(P + (size_t)(64 * kn + (idx >> 4)) * EVEN_N + 9216 + hb * 128 + (idx & 15) * 8); rv[i] = *(const u32x4*)(VBT + (size_t)(kn * 8 + hb) * 8192 + idx * 8); } }
        AT_BAR();
        {
            f32x4 z[4];
#pragma unroll
            for (int kt = 0; kt < 4; ++kt) z[kt] = (f32x4){0.f, 0.f, 0.f, 0.f};
#pragma unroll
            for (int kk = 0; kk < 4; ++kk) { const bf16x8 af = *(const LAS bf16x8*)(sQ + (16 * ta + fr) * 272 + (32 * kk + 8 * fq) * 2);
#pragma unroll
                for (int kt = 0; kt < 4; ++kt) { const bf16x8 bq = *(const LAS bf16x8*)(sK + (16 * kt + fr) * 272 + (32 * kk + 8 * fq) * 2);
                    z[kt] = __builtin_amdgcn_mfma_f32_16x16x32_bf16(af, bq, z[kt], 0, 0, 0); } }
#pragma unroll
            for (int kt = 0; kt < 4; ++kt)
#pragma unroll
                for (int r = 0; r < 4; ++r) sZ[(16 * ta + 4 * fq + r) * 68 + 16 * kt + fr] = z[kt][r];
        }
        AT_BAR();
        {
            float rmin = 3.0e38f;
#pragma unroll
            for (int hr = 0; hr < 2; ++hr) { const int row = t + 64 * hr;
                const f32x4 za = *(const LAS f32x4*)(sZ + row * 68 + 8 * sg), zb = *(const LAS f32x4*)(sZ + row * 68 + 8 * sg + 4);
                const float z[8] = {za.x, za.y, za.z, za.w, zb.x, zb.y, zb.z, zb.w};
                float sp[8], tot = 0.f;
#pragma unroll
                for (int i = 0; i < 8; ++i) { const bool ok = (k0 + 8 * sg + i) < (q0 + row); sp[i] = ok ? softplusf_fast(z[i]) : 0.f; tot += sp[i]; }
                float v = tot;
#pragma unroll
                for (int o = 1; o < 8; o <<= 1) { const float u = __shfl_down(v, o, 8); if (sg + o < 8) v += u; }
                const float rowtot = __shfl(v, 0, 8);
                float suf = R[hr] + (v - tot);
                float w[8];
#pragma unroll
                for (int i = 7; i >= 0; --i) { const bool ok = (k0 + 8 * sg + i) < (q0 + row); w[i] = ok ? __expf(z[i] - sp[i] - suf) : 0.f; suf += sp[i]; }
                *(LAS u32x4*)(sW + row * 144 + sg * 16) = (u32x4){pk2(w[0], w[1]), pk2(w[2], w[3]), pk2(w[4], w[5]), pk2(w[6], w[7])};
                R[hr] += rowtot; rmin = fminf(rmin, R[hr]); }
            const float mn = wave_min(rmin);
            if (lane == 0) sMin[wave] = mn;
        }
        AT_BAR();
        {
#pragma unroll
            for (int kk = 0; kk < 2; ++kk) { const bf16x8 af = *(const LAS bf16x8*)(sW + (16 * ta + fr) * 144 + (32 * kk + 8 * fq) * 2);
#pragma unroll
                for (int e = 0; e < 8; ++e) { const bf16x8 bfr = *(const LAS bf16x8*)(sVT + (16 * e + fr) * 144 + (32 * kk + 8 * fq) * 2);
                    acc[e] = __builtin_amdgcn_mfma_f32_16x16x32_bf16(af, bfr, acc[e], 0, 0, 0); } }
        }
        float mn = sMin[0];
#pragma unroll
        for (int w = 1; w < 8; ++w) mn = fminf(mn, sMin[w]);
        if (mn > SB_EXIT) break;
    }
    __syncthreads();
#pragma unroll
    for (int e = 0; e < 8; ++e)
#pragma unroll
        for (int r = 0; r < 4; ++r) sO[(16 * ta + 4 * fq + r) * 132 + 16 * e + fr] = acc[e][r];
    __syncthreads();
    {
#pragma unroll
        for (int hr = 0; hr < 2; ++hr) { const int row = t + 64 * hr; const size_t m = (size_t)(q0 + row);
#pragma unroll
            for (int half = 0; half < 2; ++half) { const int d0 = 64 * half + 8 * sg;
                const f32x4 oa = *(const LAS f32x4*)(sO + row * 132 + d0), ob = *(const LAS f32x4*)(sO + row * 132 + d0 + 4);
                float zf[8]; unpack8(__builtin_nontemporal_load((const u32x4*)(P + m * EVEN_N + 11264 + hb * 128 + d0)), zf);
                u32x4 o; o.x = pk2(oa.x * zf[0], oa.y * zf[1]); o.y = pk2(oa.z * zf[2], oa.w * zf[3]); o.z = pk2(ob.x * zf[4], ob.y * zf[5]); o.w = pk2(ob.z * zf[6], ob.w * zf[7]);
                *(u32x4*)(MIX + m * EVEN_MIX + 2048 + hb * 128 + d0) = o; } }
    }
}

#define SC_BAR() do { asm volatile("s_waitcnt lgkmcnt(0)" ::: "memory"); __builtin_amdgcn_s_barrier(); asm volatile("" ::: "memory"); } while (0)
constexpr int SC_SLICES = 8, SC_ITEMS = 4 * (SC_SLICES + 1) * 2;
constexpr int SC_SQ = 0, SC_SS = 16384, SC_SWI = 24576, SC_SVT = 25088, SC_SKT = 33280, SC_SET = 49664;
constexpr int SC_NSET = 3, SC_PUB = 32;
static_assert(SC_NSET * SC_SET <= RING_BYTES, "scan LDS map");
__device__ __forceinline__ void e3_scan_item(int h, int sl, int half, const bf16* QC, const bf16* KCT, const bf16* SB, const bf16* VT, const float* WINTER, const float* CDEC,
                                             float* NUM, float* DENR, const bf16* ONES, unsigned* prog, LAS unsigned char* lds) {
    int tid = threadIdx.x; asm volatile("" : "+v"(tid));
    const int lane = tid & 63, wave = __builtin_amdgcn_readfirstlane(tid >> 6), fr = lane & 15, fq = lane >> 4;
    const bool ones = (sl == SC_SLICES);
    __syncthreads();
    if (wave & 2) {
        const int wl = (wave & 1) | ((wave >> 2) << 1), rr = lane >> 2, q = (lane & 3) ^ ((rr & 8) ? 2 : 0);
        const unsigned offQ = (unsigned)(rr * 1024 + q * 8) * 2u, off64 = (unsigned)(rr * 64 + q * 8) * 2u;
        const char* gQ = (const char*)(QC + (size_t)(16 * wl) * 1024 + h * 256 + 128 * half) + offQ;
        const char* gK = (const char*)(KCT + (size_t)h * 16384 + (size_t)(128 * half + 32 * wl) * 64) + off64;
        const char* gS = (const char*)(SB + (size_t)h * 4096 + (size_t)(16 * (2 * half + (wl >> 1))) * 64) + off64 + (wl & 1) * 64;
        const int vrow = 32 * (wl >> 1) + 8 * (rr >> 2) + 4 * (wl & 1) + (rr & 3);
        const char* gV = (ones ? (const char*)ONES + (size_t)(16 * wl) * 128 + off64 : (const char*)(VT + (size_t)h * 32768 + (size_t)(64 * sl) * 64) + (size_t)vrow * 128 + (size_t)(q * 16));
        const float* gC = CDEC + h;
#define SC_DMA16(src, dstoff) __builtin_amdgcn_global_load_lds((const unsigned*)(src), (LAS unsigned*)(lds + (dstoff)), 16, 0, 0)
#define SC_DMA4(src, dstoff) __builtin_amdgcn_global_load_lds((const unsigned*)(src), (LAS unsigned*)(lds + (dstoff)), 4, 0, 0)
#define SC_DMA(cc, setoff) do { const int _c = (cc) < 255 ? (cc) : 255; const int _so = (setoff); \
            _Pragma("unroll") for (int kt = 0; kt < 4; ++kt) SC_DMA16(gQ + (size_t)_c * 131072 + kt * 64, _so + SC_SQ + (wl * 4 + kt) * 1024); \
            _Pragma("unroll") for (int j = 0; j < 4; ++j) SC_DMA16(gK + (size_t)_c * 131072 + (j >> 1) * 2048 + (j & 1) * 64, _so + SC_SKT + ((2 * wl + (j >> 1)) * 2 + (j & 1)) * 1024); \
            SC_DMA16(gS + (size_t)_c * 32768, _so + SC_SS + wl * 1024); \
            _Pragma("unroll") for (int k2 = 0; k2 < 2; ++k2) SC_DMA16(gV + (ones ? (size_t)0 : (size_t)_c * 262144) + k2 * 64, _so + SC_SVT + (wl * 2 + k2) * 1024); \
            SC_DMA4(gC + _c * 4, _so + SC_SWI + 256); } while (0)
        SC_DMA(0, 0); SC_DMA(1, SC_SET);
        asm volatile("s_waitcnt vmcnt(12)" ::: "memory");
        int so2 = 2 * SC_SET;
        for (int c = 0; c < 256; ++c) {
            SC_BAR();
            SC_DMA(c + 2, so2);
            asm volatile("s_waitcnt vmcnt(12)" ::: "memory");
            so2 = (so2 == 2 * SC_SET) ? 0 : so2 + SC_SET;
        }
        asm volatile("s_waitcnt vmcnt(0)" ::: "memory");
        SC_BAR();
#undef SC_DMA16
#undef SC_DMA4
#undef SC_DMA
    } else if (wave < 2) {
        f32x4 C[2][8];
#pragma unroll
        for (int u = 0; u < 2; ++u)
#pragma unroll
            for (int i = 0; i < 8; ++i) C[u][i] = (f32x4){0.f, 0.f, 0.f, 0.f};
        const int lo = fr * 64 + ((fq ^ ((fr >> 3) << 1)) * 16);
        int sco = 0;
        bf16* NUMh = (bf16*)NUM + (size_t)half * ((size_t)M * 2048); float* DENRh = DENR + (size_t)half * ((size_t)M * 4);
        __builtin_amdgcn_s_setprio(2);
        for (int c = 0; c < 256; ++c) {
            if (c > 0 && (c & (SC_PUB - 1)) == 0) asm volatile("s_waitcnt vmcnt(0)" ::: "memory");
            SC_BAR();
            const LAS unsigned char* sb_ = lds + sco; sco = (sco == 2 * SC_SET) ? 0 : sco + SC_SET;
            const LAS unsigned char* qbase = sb_ + SC_SQ + lo; const LAS unsigned char* sbase = sb_ + SC_SS + lo; const LAS unsigned char* kbase = sb_ + SC_SKT + lo;
            const LAS float* sWI = (const LAS float*)(sb_ + SC_SWI);
#define SC_LD4(F, base, s1) do { _Pragma("unroll") for (int _j = 0; _j < 4; ++_j) F[_j] = *(const LAS bf16x8*)((base) + _j * (s1)); } while (0)
#define SC_SB __builtin_amdgcn_sched_barrier(0)
#define SC_USE4(F) asm volatile("" :: "v"(F[0]), "v"(F[1]), "v"(F[2]), "v"(F[3]))
#define SC_CVT(dst, t) do { _Pragma("unroll") for (int _u = 0; _u < 2; ++_u) { \
                const u32x4 _w = (u32x4){pk2n(C[_u][t][0], C[_u][t][1]), pk2n(C[_u][t][2], C[_u][t][3]), pk2n(C[_u][(t) + 1][0], C[_u][(t) + 1][1]), pk2n(C[_u][(t) + 1][2], C[_u][(t) + 1][3])}; dst[_u] = __builtin_bit_cast(bf16x8, _w); } } while (0)
#define SC_INTER(cbv, F) do { _Pragma("unroll") for (int _u = 0; _u < 2; ++_u) _Pragma("unroll") for (int _a = 0; _a < 4; ++_a) o[_u][_a] = __builtin_amdgcn_mfma_f32_16x16x32_bf16(cbv[_u], F[_a], o[_u][_a], 0, 0, 0); } while (0)
#define SC_SCALE(t) do { _Pragma("unroll") for (int _u = 0; _u < 2; ++_u) { C[_u][t] = C[_u][t] * cdec; C[_u][(t) + 1] = C[_u][(t) + 1] * cdec; asm volatile("" : "+v"(C[_u][t]), "+v"(C[_u][(t) + 1])); } } while (0)
#define SC_MIX(nv) do { _Pragma("unroll") for (int _g = 0; _g < 8; ++_g) { __builtin_amdgcn_sched_group_barrier(0x008, 1, 0); __builtin_amdgcn_sched_group_barrier(0x002, nv, 0); } } while (0)
#define SC_UPD(F, b, k) do { _Pragma("unroll") for (int _i = 0; _i < 4; ++_i) _Pragma("unroll") for (int _u = 0; _u < 2; ++_u) \
                C[_u][4 * (b) + _i] = __builtin_amdgcn_mfma_f32_16x16x32_bf16(F[_i], v[_u][k], C[_u][4 * (b) + _i], 0, 0, 0); } while (0)
            {
                bf16x8 v[2][2], F0[4], F1[4], cba[2], cbb[2]; f32x4 o[2][4];
                const float cdec = sWI[64];
#pragma unroll
                for (int u = 0; u < 2; ++u)
#pragma unroll
                    for (int a = 0; a < 4; ++a) o[u][a] = (f32x4){0.f, 0.f, 0.f, 0.f};
                SC_LD4(F0, qbase, 4096);
                SC_CVT(cba, 0);
                SC_SB;
                SC_USE4(F0); SC_SB; SC_LD4(F1, qbase + 1024, 4096);
#pragma unroll
                for (int u = 0; u < 2; ++u)
#pragma unroll
                    for (int k2 = 0; k2 < 2; ++k2) v[u][k2] = *(const LAS bf16x8*)(sb_ + SC_SVT + (2 * (2 * wave + u) + k2) * 1024 + lo);
                SC_SB; SC_INTER(cba, F0); SC_CVT(cbb, 2); SC_SCALE(0); SC_MIX(2); SC_SB;
                SC_USE4(F1); SC_SB; SC_LD4(F0, qbase + 2048, 4096); SC_SB; SC_INTER(cbb, F1); SC_CVT(cba, 4); SC_SCALE(2); SC_MIX(2); SC_SB;
                SC_USE4(F0); SC_SB; SC_LD4(F1, qbase + 3072, 4096); SC_SB; SC_INTER(cba, F0); SC_CVT(cbb, 6); SC_SCALE(4); SC_MIX(2); SC_SB;
                SC_USE4(F1); SC_SB; SC_LD4(F0, sbase, 1024); SC_SB; SC_INTER(cbb, F1); SC_SCALE(6); SC_MIX(1); SC_SB;
                SC_USE4(F0); SC_SB; SC_LD4(F1, kbase, 2048); SC_SB;
                if (half == 0) {
#pragma unroll
                    for (int k2 = 0; k2 < 2; ++k2)
#pragma unroll
                        for (int a = 0; a < 2; ++a)
#pragma unroll
                            for (int u = 0; u < 2; ++u) o[u][a] = __builtin_amdgcn_mfma_f32_16x16x32_bf16(v[u][k2], F0[a * 2 + k2], o[u][a], 0, 0, 0);
                } else {
#pragma unroll
                    for (int k2 = 0; k2 < 2; ++k2)
#pragma unroll
                        for (int a = 0; a < 2; ++a)
#pragma unroll
                            for (int u = 0; u < 2; ++u) o[u][2 + a] = __builtin_amdgcn_mfma_f32_16x16x32_bf16(v[u][k2], F0[a * 2 + k2], o[u][2 + a], 0, 0, 0);
                }
                SC_SB;
                SC_USE4(F1); SC_SB; SC_LD4(F0, kbase + 1024, 2048); SC_SB;
                if (!ones) {
                    SC_UPD(F1, 0, 0);
#pragma unroll
                    for (int a = 0; a < 4; ++a) { const size_t mrow = (size_t)(64 * c + 16 * a + fr);
                        *(u32x4*)(NUMh + mrow * 2048 + h * 512 + 64 * sl + 32 * wave + 8 * fq) = (u32x4){pk2n(o[0][a][0], o[0][a][1]), pk2n(o[0][a][2], o[0][a][3]), pk2n(o[1][a][0], o[1][a][1]), pk2n(o[1][a][2], o[1][a][3])}; }
                    SC_MIX(2);
                } else {
                    SC_UPD(F1, 0, 0);
#pragma unroll
                    for (int a = 0; a < 4; ++a) { const size_t mrow = (size_t)(64 * c + 16 * a + fr); if (wave == 0 && fq == 0) DENRh[mrow * 4 + h] = o[0][a][0]; }
                }
                SC_SB;
                SC_USE4(F0); SC_SB; SC_LD4(F1, kbase + 8192, 2048); SC_SB; SC_UPD(F0, 0, 1); SC_SB;
                SC_USE4(F1); SC_SB; SC_LD4(F0, kbase + 8192 + 1024, 2048); SC_SB; SC_UPD(F1, 1, 0); SC_SB;
                SC_UPD(F0, 1, 1); SC_SB;
            }
#undef SC_LD4
#undef SC_SB
#undef SC_USE4
#undef SC_INTER
#undef SC_CVT
#undef SC_SCALE
#undef SC_MIX
#undef SC_UPD
        }
        __builtin_amdgcn_s_setprio(0);
        asm volatile("s_waitcnt vmcnt(0)" ::: "memory");
        SC_BAR();
    } else {
        for (int c = 0; c <= 256; ++c) {
            SC_BAR();
            if (wave == 4 && c > 0 && (c & (SC_PUB - 1)) == 0) {
                __builtin_amdgcn_fence(__ATOMIC_RELEASE, "agent");
                asm volatile("s_waitcnt vmcnt(0)" ::: "memory");
                if (lane == 0) __hip_atomic_store(prog, (unsigned)c, __ATOMIC_RELAXED, __HIP_MEMORY_SCOPE_AGENT);
            }
        }
    }
}

__device__ __forceinline__ void e4_step(int it0, int stride, const float* NUM, const float* DENR, const float* EMT, const bf16* P, const f32x4 w0, const f32x4 w1, bf16* MIX, int lane) {
    u32x4 ra[2], rb[2], ro[2], rz[2]; float dn[2], em[2];
#pragma unroll
    for (int q = 0; q < 2; ++q) { const int it = it0 + q * stride < M * 4 ? it0 + q * stride : it0; const int m = it >> 2, h = it & 3;
        const bf16* NB0 = (const bf16*)NUM + (size_t)m * 2048 + h * 512 + lane * 8;
        ra[q] = __builtin_nontemporal_load((const u32x4*)NB0); rb[q] = __builtin_nontemporal_load((const u32x4*)(NB0 + (size_t)M * 2048));
        ro[q] = __builtin_nontemporal_load((const u32x4*)(P + (size_t)m * EVEN_N + 4096 + h * 512 + lane * 8)); rz[q] = __builtin_nontemporal_load((const u32x4*)(P + (size_t)m * EVEN_N + 6144 + h * 512 + lane * 8));
        dn[q] = DENR[(size_t)m * 4 + h] + DENR[(size_t)M * 4 + (size_t)m * 4 + h]; em[q] = EMT[(size_t)m * 4 + h]; }
#pragma unroll
    for (int q = 0; q < 2; ++q) { const int it = it0 + q * stride; if (it >= M * 4) break; const int m = it >> 2, h = it & 3;
        float na[8], nb[8], og[8], zg[8]; unpack8(ra[q], na); unpack8(rb[q], nb); unpack8(ro[q], og); unpack8(rz[q], zg);
        const float rd = 1.0f / fmaxf(fabsf(dn[q]), em[q]);
        float v[8]; float s = 0.f;
#pragma unroll
        for (int e = 0; e < 8; ++e) { v[e] = (na[e] + nb[e]) * rd * og[e]; s += v[e]; }
        const float mean = wave_sum(s) * (1.f / 512.f); float s2 = 0.f;
#pragma unroll
        for (int e = 0; e < 8; ++e) { v[e] -= mean; s2 += v[e] * v[e]; }
        const float rstd = 1.f / sqrtf(wave_sum(s2) * (1.f / 512.f) + LN_EPS);
        const float wv[8] = {w0.x, w0.y, w0.z, w0.w, w1.x, w1.y, w1.z, w1.w};
#pragma unroll
        for (int e = 0; e < 8; ++e) v[e] = v[e] * rstd * wv[e] * zg[e];
        u32x4 o; o.x = pk2(v[0], v[1]); o.y = pk2(v[2], v[3]); o.z = pk2(v[4], v[5]); o.w = pk2(v[6], v[7]);
        *(u32x4*)(MIX + (size_t)m * EVEN_MIX + h * 512 + lane * 8) = o; }
}
__device__ __forceinline__ void phase_e4(const float* NUM, const float* DENR, const float* EMT, const bf16* P, const float* hnw, bf16* MIX, int G) {
    int tid = threadIdx.x; asm volatile("" : "+v"(tid));
    const int lane = tid & 63, wave = tid >> 6;
    const int gw = blockIdx.x * NWAVES + wave, NGW = G * NWAVES;
    const int hh = gw & 3;
    const f32x4 w0 = *(const f32x4*)(hnw + hh * 512 + lane * 8), w1 = *(const f32x4*)(hnw + hh * 512 + lane * 8 + 4);
    for (int it0 = gw; it0 < M * 4; it0 += 2 * NGW) e4_step(it0, NGW, NUM, DENR, EMT, P, w0, w1, MIX, lane);
}
__device__ __forceinline__ void e4_fused(int bq, int nb, const unsigned* prog, const float* NUM, const float* DENR, const float* EMT, const bf16* P, const float* hnw, bf16* MIX, LAS unsigned char* lds) {
    int tid = threadIdx.x; asm volatile("" : "+v"(tid));
    const int lane = tid & 63, wave = __builtin_amdgcn_readfirstlane(tid >> 6);
    const int NGW = nb * NWAVES;
    volatile LAS unsigned* sHave = (volatile LAS unsigned*)(lds + MISC_OFF) + 16;
    unsigned have = 0u;
    const int hh = wave & 3;
    const f32x4 w0 = *(const f32x4*)(hnw + hh * 512 + lane * 8), w1 = *(const f32x4*)(hnw + hh * 512 + lane * 8 + 4);
    for (int base = bq * NWAVES; base < M * 4; base += 2 * NGW) {
        int last = base + NWAVES - 1 + NGW; last = last < M * 4 ? last : M * 4 - 1;
        const unsigned need = (unsigned)((last >> 2) >> 6) + 1u;
        if (have < need) {
            __syncthreads();
            if (wave == 0) {
                unsigned mn, sp = 0u;
                for (;;) {
                    unsigned a0 = __hip_atomic_load(prog + lane, __ATOMIC_RELAXED, __HIP_MEMORY_SCOPE_AGENT);
                    unsigned a1 = (lane < SC_ITEMS - 64) ? __hip_atomic_load(prog + 64 + lane, __ATOMIC_RELAXED, __HIP_MEMORY_SCOPE_AGENT) : 256u;
                    a0 = a0 < a1 ? a0 : a1;
#pragma unroll
                    for (int o = 32; o >= 1; o >>= 1) { const unsigned u = (unsigned)__shfl_xor((int)a0, o); a0 = a0 < u ? a0 : u; }
                    mn = a0;
                    if (mn >= need || ++sp > (1u << 16)) break;
                    __builtin_amdgcn_s_sleep(64);
                }
                __builtin_amdgcn_fence(__ATOMIC_ACQUIRE, "agent");
                asm volatile("s_waitcnt vmcnt(0)" ::: "memory");
                if (lane == 0) sHave[0] = mn;
            }
            __syncthreads();
            have = sHave[0];
        }
        e4_step(base + wave, NGW, NUM, DENR, EMT, P, w0, w1, MIX, lane);
    }
}

__device__ __forceinline__ void phase_o2(const bf16* P2, const float* pool_b, const float* pool_s, bf16* H, int G) {
    int tid = threadIdx.x; asm volatile("" : "+v"(tid));
    const int gt = blockIdx.x * NTHR + tid, NT = G * NTHR;
    for (int idx = gt; idx < 256 * 512; idx += NT) {
        const int cg = idx & 511, run = idx >> 9, g = cg >> 7, w = 2 << g, t0 = run * 64;
        const bf16* src = P2 + cg * 8;
        const f32x4 b0 = *(const f32x4*)(pool_b + cg * 8), b1 = *(const f32x4*)(pool_b + cg * 8 + 4), s0 = *(const f32x4*)(pool_s + cg * 8), s1 = *(const f32x4*)(pool_s + cg * 8 + 4);
        const float pb[8] = {b0.x, b0.y, b0.z, b0.w, b1.x, b1.y, b1.z, b1.w}, ps[8] = {s0.x, s0.y, s0.z, s0.w, s1.x, s1.y, s1.z, s1.w};
        float sum[8];
#pragma unroll
        for (int e = 0; e < 8; ++e) sum[e] = 0.f;
        for (int t = t0 - w + 1; t < t0; ++t) if (t >= 0) { float f[8]; unpack8(*(const u32x4*)(src + (size_t)t * ODD_IN), f);
#pragma unroll
            for (int e = 0; e < 8; ++e) sum[e] += f[e]; }
        for (int t = t0; t < t0 + 64; t += 4) {
            u32x4 rc[4], rz[4], ro[4];
#pragma unroll
            for (int j = 0; j < 4; ++j) { rc[j] = *(const u32x4*)(src + (size_t)(t + j) * ODD_IN); rz[j] = __builtin_nontemporal_load((const u32x4*)(src + (size_t)(t + j) * ODD_IN + 4096));
                const int to = t + j - w + 1; ro[j] = __builtin_nontemporal_load((const u32x4*)(src + (size_t)(to >= 0 ? to : 0) * ODD_IN)); }
#pragma unroll
            for (int j = 0; j < 4; ++j) {
                float cur[8], zf[8]; unpack8(rc[j], cur); unpack8(rz[j], zf);
#pragma unroll
                for (int e = 0; e < 8; ++e) sum[e] += cur[e];
                const int tt = t + j; const float inv = 1.0f / (float)((tt + 1) < w ? (tt + 1) : w);
                float o[8];
#pragma unroll
                for (int e = 0; e < 8; ++e) o[e] = ((sum[e] * inv - cur[e]) + pb[e]) * ps[e] * zf[e];
                *(u32x4*)(H + (size_t)tt * D + cg * 8) = (u32x4){pk2(o[0], o[1]), pk2(o[2], o[3]), pk2(o[4], o[5]), pk2(o[6], o[7])};
                if (tt - w + 1 >= 0) { float old[8]; unpack8(ro[j], old);
#pragma unroll
                    for (int e = 0; e < 8; ++e) sum[e] -= old[e]; }
            }
        }
    }
}

constexpr int N_PHASES = 24;
__global__ void __launch_bounds__(NTHR, 2) fwd_kernel(Args a) {
    extern __shared__ __attribute__((aligned(16))) unsigned char lds_raw[];
    LAS unsigned char* lds = (LAS unsigned char*)lds_raw;
    const int tid = threadIdx.x, G = gridDim.x;
    unsigned char* ws = a.ws;
    for (int u = tid; u < (LDS_BYTES - LDSCTL_OFF) / 4; u += NTHR) ((LAS unsigned*)(lds + LDSCTL_OFF))[u] = 0u;
    __syncthreads();
    unsigned* barw = (unsigned*)(ws + WS_CTL) + CW_BAR;
    XcdBarrier bar; bar.bar = barw; bar.x = 0; bar.st = nullptr;
    if (!MK_MULTI) bar = xcd_barrier_post(barw, (volatile LAS unsigned*)(lds + MISC_OFF) + 8);
    const int lo = a.ph_lo, hi = a.ph_hi;
#define IN(k) (lo <= (k) && (k) < hi)
#define SEAM(k) do { if (!MK_MULTI && IN(k) && IN((k) + 1)) xcd_barrier_next(bar); } while (0)
#define SEAM0(k) do { if (!MK_MULTI && IN(k) && IN((k) + 1)) xcd_barrier(bar); } while (0)

    float* MOD = (float*)(ws + WS_MOD); float* GATES = (float*)(ws + WS_GATES);
    bf16* U = (bf16*)(ws + WS_U); float* T = (float*)(ws + WS_T); bf16* YB = (bf16*)(ws + WS_T); bf16* XH = (bf16*)(ws + WS_T + 128 * MiB);     bf16* P = (bf16*)(ws + WS_P); bf16* MIX = (bf16*)(ws + WS_MIX);
    float* NUM = (float*)(ws + WS_NUM2); bf16* POOLED = (bf16*)(ws + WS_NUM);
    float* WINTER = (float*)(ws + WS_WINTER); float* EMT = (float*)(ws + WS_EMT); float* CDEC = (float*)(ws + WS_CDEC); float* DENR = (float*)(ws + WS_DENR); float* BLWM = (float*)(ws + WS_CDEC + 65536);
    bf16* SB = (bf16*)(ws + WS_S); bf16* QC = (bf16*)(ws + WS_QC); bf16* KC = (bf16*)(ws + WS_KC); bf16* VT = (bf16*)(ws + WS_VT); bf16* VBT = (bf16*)(ws + WS_VBT); bf16* QB2 = (bf16*)(ws + WS_T); bf16* KB2 = (bf16*)(ws + WS_T + 32 * MiB);

    float* BIAS = (float*)(ws + WS_BIAS);
    if (IN(0)) { phase_mods(a, lds, G); } SEAM0(0);
    if (IN(1)) { for (int rep = 0; rep < REP_P0; ++rep) phase_weights(a, lds, G); } SEAM(1);
    if (IN(2)) {
#pragma unroll 1
        for (int lp = 0; lp < 2; ++lp) {
            const bf16* wbp = (const bf16*)(ws + WS_W + (size_t)lp * W_PAIR);
            const bf16* Wt_pool_ = (const bf16*)((const unsigned char*)wbp + W_IN_E + W_OUT_E + W_IN_O); bf16* Wt_in_o_ = (bf16*)((unsigned char*)wbp + W_IN_E + W_OUT_E);
            pg8::Gemm g{Wt_pool_, (const bf16*)(ws + WS_P) + (size_t)lp * D * D, D, D, 1024, 1024, D, 0, 4}; pg8::StaticOrder S; S.init(D, D, G, (int)blockIdx.x);
            pg8::EpiColScale E{Wt_in_o_, D, MOD + (2 * lp + 1) * 12288 + D}; pg8::gemm_phase<pg8::EpiColScale, pg8::StaticOrder, true>(lds, g, S, E);
        }
    }
    if (IN(3)) { phase_rows<true, false, false>(a.in[I_X], nullptr, nullptr, nullptr, nullptr, U, nullptr, (const bf16*)(ws + WS_WG), (const float*)(ws + WS_WG + 262144), GATES, lds, G); } SEAM(3);

#pragma unroll 1
    for (int lp = 0; lp < 2; ++lp) {
        const int pb = 4 + 10 * lp;
        const bf16* wb = (const bf16*)(ws + WS_W + (size_t)lp * W_PAIR);
        const bf16* Wt_in_e = wb; const bf16* Wt_out_e = (const bf16*)((const unsigned char*)wb + W_IN_E); const bf16* Wt_in_o = (const bf16*)((const unsigned char*)wb + W_IN_E + W_OUT_E);
        const bf16* Wt_pool = (const bf16*)((const unsigned char*)wb + W_IN_E + W_OUT_E + W_IN_O); const bf16* Wt_out_o = (const bf16*)((const unsigned char*)wb + W_IN_E + W_OUT_E + W_IN_O + W_POOL);
        const float* conv_w = lp ? a.in[24] : a.in[5]; const float* igb = lp ? a.in[25] : a.in[6]; const float* fgb = lp ? a.in[26] : a.in[7]; const float* hnw = lp ? a.in[27] : a.in[8];
        const float* lng_e = lp ? a.in[29] : a.in[10]; const float* lnb_e = lp ? a.in[30] : a.in[11];
        const float* pool_b = lp ? a.in[35] : a.in[16]; const float* pool_s = lp ? a.in[36] : a.in[17];
        const float* lng_o = lp ? a.in[38] : a.in[19]; const float* lnb_o = lp ? a.in[39] : a.in[20];
        const float* xcur_e = lp ? (const float*)a.out : a.in[I_X];
        const float* mod_e = MOD + (2 * lp) * 12288; const float* mod_o = MOD + (2 * lp + 1) * 12288;

        if (IN(pb + 0)) { chunk_gate_sums(GATES, igb, fgb, BLWM, G);
            pg8::Gemm g{U, Wt_in_e, M, EVEN_N, D, D, D, 0, 0}; pg8::StaticOrder S; S.init(M, EVEN_N, G, (int)blockIdx.x);
            pg8::EpiAct E{P, EVEN_N, 0, BIAS + (2 * lp) * 12288}; pg8::gemm_phase<pg8::EpiAct, pg8::StaticOrder, true>(lds, g, S, E); }
        SEAM(pb + 0);
        if (IN(pb + 1)) for (int rep = 0; rep < REP_E2; ++rep) {
            e2_preamble(BLWM, lds);
            for (int it = blockIdx.x; it < 1024; it += G) e2_prep_item(it >> 2, it & 3, P, conv_w, GATES, igb, fgb, QC, KC, SB, VT, VBT, QB2, KB2, WINTER, EMT, CDEC, lds);
        }
        SEAM(pb + 1);
        const bool fusedE4 = G > 2 * SC_ITEMS;
        unsigned* PROG = (unsigned*)(ws + WS_CTL + 32768) + lp * 128;
        if (IN(pb + 2)) for (int rep = 0; rep < REP_E3; ++rep) {
            const int nscan = G > 2 * SC_ITEMS ? SC_ITEMS : 0;
#define SC_CALL(it) e3_scan_item(((it) >> 1) / (SC_SLICES + 1), ((it) >> 1) % (SC_SLICES + 1), (it) & 1, QC, KC, SB, VT, WINTER, CDEC, NUM, DENR, (const bf16*)(ws + WS_CDEC + 131072), PROG + (it), lds)
            if ((int)blockIdx.x < nscan) { const int g_ = (int)blockIdx.x & 7, s_ = (int)blockIdx.x >> 3; SC_CALL(((g_ >> 1) * (SC_SLICES + 1) + s_) * 2 + (g_ & 1)); }
            else {
                if (nscan == 0) for (int it = blockIdx.x; it < SC_ITEMS; it += G) SC_CALL(it);
                for (int it = blockIdx.x - nscan; it < 1024; it += G - nscan) { const int r = 1023 - it; e3_attn_item(r & 7, r >> 3, P, QB2, KB2, VBT, MIX, lds); }
                if (nscan) e4_fused((int)blockIdx.x - nscan, G - nscan, PROG, NUM, DENR, EMT, P, hnw, MIX, lds);
            }
#undef SC_CALL
        }
        if (!fusedE4 || MK_MULTI) SEAM(pb + 2);
        if (IN(pb + 3) && !fusedE4) { phase_e4(NUM, DENR, EMT, P, hnw, MIX, G); }
        SEAM(pb + 3);
        if (IN(pb + 4)) { pg8::Gemm g{MIX, Wt_out_e, M, D, EVEN_MIX, EVEN_MIX, EVEN_MIX, 0, 0}; pg8::StaticOrder S; S.init(M, D, G, (int)blockIdx.x);
            pg8::EpiAct E{YB, D, 2, nullptr}; pg8::gemm_phase<pg8::EpiAct, pg8::StaticOrder, true>(lds, g, S, E); }
        SEAM(pb + 4);
        if (IN(pb + 5)) for (int rep = 0; rep < REP_ROWS; ++rep) {
            if (lp == 0) phase_rows<false, true, false, true>(U, YB, mod_e + 2 * D, lng_e, lnb_e, U, XH, nullptr, nullptr, nullptr, lds, G);
            else phase_rows<false, true, false>(XH, YB, mod_e + 2 * D, lng_e, lnb_e, U, XH, nullptr, nullptr, nullptr, lds, G);
        }
        SEAM(pb + 5);
        if (IN(pb + 6)) { pg8::Gemm g{U, Wt_in_o, M, ODD_IN, D, D, D, 0, 0}; pg8::StaticOrder S; S.init(M, ODD_IN, G, (int)blockIdx.x);
            pg8::EpiAct E{P, ODD_IN, 1, BIAS + (2 * lp + 1) * 12288}; pg8::gemm_phase<pg8::EpiAct, pg8::StaticOrder, true>(lds, g, S, E); }
        SEAM(pb + 6);
        if (IN(pb + 7)) { phase_o2(P, pool_b, pool_s, MIX, G); }
        SEAM(pb + 7);
        if (IN(pb + 8)) for (int rep = 0; rep < REP_GEMM; ++rep) { pg8::Gemm g{MIX, Wt_out_o, M, D, D, D, D, 0, 0}; pg8::StaticOrder S; S.init(M, D, G, (int)blockIdx.x);
            pg8::EpiAct E{YB, D, 2, nullptr}; pg8::gemm_phase<pg8::EpiAct, pg8::StaticOrder, true>(lds, g, S, E); }
        SEAM(pb + 8);
        if (IN(pb + 9)) {
            if (lp == 0) phase_rows<false, true, false>(XH, YB, mod_o + 2 * D, lng_o, lnb_o, U, XH, (const bf16*)(ws + WS_WG) + 8 * D, (const float*)(ws + WS_WG + 262144) + 8, GATES, lds, G);
            else phase_rows<false, true, true>(XH, YB, mod_o + 2 * D, lng_o, lnb_o, a.out, nullptr, nullptr, nullptr, nullptr, lds, G);
        }
        SEAM(pb + 9);
    }
#undef IN
#undef SEAM
}

extern "C" void kernel_launch(void* const* d_in, const int* in_sizes, int n_in, void* d_out, int out_size, void* d_ws, size_t ws_size, hipStream_t stream) {
    static int grid = 0;
    if (grid == 0) {
        if (n_in != 40 || in_sizes[0] != M * D || out_size != M * D || ws_size < WS_END) { fprintf(stderr, "kernel_launch: unexpected shapes (n_in %d, in0 %d, out %d, ws %zu < %zu)\n", n_in, n_in > 0 ? in_sizes[0] : -1, out_size, ws_size, (size_t)WS_END); grid = -1; return; }
        int dev = 0, cus = 0, per_cu = 0;
        if (hipGetDevice(&dev) != hipSuccess || hipDeviceGetAttribute(&cus, hipDeviceAttributeMultiprocessorCount, dev) != hipSuccess) { grid = -1; return; }
        if (hipFuncSetAttribute((const void*)fwd_kernel, hipFuncAttributeMaxDynamicSharedMemorySize, LDS_BYTES) != hipSuccess) { fprintf(stderr, "kernel_launch: hipFuncSetAttribute failed\n"); grid = -1; return; }
        if (hipOccupancyMaxActiveBlocksPerMultiprocessor(&per_cu, (const void*)fwd_kernel, NTHR, LDS_BYTES) != hipSuccess || per_cu < 1)
            fprintf(stderr, "kernel_launch: note: occupancy query reports %d workgroups per CU\n", per_cu);
        (void)hipGetLastError();
        grid = cus;
    }
    if (grid < 0) return;
    if (hipMemsetAsync((char*)d_ws + WS_CTL, 0, CTL_ZERO_BYTES, stream) != hipSuccess) return;
    Args a{};
    for (int i = 0; i < 40; ++i) a.in[i] = (const float*)d_in[i];
    a.out = (float*)d_out; a.ws = (unsigned char*)d_ws;
#if MK_MULTI
    for (int p = 0; p < N_PHASES; ++p) { a.ph_lo = p; a.ph_hi = p + 1; hipLaunchKernelGGL(fwd_kernel, dim3(grid), dim3(NTHR), LDS_BYTES, stream, a); }
#else
    a.ph_lo = 0; a.ph_hi = N_PHASES; hipLaunchKernelGGL(fwd_kernel, dim3(grid), dim3(NTHR), LDS_BYTES, stream, a);
#endif
}
```
